# Optimizing an MI355X kernel written in HIP

```python
import math
import jax, jax.numpy as jnp
from jax import lax
import numpy as np

D_MODEL = 1024
BATCH = 4
SEQ = 8192
DEPTH = 2

N_A_LAYERS = DEPTH // 2
N_B_LAYERS = DEPTH - N_A_LAYERS

SSM_D_INNER = 2 * D_MODEL
SSM_HEAD_DIM = 64
SSM_N_HEADS = SSM_D_INNER // SSM_HEAD_DIM
SSM_D_STATE = 128
SSM_N_GROUPS = 8
SSM_HEADS_PER_GROUP = SSM_N_HEADS // SSM_N_GROUPS
SSM_CONV = 4
SSM_CHUNK = 128
SSM_CONV_DIM = SSM_D_INNER + 2 * SSM_N_GROUPS * SSM_D_STATE
SSM_IN_DIM = SSM_D_INNER + SSM_CONV_DIM + SSM_N_HEADS

SB_N_HEADS = 16
SB_HEAD_DIM = D_MODEL // SB_N_HEADS
SB_WIDTH = SB_N_HEADS * SB_HEAD_DIM
SB_BLOCK = 128

FFN_DIM = ((8 * D_MODEL // 3 + 255) // 256) * 256
FFN_CONV = 3

NORM_EPS = 1e-6

kernel_name = "yoco_mamba2_stickbreaking_convffn_adaln"


def rmsnorm(x, g):
    xf = x.astype(jnp.float32)
    y = xf * lax.rsqrt(jnp.mean(xf * xf, axis=-1, keepdims=True) + NORM_EPS)
    return (y * g.astype(jnp.float32)).astype(x.dtype)


def modulate(h, shift, scale):
    return h * (1.0 + scale[:, None, :]) + shift[:, None, :]


def causal_dwconv(x, w, b):
    width = w.shape[0]
    s = x.shape[1]
    xp = jnp.pad(x, ((0, 0), (width - 1, 0), (0, 0)))
    out = xp[:, 0:s] * w[0]
    for k in range(1, width):
        out = out + xp[:, k:k + s] * w[k]
    return out + b


def ssd_chunked(x, dt, a_neg, bm, cm):
    b, l = x.shape[0], x.shape[1]
    nc = l // SSM_CHUNK
    G, R, P, N, Q = SSM_N_GROUPS, SSM_HEADS_PER_GROUP, SSM_HEAD_DIM, SSM_D_STATE, SSM_CHUNK
    xdt = (x * dt[..., None].astype(x.dtype)).reshape(b, nc, Q, G, R, P)
    bc = bm.reshape(b, nc, Q, G, N)
    cc = cm.reshape(b, nc, Q, G, N)
    a = (dt * a_neg).reshape(b, nc, Q, G, R)
    acs = jnp.moveaxis(jnp.cumsum(a, axis=2), 2, -1)
    causal = jnp.tril(jnp.ones((Q, Q), dtype=bool))
    seg = jnp.exp(jnp.where(causal, acs[..., :, None] - acs[..., None, :], -jnp.inf)).astype(x.dtype)
    cb = jnp.einsum('bclgn,bcsgn->bcgls', cc, bc)
    y_diag = jnp.einsum('bcgrls,bcsgrp->bclgrp', cb[:, :, :, None] * seg, xdt)
    decay_states = jnp.exp(acs[..., -1:] - acs).astype(x.dtype)
    states = jnp.einsum('bcsgn,bcgrs,bcsgrp->bcgrpn', bc, decay_states, xdt)
    chunk_decay = jnp.exp(acs[..., -1])

    def step(h, inp):
        st, dec = inp
        return h * dec[..., None, None] + st, h

    h0 = jnp.zeros((b, G, R, P, N), jnp.float32)
    _, prev = lax.scan(step, h0, (jnp.moveaxis(states, 1, 0).astype(jnp.float32),
                                  jnp.moveaxis(chunk_decay, 1, 0)))
    prev = jnp.moveaxis(prev, 0, 1).astype(x.dtype)
    y_off = jnp.einsum('bclgn,bcgrpn,bcgrl->bclgrp', cc, prev, jnp.exp(acs).astype(x.dtype))
    return (y_diag + y_off).reshape(b, l, G * R, P)


def mamba2_mixer(h, w_in, conv_w, conv_b, dt_bias, a_log, d_skip, norm_g, w_out):
    b, l, _ = h.shape
    zxbcdt = h @ w_in
    z = zxbcdt[..., :SSM_D_INNER]
    xbc = zxbcdt[..., SSM_D_INNER:SSM_D_INNER + SSM_CONV_DIM]
    dt_raw = zxbcdt[..., SSM_D_INNER + SSM_CONV_DIM:]
    xbc = jax.nn.silu(causal_dwconv(xbc, conv_w, conv_b))
    gn = SSM_N_GROUPS * SSM_D_STATE
    xs = xbc[..., :SSM_D_INNER].reshape(b, l, SSM_N_HEADS, SSM_HEAD_DIM)
    bm = xbc[..., SSM_D_INNER:SSM_D_INNER + gn].reshape(b, l, SSM_N_GROUPS, SSM_D_STATE)
    cm = xbc[..., SSM_D_INNER + gn:].reshape(b, l, SSM_N_GROUPS, SSM_D_STATE)
    dt = jax.nn.softplus(dt_raw.astype(jnp.float32) + dt_bias.astype(jnp.float32))
    a_neg = -jnp.exp(a_log.astype(jnp.float32))
    y = ssd_chunked(xs, dt, a_neg, bm, cm) + xs * d_skip[:, None]
    y = y.reshape(b, l, SSM_D_INNER)
    y = rmsnorm(y * jax.nn.silu(z), norm_g)
    return y @ w_out


def stick_breaking_attention(q, k, v):
    b, nh, s, d = q.shape
    nb = s // SB_BLOCK
    scale = 1.0 / math.sqrt(d)
    pos = jnp.arange(SB_BLOCK)

    def one_block(qi):
        q_blk = lax.dynamic_slice_in_dim(q, qi * SB_BLOCK, SB_BLOCK, axis=2)
        qpos = qi * SB_BLOCK + pos

        def body(step, carry):
            acc, suffix = carry
            kb = qi - step
            k_blk = lax.dynamic_slice_in_dim(k, kb * SB_BLOCK, SB_BLOCK, axis=2)
            v_blk = lax.dynamic_slice_in_dim(v, kb * SB_BLOCK, SB_BLOCK, axis=2)
            kpos = kb * SB_BLOCK + pos
            live = kpos[None, :] < qpos[:, None]
            z = jnp.einsum('bhtd,bhsd->bhts', q_blk, k_blk).astype(jnp.float32) * scale
            log_1mb = jnp.where(live, jax.nn.log_sigmoid(-z), 0.0)
            row_total = jnp.sum(log_1mb, axis=-1)
            later = row_total[..., None] - jnp.cumsum(log_1mb, axis=-1)
            log_w = jax.nn.log_sigmoid(z) + later + suffix[..., None]
            w = jnp.where(live, jnp.exp(log_w), 0.0)
            acc = acc + jnp.einsum('bhts,bhsd->bhtd', w.astype(v.dtype), v_blk).astype(jnp.float32)
            return acc, suffix + row_total

        init = (jnp.zeros((b, nh, SB_BLOCK, d), jnp.float32), jnp.zeros((b, nh, SB_BLOCK), jnp.float32))
        acc, _ = lax.fori_loop(0, qi + 1, body, init)
        return acc.astype(q.dtype)

    out = lax.map(one_block, jnp.arange(nb))
    return jnp.transpose(out, (1, 2, 0, 3, 4)).reshape(b, nh, s, d)


def split_heads(t):
    b, s, _ = t.shape
    return t.reshape(b, s, SB_N_HEADS, SB_HEAD_DIM).transpose(0, 2, 1, 3)


def sb_mixer(h, k, v, w_q, w_o):
    b, s, _ = h.shape
    q = split_heads(h @ w_q)
    o = stick_breaking_attention(q, k, v)
    return o.transpose(0, 2, 1, 3).reshape(b, s, SB_WIDTH) @ w_o


def conv_ffn(h, w_in, conv_w, conv_b, w_out):
    u = causal_dwconv(h @ w_in, conv_w, conv_b)
    gate, val = u[..., :FFN_DIM], u[..., FFN_DIM:]
    return (jax.nn.silu(gate) * val) @ w_out


def setup_inputs(seed: int = 0) -> dict:
    key = jax.random.key(seed)
    ks = iter(jax.random.split(key, 40))
    f32 = jnp.float32
    D = D_MODEL

    def nrm(shape, scale):
        return jax.random.normal(next(ks), shape, f32) * scale

    def gain(shape):
        return 1.0 + 0.02 * jax.random.normal(next(ks), shape, f32)

    x = jax.random.normal(next(ks), (BATCH, SEQ, D), f32)
    c = jax.random.normal(next(ks), (BATCH, D), f32)
    ada_w = nrm((DEPTH, D, 6 * D), 0.5 * D ** -0.5)
    ada_b = nrm((DEPTH, 6 * D), 0.02)
    norm_mix_g = gain((DEPTH, D))
    norm_ffn_g = gain((DEPTH, D))
    ssm_w_in = nrm((N_A_LAYERS, D, SSM_IN_DIM), D ** -0.5)
    ssm_conv_w = nrm((N_A_LAYERS, SSM_CONV, SSM_CONV_DIM), SSM_CONV ** -0.5)
    ssm_conv_b = nrm((N_A_LAYERS, SSM_CONV_DIM), 0.02)
    u = jax.random.uniform(next(ks), (N_A_LAYERS, SSM_N_HEADS), f32)
    dt0 = jnp.exp(u * (math.log(0.1) - math.log(0.001)) + math.log(0.001))
    ssm_dt_bias = dt0 + jnp.log(-jnp.expm1(-dt0))
    ssm_a_log = jnp.log(jax.random.uniform(next(ks), (N_A_LAYERS, SSM_N_HEADS), f32, 1.0, 16.0))
    ssm_d = gain((N_A_LAYERS, SSM_N_HEADS))
    ssm_norm_g = gain((N_A_LAYERS, SSM_D_INNER))
    ssm_w_out = nrm((N_A_LAYERS, SSM_D_INNER, D), SSM_D_INNER ** -0.5)
    kv_ada_w = nrm((D, 2 * D), 0.5 * D ** -0.5)
    kv_ada_b = nrm((2 * D,), 0.02)
    kv_norm_g = gain((D,))
    w_k = nrm((D, SB_WIDTH), D ** -0.5)
    w_v = nrm((D, SB_WIDTH), D ** -0.5)
    sb_w_q = nrm((N_B_LAYERS, D, SB_WIDTH), D ** -0.5)
    sb_w_o = nrm((N_B_LAYERS, SB_WIDTH, D), SB_WIDTH ** -0.5)
    ffn_w_in = nrm((DEPTH, D, 2 * FFN_DIM), D ** -0.5)
    ffn_conv_w = nrm((DEPTH, FFN_CONV, 2 * FFN_DIM), FFN_CONV ** -0.5)
    ffn_conv_b = nrm((DEPTH, 2 * FFN_DIM), 0.02)
    ffn_w_out = nrm((DEPTH, FFN_DIM, D), FFN_DIM ** -0.5)
    final_ada_w = nrm((D, 2 * D), 0.5 * D ** -0.5)
    final_ada_b = nrm((2 * D,), 0.02)
    final_norm_g = gain((D,))
    return {"x": x, "c": c, "ada_w": ada_w, "ada_b": ada_b,
            "norm_mix_g": norm_mix_g, "norm_ffn_g": norm_ffn_g,
            "ssm_w_in": ssm_w_in, "ssm_conv_w": ssm_conv_w, "ssm_conv_b": ssm_conv_b,
            "ssm_dt_bias": ssm_dt_bias, "ssm_a_log": ssm_a_log, "ssm_d": ssm_d,
            "ssm_norm_g": ssm_norm_g, "ssm_w_out": ssm_w_out,
            "kv_ada_w": kv_ada_w, "kv_ada_b": kv_ada_b, "kv_norm_g": kv_norm_g,
            "w_k": w_k, "w_v": w_v, "sb_w_q": sb_w_q, "sb_w_o": sb_w_o,
            "ffn_w_in": ffn_w_in, "ffn_conv_w": ffn_conv_w, "ffn_conv_b": ffn_conv_b,
            "ffn_w_out": ffn_w_out, "final_ada_w": final_ada_w, "final_ada_b": final_ada_b,
            "final_norm_g": final_norm_g}


def reference(x, c, ada_w, ada_b, norm_mix_g, norm_ffn_g,
              ssm_w_in, ssm_conv_w, ssm_conv_b, ssm_dt_bias, ssm_a_log, ssm_d,
              ssm_norm_g, ssm_w_out, kv_ada_w, kv_ada_b, kv_norm_g, w_k, w_v,
              sb_w_q, sb_w_o, ffn_w_in, ffn_conv_w, ffn_conv_b, ffn_w_out,
              final_ada_w, final_ada_b, final_norm_g):
    c_act = jax.nn.silu(c)
    k = v = None
    for layer in range(DEPTH):
        mod = c_act @ ada_w[layer] + ada_b[layer]
        sh1, sc1, g1, sh2, sc2, g2 = jnp.split(mod, 6, axis=-1)
        h = modulate(rmsnorm(x, norm_mix_g[layer]), sh1, sc1)
        if layer < N_A_LAYERS:
            y = mamba2_mixer(h, ssm_w_in[layer], ssm_conv_w[layer], ssm_conv_b[layer],
                             ssm_dt_bias[layer], ssm_a_log[layer], ssm_d[layer],
                             ssm_norm_g[layer], ssm_w_out[layer])
        else:
            j = layer - N_A_LAYERS
            y = sb_mixer(h, k, v, sb_w_q[j], sb_w_o[j])
        x = x + g1[:, None, :] * y
        h = modulate(rmsnorm(x, norm_ffn_g[layer]), sh2, sc2)
        x = x + g2[:, None, :] * conv_ffn(h, ffn_w_in[layer], ffn_conv_w[layer],
                                          ffn_conv_b[layer], ffn_w_out[layer])
        if layer == N_A_LAYERS - 1:
            kv_mod = c_act @ kv_ada_w + kv_ada_b
            kv_sh, kv_sc = jnp.split(kv_mod, 2, axis=-1)
            hk = modulate(rmsnorm(x, kv_norm_g), kv_sh, kv_sc)
            k = split_heads(hk @ w_k)
            v = split_heads(hk @ w_v)
    f_mod = c_act @ final_ada_w + final_ada_b
    f_sh, f_sc = jnp.split(f_mod, 2, axis=-1)
    return modulate(rmsnorm(x, final_norm_g), f_sh, f_sc)
```

```cpp
#include <hip/hip_runtime.h>
#include <hip/hip_cooperative_groups.h>
#include <cstdio>
#include <cstdint>
namespace cg = cooperative_groups;
#ifndef DBG
#define DBG 0
#endif
namespace pg8 {
#define PG8_LAS __attribute__((address_space(3)))
typedef unsigned short bf16_t;
typedef short bf16x8 __attribute__((ext_vector_type(8)));
typedef float f32x4 __attribute__((ext_vector_type(4)));
typedef unsigned u32x4 __attribute__((ext_vector_type(4)));
constexpr int BM = 256, BK = 64, HALF = 128, HTB = HALF * BK * 2  , STAGE_BYTES = 8 * HTB, NXCD = 8, WGM = 8;

__host__ __device__ __forceinline__ int lds_byte(int r, int c) { const int st = (r >> 4) * 2 + (c >> 5), rr = r & 15, cc = c & 31, ob = rr * 64 + cc * 2; return st * 1024 + (ob ^ (((ob >> 9) & 1) << 5)); }
__host__ __device__ __forceinline__ void stage_rc(int b, int& R, int& C) { const int st = b / 1024, sb = b % 1024, swz = sb ^ (((sb >> 9) & 1) << 5); R = (st >> 1) * 16 + swz / 64; C = (st & 1) * 32 + (swz % 64) / 2; }
__host__ __device__ __forceinline__ int perm32(int rho) { const int n = rho >> 4, i = rho & 15; return 8 * (i >> 2) + 4 * n + (i & 3); }

struct Unit { int pm, pn; };
struct Gemm { const bf16_t* A; const bf16_t* Bt; int M, N, K; };

struct StaticOrder {
    int nM, nN, nwg, G, c;
    __host__ __device__ void init(int M, int N, int G_, int c_) { nM = M / BM; nN = N / BM; nwg = nM * nN; G = G_; c = c_; }
    __host__ __device__ bool next(int i, Unit& u) const {
        const long L = (long)i * G + c; if (L >= nwg) return false;
        int wgid = (int)L; { const int q = nwg / NXCD, r = nwg % NXCD, xcd = wgid % NXCD, off = wgid / NXCD; wgid = (xcd < r ? xcd * (q + 1) : r * (q + 1) + (xcd - r) * q) + off; }
        const int nig = WGM * nN, gid = wgid / nig, fm = gid * WGM, gsz = (nM - fm) < WGM ? (nM - fm) : WGM;
        u.pm = fm + ((wgid % nig) % gsz); u.pn = (wgid % nig) / gsz; return true;
    }
    __device__ __forceinline__ void a_ready(const Unit&) const {}
    __device__ __forceinline__ void done(const Unit&) const {}
};

__device__ __forceinline__ unsigned cvt_pk_bf16(float lo, float hi) { unsigned r; asm volatile("v_cvt_pk_bf16_f32 %0, %1, %2" : "=v"(r) : "v"(lo), "v"(hi)); return r; }

typedef unsigned u32x2 __attribute__((ext_vector_type(2)));
typedef float f32x2 __attribute__((ext_vector_type(2)));
__device__ __forceinline__ float silu_f(float x) { return x * __builtin_amdgcn_rcpf(1.f + __expf(-x)); }
__device__ __forceinline__ float softplus_f(float x) { return fmaxf(x, 0.f) + __logf(1.f + __expf(-fabsf(x))); }
template <int K> __device__ __forceinline__ float dpp_ror(float v) { return __int_as_float(__builtin_amdgcn_update_dpp(0, __float_as_int(v), 0x120 + K, 0xf, 0xf, false)); }
template <int K> __device__ __forceinline__ float dpp_shr_keep(float cur, float old) { return __int_as_float(__builtin_amdgcn_update_dpp(__float_as_int(old), __float_as_int(cur), 0x110 + K, 0xf, 0xf, false)); }
template <int K> __device__ __forceinline__ float shift1(float cur, float prev, float halo, bool first) { const float old = first ? halo : dpp_ror<K>(prev); return dpp_shr_keep<K>(cur, old); }
template <int K> __device__ __forceinline__ f32x4 shift_rows(const f32x4 cur, const f32x4 prev, const f32x4 halo, bool first) {
    f32x4 r;
#pragma unroll
    for (int e = 0; e < 4; ++e) { const float old = first ? halo[e] : dpp_ror<K>(prev[e]); r[e] = dpp_shr_keep<K>(cur[e], old); }
    return r;
}

struct EpiStore {
    static constexpr bool PERM = true, AFTER_DRAIN = false;
    bf16_t* O; int ldc; float sc;
    __device__ __forceinline__ void operator()(const f32x4 (&acc)[2][2][4][2], const Unit& u, int wr, int wc, int fr, int fq) const {
        asm volatile("" : "+v"(fr), "+v"(fq));
        const int row0 = u.pm * BM + wr * 64 + fr, col0 = u.pn * BM + wc * 32 + 8 * fq;
#pragma unroll
        for (int ai = 0; ai < 2; ++ai)
#pragma unroll
            for (int m = 0; m < 4; ++m) { bf16_t* rowp = O + (size_t)(row0 + ai * HALF + m * 16) * ldc + col0;
#pragma unroll
                for (int bj = 0; bj < 2; ++bj) { const f32x4 v0 = acc[ai][bj][m][0] * sc, v1 = acc[ai][bj][m][1] * sc;
                    u32x4 w; w.x = cvt_pk_bf16(v0[0], v0[1]); w.y = cvt_pk_bf16(v0[2], v0[3]); w.z = cvt_pk_bf16(v1[0], v1[1]); w.w = cvt_pk_bf16(v1[2], v1[3]);
                    *(u32x4*)(rowp + bj * HALF) = w; } }
    }
};

struct EpiRes {
    static constexpr bool PERM = false, AFTER_DRAIN = false;
    const float* xin; float* xout; const float* gate; const float* sumsq;
    __device__ __forceinline__ void operator()(const f32x4 (&acc)[2][2][4][2], const Unit& u, int wr, int wc, int fr, int fq) const {
        asm volatile("" : "+v"(fr), "+v"(fq));
        const int row0 = u.pm * BM + wr * 64 + fr, col0 = u.pn * BM + wc * 32 + 4 * fq;
        const float* gp = gate + (size_t)(u.pm >> 5) * 16384 + col0;
        f32x4 gv[2][2];
#pragma unroll
        for (int bj = 0; bj < 2; ++bj)
#pragma unroll
            for (int n = 0; n < 2; ++n) gv[bj][n] = *(const f32x4*)(gp + bj * HALF + n * 16);
#pragma unroll
        for (int ai = 0; ai < 2; ++ai)
#pragma unroll
            for (int m = 0; m < 4; ++m) { const int row = row0 + ai * HALF + m * 16;
                const float rs = sumsq ? rsqrtf(sumsq[row] * (1.0f / 2048.0f) + 1e-6f) : 1.0f;
                const size_t off = (size_t)row * 1024 + col0;
#pragma unroll
                for (int bj = 0; bj < 2; ++bj)
#pragma unroll
                    for (int n = 0; n < 2; ++n) { const f32x4 xi = *(const f32x4*)(xin + off + bj * HALF + n * 16);
                        *(f32x4*)(xout + off + bj * HALF + n * 16) = xi + gv[bj][n] * acc[ai][bj][m][n] * rs; } }
    }
};

struct EpiZdt {
    static constexpr bool PERM = true, AFTER_DRAIN = false;
    bf16_t* Z; float* DT; const float* dtb;
    __device__ __forceinline__ void operator()(const f32x4 (&acc)[2][2][4][2], const Unit& u, int wr, int wc, int fr, int fq) const {
        asm volatile("" : "+v"(fr), "+v"(fq));
        const int row0 = u.pm * BM + wr * 64 + fr;
        if (u.pn < 8) {
            const int col0 = u.pn * BM + wc * 32 + 8 * fq;
#pragma unroll
            for (int ai = 0; ai < 2; ++ai)
#pragma unroll
                for (int m = 0; m < 4; ++m) { bf16_t* rowp = Z + (size_t)(row0 + ai * HALF + m * 16) * 2048 + col0;
#pragma unroll
                    for (int bj = 0; bj < 2; ++bj) { const f32x4 v0 = acc[ai][bj][m][0], v1 = acc[ai][bj][m][1];
                        u32x4 w; w.x = cvt_pk_bf16(v0[0], v0[1]); w.y = cvt_pk_bf16(v0[2], v0[3]); w.z = cvt_pk_bf16(v1[0], v1[1]); w.w = cvt_pk_bf16(v1[2], v1[3]);
                        *(u32x4*)(rowp + bj * HALF) = w; } }
            return;
        }
        {
            if (wc == 0) {
#pragma unroll
                for (int n = 0; n < 2; ++n) { const f32x4 bv = *(const f32x4*)(dtb + 8 * fq + 4 * n);
#pragma unroll
                    for (int ai = 0; ai < 2; ++ai)
#pragma unroll
                        for (int m = 0; m < 4; ++m) { f32x4 v = acc[ai][0][m][n] + bv;
#pragma unroll
                            for (int e = 0; e < 4; ++e) v[e] = softplus_f(v[e]);
                            *(f32x4*)(DT + (size_t)(row0 + ai * HALF + m * 16) * 32 + 8 * fq + 4 * n) = v; } }
            }
            return;
        }
    }
};

struct EpiMamba {
    static constexpr bool PERM = true, AFTER_DRAIN = false;
    static constexpr int NC = 4096;
    bf16_t* XBC; float* P; float* UH; const float* cw; const float* cb; PG8_LAS float* xch;
    __device__ __forceinline__ void operator()(const f32x4 (&acc)[2][2][4][2], const Unit& u, int wr, int wc, int fr, int fq) const {
        asm volatile("" : "+v"(fr), "+v"(fq));
        const int row0 = u.pm * BM + wr * 64 + fr;
        const int cpos0 = 32 * wc + 8 * fq;
        if (fr >= 13) {
#pragma unroll
            for (int ai = 0; ai < 2; ++ai)
#pragma unroll
                for (int bj = 0; bj < 2; ++bj)
#pragma unroll
                    for (int n = 0; n < 2; ++n) *(PG8_LAS f32x4*)(xch + ((2 * ai + wr) * 3 + (fr - 13)) * 256 + 128 * bj + cpos0 + 4 * n) = acc[ai][bj][3][n];
            if (wr == 1) {
#pragma unroll
                for (int bj = 0; bj < 2; ++bj)
#pragma unroll
                    for (int n = 0; n < 2; ++n) *(f32x4*)(UH + ((size_t)u.pm * 3 + (fr - 13)) * NC + u.pn * BM + 128 * bj + cpos0 + 4 * n) = acc[1][bj][3][n];
            }
        }
        asm volatile("s_waitcnt lgkmcnt(0)" ::: "memory"); __builtin_amdgcn_s_barrier(); asm volatile("" ::: "memory");
#pragma unroll
        for (int ai = 0; ai < 2; ++ai) {
            const int seg = 2 * ai + wr; const bool has_prev = seg > 0; const int sp = has_prev ? seg - 1 : 0;
#pragma unroll
            for (int bj = 0; bj < 2; ++bj) {
                const int ch0 = u.pn * BM + 128 * bj + cpos0;
#pragma unroll
                for (int n = 0; n < 2; ++n) {
                    unsigned pk[4][2];
#pragma unroll
                    for (int eh = 0; eh < 2; ++eh) {
                        const int cpos = 128 * bj + cpos0 + 4 * n + 2 * eh; const int ch = ch0 + 4 * n + 2 * eh;
                        f32x2 halo[3];
#pragma unroll
                        for (int k = 1; k <= 3; ++k) { int hr = 3 + fr - k; hr = hr > 2 ? 2 : hr; const f32x2 hv = *(const PG8_LAS f32x2*)(xch + (sp * 3 + hr) * 256 + cpos);
                            halo[k - 1] = has_prev ? hv : (f32x2){0.f, 0.f}; }
                        const f32x2 w0 = *(const f32x2*)(cw + 0 * 4096 + ch), w1 = *(const f32x2*)(cw + 1 * 4096 + ch), w2 = *(const f32x2*)(cw + 2 * 4096 + ch),
                                    w3 = *(const f32x2*)(cw + 3 * 4096 + ch), bb = *(const f32x2*)(cb + ch);
#pragma unroll
                        for (int m = 0; m < 4; ++m) {
                            f32x2 o;
#pragma unroll
                            for (int e2 = 0; e2 < 2; ++e2) { const float cur = acc[ai][bj][m][n][2 * eh + e2], prv = acc[ai][bj][m > 0 ? m - 1 : 0][n][2 * eh + e2];
                                const float p1 = shift1<1>(cur, prv, halo[0][e2], m == 0), p2 = shift1<2>(cur, prv, halo[1][e2], m == 0), p3 = shift1<3>(cur, prv, halo[2][e2], m == 0);
                                o[e2] = bb[e2] + w3[e2] * cur + w2[e2] * p1 + w1[e2] * p2 + w0[e2] * p3; }
                            if (m == 0 && seg == 0 && fr < 3) *(f32x2*)(P + ((size_t)u.pm * 3 + fr) * NC + u.pn * BM + cpos) = o;
                            pk[m][eh] = cvt_pk_bf16(silu_f(o[0]), silu_f(o[1]));
                        }
                        asm volatile("" ::: "memory"); __builtin_amdgcn_sched_barrier(0);
                    }
#pragma unroll
                    for (int m = 0; m < 4; ++m) { u32x2 w; w.x = pk[m][0]; w.y = pk[m][1]; *(u32x2*)(XBC + (size_t)(row0 + ai * HALF + m * 16) * 4096 + ch0 + 4 * n) = w; }
                }
            }
        }
    }
};

struct EpiFFN {
    static constexpr bool PERM = true, AFTER_DRAIN = false;
    static constexpr int NC = 5632, F = 2816;
    bf16_t* G; float* P; float* UH; const float* cw; const float* cb; PG8_LAS float* xch;
    __device__ __forceinline__ void operator()(const f32x4 (&acc)[2][2][4][2], const Unit& u, int wr, int wc, int fr, int fq) const {
        asm volatile("" : "+v"(fr), "+v"(fq));
        const int row0 = u.pm * BM + wr * 64 + fr;
        const int cpos0 = 32 * wc + 8 * fq;
        if (fr >= 14) {
#pragma unroll
            for (int ai = 0; ai < 2; ++ai)
#pragma unroll
                for (int bj = 0; bj < 2; ++bj)
#pragma unroll
                    for (int n = 0; n < 2; ++n) *(PG8_LAS f32x4*)(xch + ((2 * ai + wr) * 2 + (fr - 14)) * 256 + 128 * bj + cpos0 + 4 * n) = acc[ai][bj][3][n];
            if (wr == 1) {
#pragma unroll
                for (int bj = 0; bj < 2; ++bj)
#pragma unroll
                    for (int n = 0; n < 2; ++n) *(f32x4*)(UH + ((size_t)u.pm * 2 + (fr - 14)) * NC + u.pn * BM + 128 * bj + cpos0 + 4 * n) = acc[1][bj][3][n];
            }
        }
        asm volatile("s_waitcnt lgkmcnt(0)" ::: "memory"); __builtin_amdgcn_s_barrier(); asm volatile("" ::: "memory");
        const int j0 = u.pn * 128 + cpos0;
#pragma unroll
        for (int ai = 0; ai < 2; ++ai) {
            const int seg = 2 * ai + wr; const bool has_prev = seg > 0; const int sp = has_prev ? seg - 1 : 0;
#pragma unroll
            for (int n = 0; n < 2; ++n) {
                unsigned pk[4][2];
#pragma unroll
                for (int eh = 0; eh < 2; ++eh) {
                    f32x2 og[2][4];
#pragma unroll
                    for (int bj = 0; bj < 2; ++bj) {
                        const int cpos = 128 * bj + cpos0 + 4 * n + 2 * eh;
                        f32x2 halo[2];
#pragma unroll
                        for (int k = 1; k <= 2; ++k) { int hr = 2 + fr - k; hr = hr > 1 ? 1 : hr; const f32x2 hv = *(const PG8_LAS f32x2*)(xch + (sp * 2 + hr) * 256 + cpos);
                            halo[k - 1] = has_prev ? hv : (f32x2){0.f, 0.f}; }
                        const int ch = bj * F + j0 + 4 * n + 2 * eh;
                        const f32x2 w0 = *(const f32x2*)(cw + 0 * NC + ch), w1 = *(const f32x2*)(cw + 1 * NC + ch), w2 = *(const f32x2*)(cw + 2 * NC + ch), bb = *(const f32x2*)(cb + ch);
#pragma unroll
                        for (int m = 0; m < 4; ++m) {
                            f32x2 o;
#pragma unroll
                            for (int e2 = 0; e2 < 2; ++e2) { const float cur = acc[ai][bj][m][n][2 * eh + e2], prv = acc[ai][bj][m > 0 ? m - 1 : 0][n][2 * eh + e2];
                                const float p1 = shift1<1>(cur, prv, halo[0][e2], m == 0), p2 = shift1<2>(cur, prv, halo[1][e2], m == 0);
                                o[e2] = bb[e2] + w2[e2] * cur + w1[e2] * p1 + w0[e2] * p2; }
                            if (m == 0 && seg == 0 && fr < 2) *(f32x2*)(P + ((size_t)u.pm * 2 + fr) * NC + u.pn * BM + cpos) = o;
                            og[bj][m] = o;
                        }
                    }
#pragma unroll
                    for (int m = 0; m < 4; ++m) pk[m][eh] = cvt_pk_bf16(silu_f(og[0][m][0]) * og[1][m][0], silu_f(og[0][m][1]) * og[1][m][1]);
                    asm volatile("" ::: "memory"); __builtin_amdgcn_sched_barrier(0);
                }
#pragma unroll
                for (int m = 0; m < 4; ++m) { u32x2 w; w.x = pk[m][0]; w.y = pk[m][1]; *(u32x2*)(G + (size_t)(row0 + ai * HALF + m * 16) * F + j0 + 4 * n) = w; }
            }
        }
    }
};
template <class Epi, class Sched, bool ALIGN_EPI = false, bool SP2 = false>
__device__ __forceinline__ void gemm_phase(PG8_LAS unsigned char* lds, const Gemm g, const Sched& S, const Epi& E) {
    int tid_ = threadIdx.x; asm volatile("" : "+v"(tid_));
    const int tid = tid_, wid = __builtin_amdgcn_readfirstlane(tid >> 6), lane = tid & 63, wr = wid >> 2, wc = wid & 3, fr = lane & 15, fq = lane >> 4;
    const int K = g.K, nt = K / BK;
    unsigned voffA[2], voffB[2];
#pragma unroll
    for (int i = 0; i < 2; ++i) { int R, C; stage_rc(tid * 16 + i * 8192, R, C); const int Rb = Epi::PERM ? ((R & ~31) + perm32(R & 31)) : R;
        voffA[i] = (unsigned)(R * K + C) * 2u; voffB[i] = (unsigned)(Rb * K + C) * 2u; }
    const size_t kstep = (size_t)(BK * 2);
    const size_t hstep = (size_t)HALF * K * 2;
    const size_t tstep = 2 * hstep;
    const unsigned ldsw = (unsigned)wid * 1024u;
    const int aoff = lds_byte(wr * 64 + fr, fq * 8), boff = lds_byte(wc * 32 + fr, fq * 8);
#define PG8_SA(b, h) (((b) * 2 + (h)) * HTB)
#define PG8_SB(b, h) ((4 + (b) * 2 + (h)) * HTB)
#define PG8_STAGE(bufoff, gbase, voff) do { _Pragma("unroll") for (int _i = 0; _i < 2; ++_i) \
        __builtin_amdgcn_global_load_lds((const unsigned*)((const char*)(gbase) + (voff)[_i]), (PG8_LAS unsigned*)(lds + (bufoff) + ldsw + _i * 8192), 16, 0, 0); } while (0)
#define PG8_LDA(dst, b, h) do { _Pragma("unroll") for (int m = 0; m < 4; ++m) _Pragma("unroll") for (int k = 0; k < 2; ++k) dst[m][k] = *(const PG8_LAS bf16x8*)(lds + PG8_SA(b, h) + aoff + m * 2048 + k * 1024); } while (0)
#define PG8_LDB(dst, b, h) do { _Pragma("unroll") for (int n = 0; n < 2; ++n) _Pragma("unroll") for (int k = 0; k < 2; ++k) dst[n][k] = *(const PG8_LAS bf16x8*)(lds + PG8_SB(b, h) + boff + n * 2048 + k * 1024); } while (0)
#define PG8_MMA(ai, bj, At, Bt) do { __builtin_amdgcn_s_setprio(1); _Pragma("unroll") for (int m = 0; m < 4; ++m) _Pragma("unroll") for (int n = 0; n < 2; ++n) _Pragma("unroll") for (int k = 0; k < 2; ++k) \
        acc[ai][bj][m][n] = __builtin_amdgcn_mfma_f32_16x16x32_bf16(Bt[n][k], At[m][k], acc[ai][bj][m][n], 0, 0, 0); __builtin_amdgcn_s_setprio(0); } while (0)
#define PG8_WAIT_V(n) asm volatile("s_waitcnt vmcnt(" #n ")" ::: "memory")
#define PG8_WAIT_L(n) asm volatile("s_waitcnt lgkmcnt(" #n ")" ::: "memory")
#define PG8_BAR __builtin_amdgcn_s_barrier()
#define PG8_SCHED __builtin_amdgcn_sched_barrier(0)
    Unit cur, nxt; int ui = 0;
    if (!S.next(0, cur)) return;
    f32x4 acc[2][2][4][2];
#pragma unroll
    for (int a = 0; a < 2; ++a)
#pragma unroll
        for (int b = 0; b < 2; ++b)
#pragma unroll
            for (int m = 0; m < 4; ++m)
#pragma unroll
                for (int n = 0; n < 2; ++n) acc[a][b][m][n] = (f32x4){0.f, 0.f, 0.f, 0.f};
    bf16x8 At[4][2], B0[2][2], B1[2][2];
    const char* cA = (const char*)g.A + (size_t)cur.pm * tstep; const char* cB = (const char*)g.Bt + (size_t)cur.pn * tstep;
    S.a_ready(cur);
    if constexpr (SP2) {
        PG8_STAGE(PG8_SB(0, 0), cB, voffB); PG8_STAGE(PG8_SB(0, 1), cB + hstep, voffB); PG8_STAGE(PG8_SA(0, 0), cA, voffA); PG8_STAGE(PG8_SA(0, 1), cA + hstep, voffA);
        if (wr == 1) PG8_BAR;
        PG8_WAIT_V(2); PG8_BAR;
        PG8_STAGE(PG8_SB(1, 0), cB + kstep, voffB); PG8_STAGE(PG8_SA(1, 0), cA + kstep, voffA); PG8_STAGE(PG8_SB(1, 1), cB + hstep + kstep, voffB);
        PG8_WAIT_V(6); PG8_BAR;
    } else {
        PG8_STAGE(PG8_SB(0, 0), cB, voffB); PG8_STAGE(PG8_SA(0, 0), cA, voffA); PG8_STAGE(PG8_SB(0, 1), cB + hstep, voffB); PG8_STAGE(PG8_SA(0, 1), cA + hstep, voffA);
        if (wr == 1) PG8_BAR;
        PG8_WAIT_V(4); PG8_BAR;
        PG8_STAGE(PG8_SB(1, 0), cB + kstep, voffB); PG8_STAGE(PG8_SA(1, 0), cA + kstep, voffA); PG8_STAGE(PG8_SB(1, 1), cB + hstep + kstep, voffB);
        PG8_WAIT_V(6); PG8_BAR;
    }
    for (;;) {
        const bool has_next = S.next(ui + 1, nxt);
        const char* nA = has_next ? (const char*)g.A + (size_t)nxt.pm * tstep : cA; const char* nB = has_next ? (const char*)g.Bt + (size_t)nxt.pn * tstep : cB;
        for (int t = 0; t < nt; t += 2) {
            const bool last = (t == nt - 2);
            const char* a1 = cA + (size_t)(t + 1) * kstep;
            const char* a2 = last ? nA : cA + (size_t)(t + 2) * kstep; const char* b2 = last ? nB : cB + (size_t)(t + 2) * kstep;
            const char* a3 = a2 + kstep; const char* b3 = b2 + kstep;
            if (last && has_next) S.a_ready(nxt);
            if constexpr (SP2) {
            PG8_LDB(B0, 0, 0); PG8_LDB(B1, 0, 1); PG8_SCHED; PG8_LDA(At, 0, 0); PG8_STAGE(PG8_SA(1, 1), a1 + hstep, voffA);
            PG8_WAIT_V(8); PG8_WAIT_L(0); PG8_BAR; PG8_MMA(0, 0, At, B0); PG8_MMA(0, 1, At, B1); PG8_BAR; PG8_SCHED;
            PG8_LDA(At, 0, 1); PG8_STAGE(PG8_SB(0, 0), b2, voffB); PG8_STAGE(PG8_SB(0, 1), b2 + hstep, voffB); PG8_STAGE(PG8_SA(0, 0), a2, voffA);
            PG8_WAIT_V(8); PG8_WAIT_L(0); PG8_BAR; PG8_MMA(1, 0, At, B0); PG8_MMA(1, 1, At, B1); PG8_BAR; PG8_SCHED;
            PG8_LDB(B0, 1, 0); PG8_LDB(B1, 1, 1); PG8_SCHED; PG8_LDA(At, 1, 0); PG8_STAGE(PG8_SA(0, 1), a2 + hstep, voffA);
            PG8_WAIT_V(8); PG8_WAIT_L(0); PG8_BAR; PG8_MMA(0, 0, At, B0); PG8_MMA(0, 1, At, B1); PG8_BAR; PG8_SCHED;
            PG8_LDA(At, 1, 1); PG8_STAGE(PG8_SB(1, 0), b3, voffB); PG8_STAGE(PG8_SB(1, 1), b3 + hstep, voffB); PG8_STAGE(PG8_SA(1, 0), a3, voffA);
            PG8_WAIT_V(8); PG8_WAIT_L(0); PG8_BAR; PG8_MMA(1, 0, At, B0); PG8_MMA(1, 1, At, B1); PG8_BAR; PG8_SCHED;
            } else {
            PG8_LDB(B0, 0, 0); PG8_SCHED; PG8_LDA(At, 0, 0); PG8_STAGE(PG8_SA(1, 1), a1 + hstep, voffA);
            PG8_WAIT_L(8); PG8_BAR; PG8_WAIT_L(0); PG8_MMA(0, 0, At, B0); PG8_BAR; PG8_SCHED;
            PG8_LDB(B1, 0, 1); PG8_STAGE(PG8_SB(0, 0), b2, voffB);
            PG8_BAR; PG8_WAIT_L(0); PG8_MMA(0, 1, At, B1); PG8_BAR;
            PG8_LDA(At, 0, 1); PG8_STAGE(PG8_SA(0, 0), a2, voffA);
            PG8_BAR; PG8_WAIT_L(0); PG8_MMA(1, 0, At, B0); PG8_BAR; PG8_SCHED;
            PG8_STAGE(PG8_SB(0, 1), b2 + hstep, voffB);
            PG8_WAIT_V(6); PG8_BAR; PG8_MMA(1, 1, At, B1); PG8_BAR;
            PG8_LDB(B0, 1, 0); PG8_SCHED; PG8_LDA(At, 1, 0); PG8_STAGE(PG8_SA(0, 1), a2 + hstep, voffA);
            PG8_WAIT_L(8); PG8_BAR; PG8_WAIT_L(0); PG8_MMA(0, 0, At, B0); PG8_BAR; PG8_SCHED;
            PG8_LDB(B1, 1, 1); PG8_STAGE(PG8_SB(1, 0), b3, voffB);
            PG8_BAR; PG8_WAIT_L(0); PG8_MMA(0, 1, At, B1); PG8_BAR;
            PG8_LDA(At, 1, 1); PG8_STAGE(PG8_SA(1, 0), a3, voffA);
            PG8_BAR; PG8_WAIT_L(0); PG8_MMA(1, 0, At, B0); PG8_BAR; PG8_SCHED;
            PG8_STAGE(PG8_SB(1, 1), b3 + hstep, voffB);
            PG8_WAIT_V(6); PG8_BAR; PG8_MMA(1, 1, At, B1); PG8_BAR;
            }
        }
        if constexpr (ALIGN_EPI) { if (wr == 0) PG8_BAR; }
        if constexpr (!Epi::AFTER_DRAIN) { E(acc, cur, wr, wc, fr, fq); S.done(cur); }
        if (!has_next) break;
#pragma unroll
        for (int a = 0; a < 2; ++a)
#pragma unroll
            for (int b = 0; b < 2; ++b)
#pragma unroll
                for (int m = 0; m < 4; ++m)
#pragma unroll
                    for (int n = 0; n < 2; ++n) acc[a][b][m][n] = (f32x4){0.f, 0.f, 0.f, 0.f};
        cur = nxt; cA = nA; cB = nB; ++ui;
        if constexpr (ALIGN_EPI) { if (wr == 1) PG8_BAR; }
    }
    PG8_WAIT_V(0);
    if constexpr (!ALIGN_EPI) { if (wr == 0) PG8_BAR; }
    PG8_BAR;
    if constexpr (Epi::AFTER_DRAIN) { E.fused(acc, cur, wr, wc, fr, fq, lds, wid, lane); S.done(cur); }
#undef PG8_SA
#undef PG8_SB
#undef PG8_STAGE
#undef PG8_LDA
#undef PG8_LDB
#undef PG8_MMA
#undef PG8_WAIT_V
#undef PG8_WAIT_L
#undef PG8_BAR
#undef PG8_SCHED
}
}

#define LAS __attribute__((address_space(3)))
typedef unsigned short bf16;
typedef short bf16x8 __attribute__((ext_vector_type(8)));
typedef short s16x4 __attribute__((ext_vector_type(4)));
typedef float f32x4 __attribute__((ext_vector_type(4)));
typedef unsigned u32x4 __attribute__((ext_vector_type(4)));
typedef unsigned u32x2 __attribute__((ext_vector_type(2)));
#define MFMA16(a, b, c) __builtin_amdgcn_mfma_f32_16x16x32_bf16((a), (b), (c), 0, 0, 0)

constexpr int T = 32768, D = 1024, SEQ = 8192, NTHR = 512;
constexpr int LDS_BYTES = 147456, XCH_OFF = 131072;
constexpr size_t MiB = 1u << 20;
constexpr size_t WS_W = 0;
constexpr size_t W_IN = 0, W_SOUT = W_IN + (size_t)6400 * 1024, W_FIN0 = W_SOUT + (size_t)1024 * 2048, W_FIN1 = W_FIN0 + (size_t)5632 * 1024,
                 W_FOUT0 = W_FIN1 + (size_t)5632 * 1024, W_FOUT1 = W_FOUT0 + (size_t)1024 * 2816, W_K = W_FOUT1 + (size_t)1024 * 2816, W_V = W_K + 1048576, W_Q = W_V + 1048576,
                 W_O = W_Q + 1048576, W_END = W_O + 1048576;
static_assert(W_END * 2 <= 58 * MiB, "weights fit");
constexpr size_t WS_MODS = 58 * MiB;
constexpr size_t WS_SUMSQ = 59 * MiB;
constexpr size_t WS_FLAGS = 60 * MiB;
constexpr size_t WS_X = 64 * MiB;
constexpr size_t WS_BIG = 192 * MiB;
constexpr size_t WS_END = 448 * MiB;
constexpr int MOD_L = 6144, MOD_KV = 12288, MOD_FIN = 14336, MOD_N = 16384;

struct Params { const float* in[28]; float* out; unsigned char* ws; };

__device__ __forceinline__ float bf2f(unsigned u) { return __uint_as_float(u << 16); }
__device__ __forceinline__ unsigned f2bf(float f) { unsigned u = __float_as_uint(f); return (u + 0x7fffu + ((u >> 16) & 1u)) >> 16; }
__device__ __forceinline__ unsigned pk2(float lo, float hi) { return f2bf(lo) | (f2bf(hi) << 16); }
__device__ __forceinline__ float wave_sum(float v) {
#pragma unroll
    for (int o = 1; o < 64; o <<= 1) v += __shfl_xor(v, o);
    return v;
}
using pg8::silu_f; using pg8::softplus_f;

__device__ __forceinline__ void p0_item(const float* W, int K, int Nsrc, bf16* WT, int dst_n0, int src_n0, int k0, LAS float* scr, int lane) {
    const int c = lane & 7;
    if (src_n0 < 0) {
#pragma unroll
        for (int j = 0; j < 4; ++j) { const int n = (lane >> 3) + 8 * j; *(u32x4*)(WT + (size_t)(dst_n0 + n) * K + k0 + 8 * c) = (u32x4){0u, 0u, 0u, 0u}; }
        return;
    }
#pragma unroll 8
    for (int i = 0; i < 32; ++i) { const int kk = 2 * i + (lane >> 5); scr[kk * 33 + (lane & 31)] = W[(size_t)(k0 + kk) * Nsrc + src_n0 + (lane & 31)]; }
    asm volatile("s_waitcnt lgkmcnt(0)" ::: "memory");
#pragma unroll
    for (int j = 0; j < 4; ++j) { const int n = (lane >> 3) + 8 * j; const LAS float* s = scr + (8 * c) * 33 + n;
        u32x4 o; o.x = pk2(s[0 * 33], s[1 * 33]); o.y = pk2(s[2 * 33], s[3 * 33]); o.z = pk2(s[4 * 33], s[5 * 33]); o.w = pk2(s[6 * 33], s[7 * 33]);
        *(u32x4*)(WT + (size_t)(dst_n0 + n) * K + k0 + 8 * c) = o; }
    asm volatile("s_waitcnt lgkmcnt(0)" ::: "memory");
}
__device__ __forceinline__ void p0_phase(const Params& p, LAS unsigned char* L) {
    const int tid = threadIdx.x, lane = tid & 63, wave = __builtin_amdgcn_readfirstlane(tid >> 6);
    bf16* WB = (bf16*)(p.ws + WS_W);
    float* MODS = (float*)(p.ws + WS_MODS); float* SUMSQ = (float*)(p.ws + WS_SUMSQ);
    for (int i = blockIdx.x * NTHR + tid; i < T; i += gridDim.x * NTHR) SUMSQ[i] = 0.f;
    if (blockIdx.x == 0 && tid < 64) ((unsigned*)(p.ws + WS_FLAGS))[tid] = 0u;
    LAS float* cs = (LAS float*)L; LAS float* part = (LAS float*)(L + 16384);
    for (int i = tid; i < 4096; i += NTHR) cs[i] = silu_f(p.in[1][i]);
    __syncthreads();
    for (int jb = blockIdx.x; jb < MOD_N / 64; jb += gridDim.x) {
        const int j = jb * 64 + lane; const float* Wsrc; const float* bsrc; int stride, jj;
        if (j < MOD_KV) { const int l = j / MOD_L; jj = j - l * MOD_L; Wsrc = p.in[2] + (size_t)l * D * MOD_L; bsrc = p.in[3] + l * MOD_L; stride = MOD_L; }
        else if (j < MOD_FIN) { jj = j - MOD_KV; Wsrc = p.in[14]; bsrc = p.in[15]; stride = 2048; }
        else { jj = j - MOD_FIN; Wsrc = p.in[25]; bsrc = p.in[26]; stride = 2048; }
        float a0 = 0.f, a1 = 0.f, a2 = 0.f, a3 = 0.f;
#pragma unroll 8
        for (int k = wave * 128; k < wave * 128 + 128; ++k) { const float wv = Wsrc[(size_t)k * stride + jj]; a0 += cs[k] * wv; a1 += cs[1024 + k] * wv; a2 += cs[2048 + k] * wv; a3 += cs[3072 + k] * wv; }
        part[(wave * 4 + 0) * 64 + lane] = a0; part[(wave * 4 + 1) * 64 + lane] = a1; part[(wave * 4 + 2) * 64 + lane] = a2; part[(wave * 4 + 3) * 64 + lane] = a3;
        __syncthreads();
        if (tid < 256) { const int b = tid >> 6; float s = 0.f;
#pragma unroll
            for (int w = 0; w < 8; ++w) s += part[(w * 4 + b) * 64 + lane];
            MODS[(size_t)b * MOD_N + j] = s + bsrc[jj]; }
        __syncthreads();
    }
    LAS float* scr = (LAS float*)(L + wave * 16384);
    const int gw = blockIdx.x * 8 + wave, NGW = gridDim.x * 8;
    constexpr int NI0 = 16 * 200, NI1 = 32 * 32, NI2 = 16 * 176, NI3 = 44 * 32, NI4 = 16 * 32;
    constexpr int NITEMS = NI0 + NI1 + 2 * NI2 + 2 * NI3 + 4 * NI4;
    for (int it = gw; it < NITEMS; it += NGW) {
        int r = it;
        if (r < NI0) { const int kb = r / 200, nb = r % 200; const int dn = nb * 32; const int sn = dn < 2048 ? dn : dn < 2080 ? 6144 + (dn - 2048) : dn < 2304 ? -1 : 2048 + (dn - 2304); p0_item(p.in[6], 1024, 6176, WB + W_IN, dn, sn, kb * 64, scr, lane); continue; } r -= NI0;
        if (r < NI1) { const int kb = r / 32, nb = r % 32; p0_item(p.in[13], 2048, 1024, WB + W_SOUT, nb * 32, nb * 32, kb * 64, scr, lane); continue; } r -= NI1;
        if (r < 2 * NI2) { const int l = r / NI2; r -= l * NI2; const int kb = r / 176, nb = r % 176; const int dn = nb * 32; const int sn = (dn >> 8) * 128 + (dn & 127) + ((dn & 255) >= 128 ? 2816 : 0);
            p0_item(p.in[21] + (size_t)l * 1024 * 5632, 1024, 5632, WB + (l ? W_FIN1 : W_FIN0), dn, sn, kb * 64, scr, lane); continue; } r -= 2 * NI2;
        if (r < 2 * NI3) { const int l = r / NI3; r -= l * NI3; const int kb = r / 32, nb = r % 32;
            p0_item(p.in[24] + (size_t)l * 2816 * 1024, 2816, 1024, WB + (l ? W_FOUT1 : W_FOUT0), nb * 32, nb * 32, kb * 64, scr, lane); continue; } r -= 2 * NI3;
        { const int q = r / NI4; r -= q * NI4; const int kb = r / 32, nb = r % 32; const float* src = q == 0 ? p.in[17] : q == 1 ? p.in[18] : q == 2 ? p.in[19] : p.in[20];
            bf16* dst = WB + (q == 0 ? W_K : q == 1 ? W_V : q == 2 ? W_Q : W_O);
            p0_item(src, 1024, 1024, dst, nb * 32, nb * 32, kb * 64, scr, lane); }
    }
}

template <int NOUT, bool F32OUT>
__device__ __forceinline__ void norm_phase(const float* X, const float* g0, const float* mod0, void* out0, const float* g1, const float* mod1, void* out1) {
    int tid_ = threadIdx.x; asm volatile("" : "+v"(tid_));
    const int tid = tid_, lane = tid & 63, wave = tid >> 6;
    const int gw = blockIdx.x * 8 + wave, NGW = gridDim.x * 8;
    for (int row = gw; row < T; row += NGW) {
        const int b = row >> 13;
        const f32x4* xr = (const f32x4*)(X + (size_t)row * D) + lane;
        f32x4 v[4]; float s = 0.f;
#pragma unroll
        for (int j = 0; j < 4; ++j) { v[j] = xr[64 * j]; s += (v[j].x * v[j].x + v[j].y * v[j].y) + (v[j].z * v[j].z + v[j].w * v[j].w); }
        const float rstd = rsqrtf(wave_sum(s) * (1.f / D) + 1e-6f);
#pragma unroll
        for (int o = 0; o < NOUT; ++o) {
            const float* g = o ? g1 : g0; const float* md = (o ? mod1 : mod0) + (size_t)b * MOD_N; void* out = o ? out1 : out0;
#pragma unroll
            for (int j = 0; j < 4; ++j) { const int col = 4 * lane + 256 * j;
                const f32x4 gv = *(const f32x4*)(g + col), sh = *(const f32x4*)(md + col), sc = *(const f32x4*)(md + 1024 + col);
                const f32x4 y = v[j] * rstd * gv * (sc + 1.0f) + sh;
                if (F32OUT) *(f32x4*)((float*)out + (size_t)row * D + col) = y;
                else { u32x2 w; w.x = pk2(y.x, y.y); w.y = pk2(y.z, y.w); *(u32x2*)((bf16*)out + (size_t)row * D + col) = w; } }
        }
    }
}

__device__ __forceinline__ void fixup_mamba(const float* P, const float* UH, const float* cw, const float* cb, bf16* XBC) {
    const int total = 128 * 3 * 4096;
    for (int i = blockIdx.x * NTHR + threadIdx.x; i < total; i += gridDim.x * NTHR) {
        const int ch = i & 4095, r = (i >> 12) % 3, pm = i / (3 * 4096); const int c = ch;
        float v = P[((size_t)pm * 3 + r) * 4096 + c];
        if (pm & 31) { for (int k = r + 1; k <= 3; ++k) v += cw[(3 - k) * 4096 + ch] * UH[((size_t)(pm - 1) * 3 + (3 + r - k)) * 4096 + c]; }
        XBC[(size_t)(pm * 256 + r) * 4096 + ch] = (bf16)f2bf(silu_f(v));
    }
}
__device__ __forceinline__ void fixup_ffn(const float* P, const float* UH, const float* cw, const float* cb, bf16* G) {
    const int total = 128 * 2 * 2816;
    for (int i = blockIdx.x * NTHR + threadIdx.x; i < total; i += gridDim.x * NTHR) {
        const int j = i % 2816, r = (i / 2816) & 1, pm = i / (2 * 2816); const int cg_ = (j >> 7) * 256 + (j & 127), cv_ = cg_ + 128;
        float g = P[((size_t)pm * 2 + r) * 5632 + cg_], v = P[((size_t)pm * 2 + r) * 5632 + cv_];
        if (pm & 31) { for (int k = r + 1; k <= 2; ++k) { const size_t ro = ((size_t)(pm - 1) * 2 + (2 + r - k)) * 5632;
            g += cw[(2 - k) * 5632 + j] * UH[ro + cg_]; v += cw[(2 - k) * 5632 + 2816 + j] * UH[ro + cv_]; } }
        G[(size_t)(pm * 256 + r) * 2816 + j] = (bf16)f2bf(silu_f(g) * v);
    }
}

constexpr int SSD_CS = 0, SSD_BS = 34816, SSD_XT = 69632, SSD_XDT = 78336, SSD_HS0 = 87040, SSD_HS1 = 95744, SSD_ACS = 104448, SSD_WSCR = 104960;
__device__ __forceinline__ void ssd_phase(const bf16* XBC, bf16* Zb, const float* DT, const float* a_log, const float* d_skip, const float* normg, float* SUMSQ, LAS unsigned char* L) {
    int tid_ = threadIdx.x; asm volatile("" : "+v"(tid_));
    const int tid = tid_, lane = tid & 63, w = __builtin_amdgcn_readfirstlane(tid >> 6), r16 = lane & 15, quad = lane >> 4;
    LAS bf16* Cs = (LAS bf16*)(L + SSD_CS); LAS bf16* Bs = (LAS bf16*)(L + SSD_BS); LAS bf16* XTs = (LAS bf16*)(L + SSD_XT); LAS bf16* XDs = (LAS bf16*)(L + SSD_XDT);
    LAS float* acs_s = (LAS float*)(L + SSD_ACS);
    LAS bf16* Wx = (LAS bf16*)(L + SSD_WSCR + w * 3840); LAS bf16* Wz = Wx + 640; LAS bf16* Wy = Wx + 1280;
    for (int unit = blockIdx.x; unit < 256; unit += gridDim.x) {
        const int b = unit >> 6, h = (unit >> 1) & 31, ph = unit & 1, g = h >> 2;
        const float A = -__expf(a_log[h]), Dh = d_skip[h];
        const int xcol = h * 64 + ph * 32;
        for (int i = tid; i < 8704 / 4; i += NTHR) ((LAS unsigned*)(L + SSD_HS0))[i] = 0u;
        f32x4 Hst[2]; Hst[0] = (f32x4){0.f, 0.f, 0.f, 0.f}; Hst[1] = (f32x4){0.f, 0.f, 0.f, 0.f};
        int hb = 0;
        for (int c = 0; c < 64; ++c) {
            const size_t tok0 = (size_t)b * SEQ + (size_t)c * 128;
            { const int row = tid >> 4, sg = tid & 15;
#pragma unroll
                for (int i = 0; i < 4; ++i) { const int l = row + 32 * i; const bf16* src = XBC + (tok0 + l) * 4096 + g * 128 + sg * 8;
                    const u32x4 cv = *(const u32x4*)(src + 3072), bv = *(const u32x4*)(src + 2048);
                    *(LAS u32x4*)(Cs + l * 136 + sg * 8) = cv; *(LAS u32x4*)(Bs + l * 136 + sg * 8) = bv; } }
            const float dt0 = DT[(tok0 + 2 * lane) * 32 + h], dt1 = DT[(tok0 + 2 * lane + 1) * 32 + h];
            const float a1 = dt1 * A; float s = dt0 * A + a1;
#pragma unroll
            for (int o = 1; o < 64; o <<= 1) { const float t = __shfl_up(s, o); if (lane >= o) s += t; }
            const float acs1 = s, acs0 = s - a1;
            if (w == 0) { acs_s[2 * lane] = acs0; acs_s[2 * lane + 1] = acs1; }
            const float acs_last = __shfl(acs1, 63);
            { const int lr = lane >> 2, part = lane & 3, l = 16 * w + lr;
                const u32x4 xv = *(const u32x4*)(XBC + (tok0 + l) * 4096 + xcol + part * 8);
                const u32x4 zv = *(const u32x4*)(Zb + (tok0 + l) * 2048 + xcol + part * 8);
                const int sl = l >> 1; const float d0 = __shfl(dt0, sl), d1 = __shfl(dt1, sl), c0 = __shfl(acs0, sl), c1 = __shfl(acs1, sl);
                const float dtl = (l & 1) ? d1 : d0, acl = (l & 1) ? c1 : c0; const float dec = __expf(acs_last - acl);
                *(LAS u32x4*)(Wx + lr * 40 + part * 8) = xv; *(LAS u32x4*)(Wz + lr * 40 + part * 8) = zv;
#pragma unroll
                for (int e = 0; e < 8; ++e) { const unsigned xb = (xv[e >> 1] >> (16 * (e & 1))) & 0xffffu; const float xd = bf2f(xb) * dtl;
                    XTs[(part * 8 + e) * 136 + l] = (bf16)f2bf(xd); XDs[(part * 8 + e) * 136 + l] = (bf16)f2bf(xd * dec); } }
            __syncthreads();
            bf16x8 cf[4];
#pragma unroll
            for (int ks = 0; ks < 4; ++ks) cf[ks] = *(const LAS bf16x8*)(Cs + (16 * w + r16) * 136 + ks * 32 + quad * 8);
            const float acs_l = acs_s[16 * w + r16];
            f32x4 Yd[2], Yo[2]; Yd[0] = Yd[1] = Yo[0] = Yo[1] = (f32x4){0.f, 0.f, 0.f, 0.f};
            for (int t = 0; t <= (w >> 1); ++t) {
                f32x4 mm[2];
#pragma unroll
                for (int hf = 0; hf < 2; ++hf) { const int st = 2 * t + hf; mm[hf] = (f32x4){0.f, 0.f, 0.f, 0.f};
                    if (st <= w) { f32x4 acc = (f32x4){0.f, 0.f, 0.f, 0.f};
#pragma unroll
                        for (int ks = 0; ks < 4; ++ks) { const bf16x8 af = *(const LAS bf16x8*)(Bs + (16 * st + r16) * 136 + ks * 32 + quad * 8); acc = MFMA16(af, cf[ks], acc); }
#pragma unroll
                        for (int j = 0; j < 4; ++j) { const int sa = 16 * st + 4 * quad + j; const float v = acc[j] * __expf(acs_l - acs_s[sa]); mm[hf][j] = (sa > 16 * w + r16) ? 0.f : v; } } }
                u32x4 mp; mp.x = pk2(mm[0][0], mm[0][1]); mp.y = pk2(mm[0][2], mm[0][3]); mp.z = pk2(mm[1][0], mm[1][1]); mp.w = pk2(mm[1][2], mm[1][3]);
                const bf16x8 mf = __builtin_bit_cast(bf16x8, mp);
#pragma unroll
                for (int pt = 0; pt < 2; ++pt) { const LAS bf16* xp = XTs + (16 * pt + r16) * 136 + 32 * t + 4 * quad;
                    const u32x2 lo = *(const LAS u32x2*)xp, hi = *(const LAS u32x2*)(xp + 16);
                    const bf16x8 xf = __builtin_bit_cast(bf16x8, ((u32x4){lo.x, lo.y, hi.x, hi.y}));
                    Yd[pt] = MFMA16(mf, xf, Yd[pt]); }
            }
            { const LAS bf16* Hc = (const LAS bf16*)(L + (hb ? SSD_HS1 : SSD_HS0));
#pragma unroll
                for (int pt = 0; pt < 2; ++pt)
#pragma unroll
                    for (int ks = 0; ks < 4; ++ks) { const bf16x8 hf = *(const LAS bf16x8*)(Hc + (16 * pt + r16) * 136 + ks * 32 + quad * 8); Yo[pt] = MFMA16(cf[ks], hf, Yo[pt]); } }
            float ssq[4] = {0.f, 0.f, 0.f, 0.f};
#pragma unroll
            for (int j = 0; j < 4; ++j) { const int lrow = 4 * quad + j; const float el = __expf(acs_s[16 * w + lrow]);
#pragma unroll
                for (int pt = 0; pt < 2; ++pt) { const int pcol = 16 * pt + r16;
                    float y = Yd[pt][j] + el * Yo[pt][j];
                    y += Dh * bf2f(Wx[lrow * 40 + pcol]);
                    const float gz = y * silu_f(bf2f(Wz[lrow * 40 + pcol])); ssq[j] += gz * gz;
                    Wy[lrow * 40 + pcol] = (bf16)f2bf(gz * normg[xcol + pcol]); } }
#pragma unroll
            for (int j = 0; j < 4; ++j) { float v = ssq[j]; v += __shfl_xor(v, 1); v += __shfl_xor(v, 2); v += __shfl_xor(v, 4); v += __shfl_xor(v, 8);
                if (r16 == 0) atomicAdd(SUMSQ + tok0 + 16 * w + 4 * quad + j, v); }
            asm volatile("s_waitcnt lgkmcnt(0)" ::: "memory");
            { const int lr = lane >> 2, part = lane & 3; const u32x4 yv = *(const LAS u32x4*)(Wy + lr * 40 + part * 8);
                *(u32x4*)(Zb + (tok0 + 16 * w + lr) * 2048 + xcol + part * 8) = yv; }
            f32x4 a4[2]; a4[0] = a4[1] = (f32x4){0.f, 0.f, 0.f, 0.f};
#pragma unroll
            for (int ks = 0; ks < 4; ++ks) { bf16x8 bfr;
#pragma unroll
                for (int j = 0; j < 8; ++j) bfr[j] = (short)Bs[(ks * 32 + quad * 8 + j) * 136 + 16 * w + r16];
#pragma unroll
                for (int pt = 0; pt < 2; ++pt) { const bf16x8 af = *(const LAS bf16x8*)(XDs + (16 * pt + r16) * 136 + ks * 32 + quad * 8); a4[pt] = MFMA16(af, bfr, a4[pt]); } }
            const float cd = __expf(acs_last);
            { LAS bf16* Hn = (LAS bf16*)(L + (hb ? SSD_HS0 : SSD_HS1));
#pragma unroll
                for (int pt = 0; pt < 2; ++pt)
#pragma unroll
                    for (int j = 0; j < 4; ++j) { const float hv = Hst[pt][j] * cd + a4[pt][j]; Hst[pt][j] = hv; Hn[(16 * pt + 4 * quad + j) * 136 + 16 * w + r16] = (bf16)f2bf(hv); } }
            hb ^= 1;
            __syncthreads();
        }
    }
}

constexpr int AT_KS = 0, AT_VS = 18432, AT_SMAX = 35840;
__device__ __forceinline__ void attn_phase(bf16* QO, const bf16* Kb, const bf16* VT, LAS unsigned char* L) {
    int tid_ = threadIdx.x; asm volatile("" : "+v"(tid_));
    const int tid = tid_, lane = tid & 63, w = __builtin_amdgcn_readfirstlane(tid >> 6), r16 = lane & 15, quad = lane >> 4;
    LAS bf16* Ks = (LAS bf16*)(L + AT_KS); LAS bf16* Vs = (LAS bf16*)(L + AT_VS); LAS float* smax_s = (LAS float*)(L + AT_SMAX);
    for (int unit = blockIdx.x; unit < 4096; unit += gridDim.x) {
        const int bh = unit & 63, qb = 63 - (unit >> 6), b = bh >> 4, h = bh & 15;
        const size_t rowq = (size_t)b * SEQ + qb * 128 + 16 * w;
        bf16x8 qf[2];
#pragma unroll
        for (int ks = 0; ks < 2; ++ks) qf[ks] = *(const bf16x8*)(QO + (rowq + r16) * 1024 + h * 64 + ks * 32 + quad * 8);
        f32x4 O[4]; O[0] = O[1] = O[2] = O[3] = (f32x4){0.f, 0.f, 0.f, 0.f};
        float suffix = 0.f, wsm = 0.f;
        const int q_rel = 16 * w + r16;
        for (int kb = qb; kb >= 0; --kb) {
            { const int s = tid >> 2, part = tid & 3; const bf16* src = Kb + ((size_t)b * SEQ + kb * 128 + s) * 1024 + h * 64 + part * 16;
                const u32x4 k0 = *(const u32x4*)src, k1 = *(const u32x4*)(src + 8);
                *(LAS u32x4*)(Ks + s * 72 + part * 16) = k0; *(LAS u32x4*)(Ks + s * 72 + part * 16 + 8) = k1;
                const int d = tid >> 3, p8 = tid & 7; const bf16* vs = VT + (size_t)(h * 64 + d) * T + (size_t)b * SEQ + kb * 128 + p8 * 16;
                const u32x4 v0 = *(const u32x4*)vs, v1 = *(const u32x4*)(vs + 8);
                *(LAS u32x4*)(Vs + d * 136 + p8 * 16) = v0; *(LAS u32x4*)(Vs + d * 136 + p8 * 16 + 8) = v1; }
            __syncthreads();
            if (wsm > -110.f) {
                const bool diag = (kb == qb);
                f32x4 S[8], Lg[8];
#pragma unroll
                for (int kt = 0; kt < 8; ++kt) { S[kt] = (f32x4){0.f, 0.f, 0.f, 0.f};
#pragma unroll
                    for (int ks = 0; ks < 2; ++ks) { const bf16x8 kf = *(const LAS bf16x8*)(Ks + (16 * kt + r16) * 72 + ks * 32 + quad * 8); S[kt] = MFMA16(kf, qf[ks], S[kt]); } }
#pragma unroll
                for (int kt = 0; kt < 8; ++kt) {
#pragma unroll
                    for (int j = 0; j < 4; ++j) { const float z = S[kt][j]; const bool live = !diag || (16 * kt + 4 * quad + j < q_rel);
                        Lg[kt][j] = live ? -softplus_f(z) : 0.f; }
                    Lg[kt][2] += Lg[kt][3]; Lg[kt][1] += Lg[kt][2]; Lg[kt][0] += Lg[kt][1];
                }
                float tail = 0.f;
#pragma unroll
                for (int kt = 7; kt >= 0; --kt) { const float a = Lg[kt][0]; const float bq = __shfl_xor(a, 16), cq = __shfl_xor(a, 32), dq = __shfl_xor(bq, 32);
                    const float E = quad == 0 ? (bq + cq + dq) : quad == 1 ? (cq + dq) : quad == 2 ? bq : 0.f;
                    const float add = E + tail;
#pragma unroll
                    for (int j = 0; j < 4; ++j) Lg[kt][j] += add;
                    tail += (a + bq) + (cq + dq); }
#pragma unroll
                for (int kt = 0; kt < 8; ++kt)
#pragma unroll
                    for (int j = 0; j < 4; ++j) { const bool live = !diag || (16 * kt + 4 * quad + j < q_rel);
                        const float lw = S[kt][j] + Lg[kt][j] + suffix; S[kt][j] = live ? __expf(lw) : 0.f; }
                suffix += tail;
#pragma unroll
                for (int t = 0; t < 4; ++t) { u32x4 wp; wp.x = pk2(S[2 * t][0], S[2 * t][1]); wp.y = pk2(S[2 * t][2], S[2 * t][3]); wp.z = pk2(S[2 * t + 1][0], S[2 * t + 1][1]); wp.w = pk2(S[2 * t + 1][2], S[2 * t + 1][3]);
                    const bf16x8 wf = __builtin_bit_cast(bf16x8, wp);
#pragma unroll
                    for (int dt = 0; dt < 4; ++dt) { const LAS bf16* vp = Vs + (16 * dt + r16) * 136 + 32 * t + 4 * quad;
                        const u32x2 lo = *(const LAS u32x2*)vp, hi = *(const LAS u32x2*)(vp + 16);
                        const bf16x8 vf = __builtin_bit_cast(bf16x8, ((u32x4){lo.x, lo.y, hi.x, hi.y}));
                        O[dt] = MFMA16(wf, vf, O[dt]); } }
                float sm = suffix; sm = fmaxf(sm, __shfl_xor(sm, 1)); sm = fmaxf(sm, __shfl_xor(sm, 2)); sm = fmaxf(sm, __shfl_xor(sm, 4)); sm = fmaxf(sm, __shfl_xor(sm, 8));
                wsm = sm;
            }
            if (lane == 0) smax_s[w] = wsm;
            __syncthreads();
            float mall = smax_s[0];
#pragma unroll
            for (int i = 1; i < 8; ++i) mall = fmaxf(mall, smax_s[i]);
            if (mall < -110.f) break;
        }
#pragma unroll
        for (int dt = 0; dt < 4; ++dt)
#pragma unroll
            for (int j = 0; j < 4; ++j) QO[(rowq + 4 * quad + j) * 1024 + h * 64 + 16 * dt + r16] = (bf16)f2bf(O[dt][j]);
    }
}

__global__ void __launch_bounds__(NTHR, 2) yoco_fwd(Params p) {
    extern __shared__ __attribute__((aligned(16))) unsigned char lds[];
    LAS unsigned char* L = (LAS unsigned char*)lds;
    cg::grid_group grid = cg::this_grid();
    unsigned char* ws = p.ws;
    bf16* WB = (bf16*)(ws + WS_W);
    float* MODS = (float*)(ws + WS_MODS); float* SUMSQ = (float*)(ws + WS_SUMSQ);
    float* X = (float*)(ws + WS_X);
    bf16* H0 = (bf16*)(ws + WS_X); float* DTb = (float*)(ws + WS_X + 64 * MiB); float* P0b = (float*)(ws + WS_X + 68 * MiB); float* UH0 = (float*)(ws + WS_X + 80 * MiB);
    bf16* XBC = (bf16*)(ws + WS_BIG); bf16* Gb = (bf16*)(ws + WS_BIG); bf16* H = (bf16*)(ws + WS_BIG + 176 * MiB);
    float* P1b = (float*)(ws + WS_BIG + 240 * MiB); float* UH1 = (float*)(ws + WS_BIG + 248 * MiB);
    bf16* HK = (bf16*)(ws + WS_BIG); bf16* QO = (bf16*)(ws + WS_BIG + 64 * MiB);
    bf16* Zb = (bf16*)p.out; bf16* Kb = (bf16*)p.out; bf16* VT = (bf16*)((unsigned char*)p.out + 64 * MiB);
    LAS float* xch = (LAS float*)(L + XCH_OFF);
    const int G_ = gridDim.x, c_ = blockIdx.x;
    using pg8::Gemm; using pg8::StaticOrder;

#ifndef PHM
#define PHM 0xffff
#endif
#define EN(x) constexpr ((PHM >> (x)) & 1)
    if EN(0) p0_phase(p, L);
    grid.sync();
    if EN(1) norm_phase<1, false>(p.in[0], p.in[4], MODS + 0, H0, nullptr, nullptr, nullptr);
    grid.sync();
    if EN(2) {
        Gemm g{H0, WB + W_IN, T, 2304, 1024}; StaticOrder S; S.init(T, 2304, G_, c_);
        pg8::EpiZdt E{Zb, DTb, p.in[9]};
        pg8::gemm_phase<pg8::EpiZdt, StaticOrder, true, true>(L, g, S, E);
    }
    if EN(2) {
        Gemm g{H0, WB + W_IN + (size_t)2304 * 1024, T, 4096, 1024}; StaticOrder S; S.init(T, 4096, G_, c_);
        pg8::EpiMamba E{XBC, P0b, UH0, p.in[7], p.in[8], xch};
        pg8::gemm_phase<pg8::EpiMamba, StaticOrder, true, true>(L, g, S, E);
    }
    grid.sync();
    if EN(3) fixup_mamba(P0b, UH0, p.in[7], p.in[8], XBC);
    grid.sync();
    if EN(4) ssd_phase(XBC, Zb, DTb, p.in[10], p.in[11], p.in[12], SUMSQ, L);
    grid.sync();
    if EN(5) {
        Gemm g{Zb, WB + W_SOUT, T, 1024, 2048}; StaticOrder S; S.init(T, 1024, G_, c_);
        pg8::EpiRes E{p.in[0], X, MODS + 2048, SUMSQ};
        pg8::gemm_phase<pg8::EpiRes, StaticOrder, true, true>(L, g, S, E);
    }
    grid.sync();
    {
        const float* md = MODS;
        norm_phase<1, false>(X, p.in[5] + 0, md + 3072, H, nullptr, nullptr, nullptr);
        grid.sync();
        if EN(9) { Gemm g{H, WB + (W_FIN0), T, 5632, 1024}; StaticOrder S; S.init(T, 5632, G_, c_);
          pg8::EpiFFN E{Gb, P1b, UH1, p.in[22] + 0, p.in[23] + 0, xch};
          pg8::gemm_phase<pg8::EpiFFN, StaticOrder, true, true>(L, g, S, E); }
        grid.sync();
        if EN(10) fixup_ffn(P1b, UH1, p.in[22] + 0, p.in[23] + 0, Gb);
        grid.sync();
        if EN(11) { Gemm g{Gb, WB + (W_FOUT0), T, 1024, 2816}; StaticOrder S; S.init(T, 1024, G_, c_); pg8::EpiRes E{X, X, md + 5120, nullptr};
          pg8::gemm_phase<pg8::EpiRes, StaticOrder, true, true>(L, g, S, E); }
        grid.sync();
    }
    {
        const float* md = MODS + MOD_L;
            norm_phase<2, false>(X, p.in[16], MODS + MOD_KV, HK, p.in[4] + 1024, md + 0, H);
            grid.sync();
            if EN(6) { Gemm g{HK, WB + W_K, T, 1024, 1024}; StaticOrder S; S.init(T, 1024, G_, c_); pg8::EpiStore E{Kb, 1024, 1.0f};
              pg8::gemm_phase<pg8::EpiStore, StaticOrder, true, true>(L, g, S, E); }
            if EN(6) { Gemm g{WB + W_V, HK, 1024, T, 1024}; StaticOrder S; S.init(1024, T, G_, c_); pg8::EpiStore E{VT, T, 1.0f};
              pg8::gemm_phase<pg8::EpiStore, StaticOrder, true, true>(L, g, S, E); }
            if EN(6) { Gemm g{H, WB + W_Q, T, 1024, 1024}; StaticOrder S; S.init(T, 1024, G_, c_); pg8::EpiStore E{QO, 1024, 0.125f};
              pg8::gemm_phase<pg8::EpiStore, StaticOrder, true, true>(L, g, S, E); }
            grid.sync();
            if EN(7) attn_phase(QO, Kb, VT, L);
            grid.sync();
            if EN(8) { Gemm g{QO, WB + W_O, T, 1024, 1024}; StaticOrder S; S.init(T, 1024, G_, c_); pg8::EpiRes E{X, X, md + 2048, nullptr};
              pg8::gemm_phase<pg8::EpiRes, StaticOrder, true, true>(L, g, S, E); }
            grid.sync();
        norm_phase<1, false>(X, p.in[5] + 1024, md + 3072, H, nullptr, nullptr, nullptr);
        grid.sync();
        if EN(9) { Gemm g{H, WB + (W_FIN1), T, 5632, 1024}; StaticOrder S; S.init(T, 5632, G_, c_);
          pg8::EpiFFN E{Gb, P1b, UH1, p.in[22] + 16896, p.in[23] + 5632, xch};
          pg8::gemm_phase<pg8::EpiFFN, StaticOrder, true, true>(L, g, S, E); }
        grid.sync();
        if EN(10) fixup_ffn(P1b, UH1, p.in[22] + 16896, p.in[23] + 5632, Gb);
        grid.sync();
        if EN(11) { Gemm g{Gb, WB + (W_FOUT1), T, 1024, 2816}; StaticOrder S; S.init(T, 1024, G_, c_); pg8::EpiRes E{X, X, md + 5120, nullptr};
          pg8::gemm_phase<pg8::EpiRes, StaticOrder, true, true>(L, g, S, E); }
        grid.sync();
    }
    norm_phase<1, true>(X, p.in[27], MODS + MOD_FIN, p.out, nullptr, nullptr, nullptr);
}

extern "C" void kernel_launch(void* const* d_in, const int* in_sizes, int n_in, void* d_out, int out_size, void* d_ws, size_t ws_size, hipStream_t stream) {
    static int grid = 0;
    if (grid == 0) {
        if (n_in != 28 || out_size != T * D || ws_size < WS_END) { fprintf(stderr, "kernel_launch: unexpected shapes (n_in %d out %d ws %zu)\n", n_in, out_size, ws_size); grid = -1; return; }
        int dev = 0, cus = 0, per_cu = 0;
        hipGetDevice(&dev); hipDeviceGetAttribute(&cus, hipDeviceAttributeMultiprocessorCount, dev);
        hipFuncSetAttribute((const void*)yoco_fwd, hipFuncAttributeMaxDynamicSharedMemorySize, LDS_BYTES);
        hipOccupancyMaxActiveBlocksPerMultiprocessor(&per_cu, (const void*)yoco_fwd, NTHR, LDS_BYTES);
        if (per_cu < 1) per_cu = 1;
        grid = cus * per_cu; if (grid > 256) grid = 256;
        (void)hipGetLastError();
    }
    if (grid < 0) return;
    Params p{};
    for (int i = 0; i < 28; ++i) p.in[i] = (const float*)d_in[i];
    p.out = (float*)d_out; p.ws = (unsigned char*)d_ws;
    void* args[] = {&p};
    hipError_t e = hipLaunchCooperativeKernel((const void*)yoco_fwd, dim3(grid), dim3(NTHR), args, LDS_BYTES, stream);
    if (e != hipSuccess) fprintf(stderr, "cooperative launch failed: %s (grid %d)\n", hipGetErrorString(e), grid);
}
```

```cpp
#include <hip/hip_runtime.h>
#include <hip/hip_cooperative_groups.h>
#include <cstdio>
#include <cstdint>
namespace cg = cooperative_groups;
#ifndef DBG
#define DBG 0
#endif
namespace pg8 {
#define PG8_LAS __attribute__((address_space(3)))
typedef unsigned short bf16_t;
typedef short bf16x8 __attribute__((ext_vector_type(8)));
typedef float f32x4 __attribute__((ext_vector_type(4)));
typedef unsigned u32x4 __attribute__((ext_vector_type(4)));
constexpr int BM = 256, BK = 64, HALF = 128, HTB = HALF * BK * 2  , STAGE_BYTES = 8 * HTB, NXCD = 8, WGM = 8;

__host__ __device__ __forceinline__ int lds_byte(int r, int c) { const int st = (r >> 4) * 2 + (c >> 5), rr = r & 15, cc = c & 31, ob = rr * 64 + cc * 2; return st * 1024 + (ob ^ (((ob >> 9) & 1) << 5)); }
__host__ __device__ __forceinline__ void stage_rc(int b, int& R, int& C) { const int st = b / 1024, sb = b % 1024, swz = sb ^ (((sb >> 9) & 1) << 5); R = (st >> 1) * 16 + swz / 64; C = (st & 1) * 32 + (swz % 64) / 2; }
__host__ __device__ __forceinline__ int perm32(int rho) { const int n = rho >> 4, i = rho & 15; return 8 * (i >> 2) + 4 * n + (i & 3); }

struct Unit { int pm, pn; };
struct Gemm { const bf16_t* A; const bf16_t* Bt; int M, N, K; };

struct StaticOrder {
    int nM, nN, nwg, G, c;
    __host__ __device__ void init(int M, int N, int G_, int c_) { nM = M / BM; nN = N / BM; nwg = nM * nN; G = G_; c = c_; }
    __host__ __device__ bool next(int i, Unit& u) const {
        const long L = (long)i * G + c; if (L >= nwg) return false;
        int wgid = (int)L; { const int q = nwg / NXCD, r = nwg % NXCD, xcd = wgid % NXCD, off = wgid / NXCD; wgid = (xcd < r ? xcd * (q + 1) : r * (q + 1) + (xcd - r) * q) + off; }
        const int nig = WGM * nN, gid = wgid / nig, fm = gid * WGM, gsz = (nM - fm) < WGM ? (nM - fm) : WGM;
        u.pm = fm + ((wgid % nig) % gsz); u.pn = (wgid % nig) / gsz; return true;
    }
    __device__ __forceinline__ void a_ready(const Unit&) const {}
    __device__ __forceinline__ void done(const Unit&) const {}
};

__device__ __forceinline__ unsigned cvt_pk_bf16(float lo, float hi) { unsigned r; asm volatile("v_cvt_pk_bf16_f32 %0, %1, %2" : "=v"(r) : "v"(lo), "v"(hi)); return r; }

typedef unsigned u32x2 __attribute__((ext_vector_type(2)));
typedef float f32x2 __attribute__((ext_vector_type(2)));
__device__ __forceinline__ float silu_f(float x) { return x * __builtin_amdgcn_rcpf(1.f + __expf(-x)); }
__device__ __forceinline__ f32x2 silu2(f32x2 x) { const f32x2 t = x * (-1.4426950408889634f); f32x2 d; d.x = __builtin_amdgcn_exp2f(t.x); d.y = __builtin_amdgcn_exp2f(t.y); d = d + 1.0f;
    f32x2 r; r.x = __builtin_amdgcn_rcpf(d.x); r.y = __builtin_amdgcn_rcpf(d.y); return x * r; }
__device__ __forceinline__ float softplus_f(float x) { return fmaxf(x, 0.f) + __logf(1.f + __expf(-fabsf(x))); }
template <int K> __device__ __forceinline__ float dpp_ror(float v) { return __int_as_float(__builtin_amdgcn_update_dpp(0, __float_as_int(v), 0x120 + K, 0xf, 0xf, false)); }
template <int K> __device__ __forceinline__ float dpp_shr_keep(float cur, float old) { return __int_as_float(__builtin_amdgcn_update_dpp(__float_as_int(old), __float_as_int(cur), 0x110 + K, 0xf, 0xf, false)); }
template <int K> __device__ __forceinline__ float shift1(float cur, float prev, float halo, bool first) { const float old = first ? halo : dpp_ror<K>(prev); return dpp_shr_keep<K>(cur, old); }
template <int K> __device__ __forceinline__ f32x4 shift_rows(const f32x4 cur, const f32x4 prev, const f32x4 halo, bool first) {
    f32x4 r;
#pragma unroll
    for (int e = 0; e < 4; ++e) { const float old = first ? halo[e] : dpp_ror<K>(prev[e]); r[e] = dpp_shr_keep<K>(cur[e], old); }
    return r;
}

struct EpiStore {
    static constexpr bool PERM = true, AFTER_DRAIN = false, ROWPERM = false;
    bf16_t* O; int ldc; float sc;
    __device__ __forceinline__ void operator()(const f32x4 (&acc)[2][2][4][2], const Unit& u, int wr, int wc, int fr, int fq) const {
        asm volatile("" : "+v"(fr), "+v"(fq));
        const int row0 = u.pm * BM + wr * 64 + fr, col0 = u.pn * BM + wc * 32 + 8 * fq;
#pragma unroll
        for (int ai = 0; ai < 2; ++ai)
#pragma unroll
            for (int m = 0; m < 4; ++m) { bf16_t* rowp = O + (size_t)(row0 + ai * HALF + m * 16) * ldc + col0;
#pragma unroll
                for (int bj = 0; bj < 2; ++bj) { const f32x4 v0 = acc[ai][bj][m][0] * sc, v1 = acc[ai][bj][m][1] * sc;
                    u32x4 w; w.x = cvt_pk_bf16(v0[0], v0[1]); w.y = cvt_pk_bf16(v0[2], v0[3]); w.z = cvt_pk_bf16(v1[0], v1[1]); w.w = cvt_pk_bf16(v1[2], v1[3]);
                    *(u32x4*)(rowp + bj * HALF) = w; } }
    }
};

template <bool XIN_F32> struct EpiRes {
    static constexpr bool PERM = true, AFTER_DRAIN = false, ROWPERM = false;
    const void* xin; bf16_t* xout; const float* gate; const float* sumsq;
    __device__ __forceinline__ void operator()(const f32x4 (&acc)[2][2][4][2], const Unit& u, int wr, int wc, int fr, int fq) const {
        asm volatile("" : "+v"(fr), "+v"(fq));
        const int row0 = u.pm * BM + wr * 64 + fr, col0 = u.pn * BM + wc * 32 + 8 * fq;
        const float* gp = gate + (size_t)(u.pm >> 5) * 16384 + col0;
        f32x4 gv[2][2];
#pragma unroll
        for (int bj = 0; bj < 2; ++bj)
#pragma unroll
            for (int n = 0; n < 2; ++n) gv[bj][n] = *(const f32x4*)(gp + bj * HALF + n * 4);
#pragma unroll
        for (int ai = 0; ai < 2; ++ai)
#pragma unroll
            for (int m = 0; m < 4; ++m) { const int row = row0 + ai * HALF + m * 16;
                const float rs = sumsq ? sumsq[row] : 1.0f;
                const size_t off = (size_t)row * 1024 + col0;
#pragma unroll
                for (int bj = 0; bj < 2; ++bj) {
                    f32x4 x0, x1;
                    if (XIN_F32) { x0 = *(const f32x4*)((const float*)xin + off + bj * HALF); x1 = *(const f32x4*)((const float*)xin + off + bj * HALF + 4); }
                    else { const u32x4 xb = *(const u32x4*)((const bf16_t*)xin + off + bj * HALF);
                        x0 = (f32x4){__uint_as_float(xb.x << 16), __uint_as_float(xb.x & 0xffff0000u), __uint_as_float(xb.y << 16), __uint_as_float(xb.y & 0xffff0000u)};
                        x1 = (f32x4){__uint_as_float(xb.z << 16), __uint_as_float(xb.z & 0xffff0000u), __uint_as_float(xb.w << 16), __uint_as_float(xb.w & 0xffff0000u)}; }
                    const f32x4 v0 = x0 + gv[bj][0] * acc[ai][bj][m][0] * rs, v1 = x1 + gv[bj][1] * acc[ai][bj][m][1] * rs;
                    u32x4 w; w.x = cvt_pk_bf16(v0[0], v0[1]); w.y = cvt_pk_bf16(v0[2], v0[3]); w.z = cvt_pk_bf16(v1[0], v1[1]); w.w = cvt_pk_bf16(v1[2], v1[3]);
                    *(u32x4*)(xout + off + bj * HALF) = w; } }
    }
};

struct EpiZdt {
    static constexpr bool PERM = true, AFTER_DRAIN = false, ROWPERM = false;
    bf16_t* Z; float* DT; const float* dtb;
    __device__ __forceinline__ void operator()(const f32x4 (&acc)[2][2][4][2], const Unit& u, int wr, int wc, int fr, int fq) const {
        asm volatile("" : "+v"(fr), "+v"(fq));
        const int row0 = u.pm * BM + wr * 64 + fr;
        if (u.pn < 8) {
            const int col0 = u.pn * BM + wc * 32 + 8 * fq;
#pragma unroll
            for (int ai = 0; ai < 2; ++ai)
#pragma unroll
                for (int m = 0; m < 4; ++m) { bf16_t* rowp = Z + (size_t)(row0 + ai * HALF + m * 16) * 2048 + col0;
#pragma unroll
                    for (int bj = 0; bj < 2; ++bj) { const f32x4 v0 = acc[ai][bj][m][0], v1 = acc[ai][bj][m][1];
                        u32x4 w; w.x = cvt_pk_bf16(v0[0], v0[1]); w.y = cvt_pk_bf16(v0[2], v0[3]); w.z = cvt_pk_bf16(v1[0], v1[1]); w.w = cvt_pk_bf16(v1[2], v1[3]);
                        *(u32x4*)(rowp + bj * HALF) = w; } }
            return;
        }
        {
            if (wc == 0) {
#pragma unroll
                for (int n = 0; n < 2; ++n) { const f32x4 bv = *(const f32x4*)(dtb + 8 * fq + 4 * n);
#pragma unroll
                    for (int ai = 0; ai < 2; ++ai)
#pragma unroll
                        for (int m = 0; m < 4; ++m) { f32x4 v = acc[ai][0][m][n] + bv;
#pragma unroll
                            for (int e = 0; e < 4; ++e) v[e] = softplus_f(v[e]);
                            *(f32x4*)(DT + (size_t)(row0 + ai * HALF + m * 16) * 32 + 8 * fq + 4 * n) = v; } }
            }
            return;
        }
    }
};

struct EpiMamba {
    static constexpr bool PERM = true, AFTER_DRAIN = false, ROWPERM = true;
    static constexpr int NC = 4096;
    bf16_t* XBC; float* P; float* UH; const float* cw; const float* cb; PG8_LAS float* xch;
    __device__ __forceinline__ void operator()(const f32x4 (&acc)[2][2][4][2], const Unit& u, int wr, int wc, int fr, int fq) const {
        asm volatile("" : "+v"(fr), "+v"(fq));
        const int row0 = u.pm * BM + wr * 64 + 4 * fr;
        const int cpos0 = 32 * wc + 8 * fq;
        PG8_LAS float* wt = xch + 3072;
        { const int tid = (wr * 4 + wc) * 64 + fq * 16 + fr;
#pragma unroll
            for (int j = 0; j < 3; ++j) { const int i = tid + 512 * j; if (i < 5 * 256) { const int t = i >> 8, cp = i & 255; wt[i] = t < 4 ? cw[t * 4096 + u.pn * BM + cp] : cb[u.pn * BM + cp]; } } }
        if (fr == 15) {
#pragma unroll
            for (int ai = 0; ai < 2; ++ai)
#pragma unroll
                for (int bj = 0; bj < 2; ++bj)
#pragma unroll
                    for (int n = 0; n < 2; ++n)
#pragma unroll
                        for (int m = 1; m < 4; ++m) {
                            *(PG8_LAS f32x4*)(xch + ((2 * ai + wr) * 3 + (m - 1)) * 256 + 128 * bj + cpos0 + 4 * n) = acc[ai][bj][m][n];
                            if (ai == 1 && wr == 1) *(f32x4*)(UH + ((size_t)u.pm * 3 + (m - 1)) * NC + u.pn * BM + 128 * bj + cpos0 + 4 * n) = acc[1][bj][m][n]; }
        }
        asm volatile("s_waitcnt lgkmcnt(0)" ::: "memory"); __builtin_amdgcn_s_barrier(); asm volatile("" ::: "memory");
#pragma unroll
        for (int ai = 0; ai < 2; ++ai) {
            const int seg = 2 * ai + wr; const bool has_prev = seg > 0; const int sp = has_prev ? seg - 1 : 0;
#pragma unroll
            for (int bj = 0; bj < 2; ++bj) {
                const int ch0 = u.pn * BM + 128 * bj + cpos0;
#pragma unroll
                for (int n = 0; n < 2; ++n) {
                    unsigned pk[4][2];
#pragma unroll
                    for (int eh = 0; eh < 2; ++eh) {
                        const int cpos = 128 * bj + cpos0 + 4 * n + 2 * eh; const int ch = ch0 + 4 * n + 2 * eh;
                        f32x2 h1 = *(const PG8_LAS f32x2*)(xch + (sp * 3 + 2) * 256 + cpos), h2 = *(const PG8_LAS f32x2*)(xch + (sp * 3 + 1) * 256 + cpos), h3 = *(const PG8_LAS f32x2*)(xch + (sp * 3 + 0) * 256 + cpos);
                        if (!has_prev) { h1 = (f32x2){0.f, 0.f}; h2 = h1; h3 = h1; }
                        const f32x2 w0 = *(const PG8_LAS f32x2*)(wt + 0 * 256 + cpos), w1 = *(const PG8_LAS f32x2*)(wt + 1 * 256 + cpos), w2 = *(const PG8_LAS f32x2*)(wt + 2 * 256 + cpos),
                                    w3 = *(const PG8_LAS f32x2*)(wt + 3 * 256 + cpos), bb = *(const PG8_LAS f32x2*)(wt + 4 * 256 + cpos);
                        f32x2 o[4], v[4];
#pragma unroll
                        for (int m = 0; m < 4; ++m) v[m] = (f32x2){acc[ai][bj][m][n][2 * eh], acc[ai][bj][m][n][2 * eh + 1]};
                        const f32x2 s1 = (f32x2){dpp_shr_keep<1>(v[3].x, h1.x), dpp_shr_keep<1>(v[3].y, h1.y)}, s2 = (f32x2){dpp_shr_keep<1>(v[2].x, h2.x), dpp_shr_keep<1>(v[2].y, h2.y)},
                                    s3 = (f32x2){dpp_shr_keep<1>(v[1].x, h3.x), dpp_shr_keep<1>(v[1].y, h3.y)};
                        o[0] = bb + w3 * v[0] + w2 * s1 + w1 * s2 + w0 * s3;
                        o[1] = bb + w3 * v[1] + w2 * v[0] + w1 * s1 + w0 * s2;
                        o[2] = bb + w3 * v[2] + w2 * v[1] + w1 * v[0] + w0 * s1;
                        o[3] = bb + w3 * v[3] + w2 * v[2] + w1 * v[1] + w0 * v[0];
                        if (seg == 0 && fr == 0) {
#pragma unroll
                            for (int m = 0; m < 3; ++m) *(f32x2*)(P + ((size_t)u.pm * 3 + m) * NC + u.pn * BM + cpos) = o[m]; }
#pragma unroll
                        for (int m = 0; m < 4; ++m) { const f32x2 r = silu2(o[m]); pk[m][eh] = cvt_pk_bf16(r.x, r.y); }
                    }
#pragma unroll
                    for (int m = 0; m < 4; ++m) { u32x2 w; w.x = pk[m][0]; w.y = pk[m][1]; *(u32x2*)(XBC + (size_t)(row0 + ai * HALF + m) * 4096 + ch0 + 4 * n) = w; }
                }
            }
        }
    }
};

struct EpiFFN {
    static constexpr bool PERM = true, AFTER_DRAIN = false, ROWPERM = true;
    static constexpr int NC = 5632, F = 2816;
    bf16_t* G; float* P; float* UH; const float* cw; const float* cb; PG8_LAS float* xch;
    __device__ __forceinline__ void operator()(const f32x4 (&acc)[2][2][4][2], const Unit& u, int wr, int wc, int fr, int fq) const {
        asm volatile("" : "+v"(fr), "+v"(fq));
        const int row0 = u.pm * BM + wr * 64 + 4 * fr;
        const int cpos0 = 32 * wc + 8 * fq;
        PG8_LAS float* wt = xch + 3072;
        { const int tid = (wr * 4 + wc) * 64 + fq * 16 + fr;
#pragma unroll
            for (int j = 0; j < 2; ++j) { const int i = tid + 512 * j; const int t = i >> 8, cp = i & 255; const int chs = (cp >> 7) * F + u.pn * 128 + (cp & 127); wt[i] = t < 3 ? cw[t * NC + chs] : cb[chs]; } }
        if (fr == 15) {
#pragma unroll
            for (int ai = 0; ai < 2; ++ai)
#pragma unroll
                for (int bj = 0; bj < 2; ++bj)
#pragma unroll
                    for (int n = 0; n < 2; ++n)
#pragma unroll
                        for (int m = 2; m < 4; ++m) {
                            *(PG8_LAS f32x4*)(xch + ((2 * ai + wr) * 2 + (m - 2)) * 256 + 128 * bj + cpos0 + 4 * n) = acc[ai][bj][m][n];
                            if (ai == 1 && wr == 1) *(f32x4*)(UH + ((size_t)u.pm * 2 + (m - 2)) * NC + u.pn * BM + 128 * bj + cpos0 + 4 * n) = acc[1][bj][m][n]; }
        }
        asm volatile("s_waitcnt lgkmcnt(0)" ::: "memory"); __builtin_amdgcn_s_barrier(); asm volatile("" ::: "memory");
        const int j0 = u.pn * 128 + cpos0;
#pragma unroll
        for (int ai = 0; ai < 2; ++ai) {
            const int seg = 2 * ai + wr; const bool has_prev = seg > 0; const int sp = has_prev ? seg - 1 : 0;
#pragma unroll
            for (int n = 0; n < 2; ++n) {
                unsigned pk[4][2];
#pragma unroll
                for (int eh = 0; eh < 2; ++eh) {
                    f32x2 og[2][4];
#pragma unroll
                    for (int bj = 0; bj < 2; ++bj) {
                        const int cpos = 128 * bj + cpos0 + 4 * n + 2 * eh;
                        f32x2 h1 = *(const PG8_LAS f32x2*)(xch + (sp * 2 + 1) * 256 + cpos), h2 = *(const PG8_LAS f32x2*)(xch + (sp * 2 + 0) * 256 + cpos);
                        if (!has_prev) { h1 = (f32x2){0.f, 0.f}; h2 = h1; }
                        const f32x2 w0 = *(const PG8_LAS f32x2*)(wt + 0 * 256 + cpos), w1 = *(const PG8_LAS f32x2*)(wt + 1 * 256 + cpos), w2 = *(const PG8_LAS f32x2*)(wt + 2 * 256 + cpos), bb = *(const PG8_LAS f32x2*)(wt + 3 * 256 + cpos);
                        f32x2 v[4];
#pragma unroll
                        for (int m = 0; m < 4; ++m) v[m] = (f32x2){acc[ai][bj][m][n][2 * eh], acc[ai][bj][m][n][2 * eh + 1]};
                        const f32x2 s1 = (f32x2){dpp_shr_keep<1>(v[3].x, h1.x), dpp_shr_keep<1>(v[3].y, h1.y)}, s2 = (f32x2){dpp_shr_keep<1>(v[2].x, h2.x), dpp_shr_keep<1>(v[2].y, h2.y)};
                        og[bj][0] = bb + w2 * v[0] + w1 * s1 + w0 * s2;
                        og[bj][1] = bb + w2 * v[1] + w1 * v[0] + w0 * s1;
                        og[bj][2] = bb + w2 * v[2] + w1 * v[1] + w0 * v[0];
                        og[bj][3] = bb + w2 * v[3] + w1 * v[2] + w0 * v[1];
                        if (seg == 0 && fr == 0) {
#pragma unroll
                            for (int m = 0; m < 2; ++m) *(f32x2*)(P + ((size_t)u.pm * 2 + m) * NC + u.pn * BM + cpos) = og[bj][m]; }
                    }
#pragma unroll
                    for (int m = 0; m < 4; ++m) { const f32x2 r = silu2(og[0][m]) * og[1][m]; pk[m][eh] = cvt_pk_bf16(r.x, r.y); }
                }
#pragma unroll
                for (int m = 0; m < 4; ++m) { u32x2 w; w.x = pk[m][0]; w.y = pk[m][1]; *(u32x2*)(G + (size_t)(row0 + ai * HALF + m) * F + j0 + 4 * n) = w; }
            }
        }
    }
};
template <class Epi, class Sched, bool ALIGN_EPI = false, bool SP2 = false>
__device__ __forceinline__ void gemm_phase(PG8_LAS unsigned char* lds, const Gemm g, const Sched& S, const Epi& E) {
    int tid_ = threadIdx.x; asm volatile("" : "+v"(tid_));
    const int tid = tid_, wid = __builtin_amdgcn_readfirstlane(tid >> 6), lane = tid & 63, wr = wid >> 2, wc = wid & 3, fr = lane & 15, fq = lane >> 4;
    const int K = g.K, nt = K / BK;
    unsigned voffA[2], voffB[2];
#pragma unroll
    for (int i = 0; i < 2; ++i) { int R, C; stage_rc(tid * 16 + i * 8192, R, C); const int Rb = Epi::PERM ? ((R & ~31) + perm32(R & 31)) : R;
        const int Ra = Epi::ROWPERM ? ((R & ~63) + 4 * (R & 15) + ((R >> 4) & 3)) : R;
        voffA[i] = (unsigned)(Ra * K + C) * 2u; voffB[i] = (unsigned)(Rb * K + C) * 2u; }
    const size_t kstep = (size_t)(BK * 2);
    const size_t hstep = (size_t)HALF * K * 2;
    const size_t tstep = 2 * hstep;
    const unsigned ldsw = (unsigned)wid * 1024u;
    const int aoff = lds_byte(wr * 64 + fr, fq * 8), boff = lds_byte(wc * 32 + fr, fq * 8);
#define PG8_SA(b, h) (((b) * 2 + (h)) * HTB)
#define PG8_SB(b, h) ((4 + (b) * 2 + (h)) * HTB)
#define PG8_STAGE(bufoff, gbase, voff) do { _Pragma("unroll") for (int _i = 0; _i < 2; ++_i) \
        __builtin_amdgcn_global_load_lds((const unsigned*)((const char*)(gbase) + (voff)[_i]), (PG8_LAS unsigned*)(lds + (bufoff) + ldsw + _i * 8192), 16, 0, 0); } while (0)
#define PG8_LDA(dst, b, h) do { _Pragma("unroll") for (int m = 0; m < 4; ++m) _Pragma("unroll") for (int k = 0; k < 2; ++k) dst[m][k] = *(const PG8_LAS bf16x8*)(lds + PG8_SA(b, h) + aoff + m * 2048 + k * 1024); } while (0)
#define PG8_LDB(dst, b, h) do { _Pragma("unroll") for (int n = 0; n < 2; ++n) _Pragma("unroll") for (int k = 0; k < 2; ++k) dst[n][k] = *(const PG8_LAS bf16x8*)(lds + PG8_SB(b, h) + boff + n * 2048 + k * 1024); } while (0)
#define PG8_MMA(ai, bj, At, Bt) do { __builtin_amdgcn_s_setprio(1); _Pragma("unroll") for (int m = 0; m < 4; ++m) _Pragma("unroll") for (int n = 0; n < 2; ++n) _Pragma("unroll") for (int k = 0; k < 2; ++k) \
        acc[ai][bj][m][n] = __builtin_amdgcn_mfma_f32_16x16x32_bf16(Bt[n][k], At[m][k], acc[ai][bj][m][n], 0, 0, 0); __builtin_amdgcn_s_setprio(0); } while (0)
#define PG8_WAIT_V(n) asm volatile("s_waitcnt vmcnt(" #n ")" ::: "memory")
#define PG8_WAIT_L(n) asm volatile("s_waitcnt lgkmcnt(" #n ")" ::: "memory")
#define PG8_BAR __builtin_amdgcn_s_barrier()
#define PG8_SCHED __builtin_amdgcn_sched_barrier(0)
    Unit cur, nxt; int ui = 0;
    if (!S.next(0, cur)) return;
    f32x4 acc[2][2][4][2];
#pragma unroll
    for (int a = 0; a < 2; ++a)
#pragma unroll
        for (int b = 0; b < 2; ++b)
#pragma unroll
            for (int m = 0; m < 4; ++m)
#pragma unroll
                for (int n = 0; n < 2; ++n) acc[a][b][m][n] = (f32x4){0.f, 0.f, 0.f, 0.f};
    bf16x8 At[4][2], B0[2][2], B1[2][2];
    const char* cA = (const char*)g.A + (size_t)cur.pm * tstep; const char* cB = (const char*)g.Bt + (size_t)cur.pn * tstep;
    S.a_ready(cur);
    if constexpr (SP2) {
        PG8_STAGE(PG8_SB(0, 0), cB, voffB); PG8_STAGE(PG8_SB(0, 1), cB + hstep, voffB); PG8_STAGE(PG8_SA(0, 0), cA, voffA); PG8_STAGE(PG8_SA(0, 1), cA + hstep, voffA);
        if (wr == 1) PG8_BAR;
        PG8_WAIT_V(2); PG8_BAR;
        PG8_STAGE(PG8_SB(1, 0), cB + kstep, voffB); PG8_STAGE(PG8_SA(1, 0), cA + kstep, voffA); PG8_STAGE(PG8_SB(1, 1), cB + hstep + kstep, voffB);
        PG8_WAIT_V(6); PG8_BAR;
    } else {
        PG8_STAGE(PG8_SB(0, 0), cB, voffB); PG8_STAGE(PG8_SA(0, 0), cA, voffA); PG8_STAGE(PG8_SB(0, 1), cB + hstep, voffB); PG8_STAGE(PG8_SA(0, 1), cA + hstep, voffA);
        if (wr == 1) PG8_BAR;
        PG8_WAIT_V(4); PG8_BAR;
        PG8_STAGE(PG8_SB(1, 0), cB + kstep, voffB); PG8_STAGE(PG8_SA(1, 0), cA + kstep, voffA); PG8_STAGE(PG8_SB(1, 1), cB + hstep + kstep, voffB);
        PG8_WAIT_V(6); PG8_BAR;
    }
    for (;;) {
        const bool has_next = S.next(ui + 1, nxt);
        const char* nA = has_next ? (const char*)g.A + (size_t)nxt.pm * tstep : cA; const char* nB = has_next ? (const char*)g.Bt + (size_t)nxt.pn * tstep : cB;
        for (int t = 0; t < nt; t += 2) {
            const bool last = (t == nt - 2);
            const char* a1 = cA + (size_t)(t + 1) * kstep;
            const char* a2 = last ? nA : cA + (size_t)(t + 2) * kstep; const char* b2 = last ? nB : cB + (size_t)(t + 2) * kstep;
            const char* a3 = a2 + kstep; const char* b3 = b2 + kstep;
            if (last && has_next) S.a_ready(nxt);
            if constexpr (SP2) {
            PG8_LDB(B0, 0, 0); PG8_LDB(B1, 0, 1); PG8_SCHED; PG8_LDA(At, 0, 0); PG8_STAGE(PG8_SA(1, 1), a1 + hstep, voffA);
            PG8_WAIT_V(8); PG8_WAIT_L(0); PG8_BAR; PG8_MMA(0, 0, At, B0); PG8_MMA(0, 1, At, B1); PG8_BAR; PG8_SCHED;
            PG8_LDA(At, 0, 1); PG8_STAGE(PG8_SB(0, 0), b2, voffB); PG8_STAGE(PG8_SB(0, 1), b2 + hstep, voffB); PG8_STAGE(PG8_SA(0, 0), a2, voffA);
            PG8_WAIT_V(8); PG8_WAIT_L(0); PG8_BAR; PG8_MMA(1, 0, At, B0); PG8_MMA(1, 1, At, B1); PG8_BAR; PG8_SCHED;
            PG8_LDB(B0, 1, 0); PG8_LDB(B1, 1, 1); PG8_SCHED; PG8_LDA(At, 1, 0); PG8_STAGE(PG8_SA(0, 1), a2 + hstep, voffA);
            PG8_WAIT_V(8); PG8_WAIT_L(0); PG8_BAR; PG8_MMA(0, 0, At, B0); PG8_MMA(0, 1, At, B1); PG8_BAR; PG8_SCHED;
            PG8_LDA(At, 1, 1); PG8_STAGE(PG8_SB(1, 0), b3, voffB); PG8_STAGE(PG8_SB(1, 1), b3 + hstep, voffB); PG8_STAGE(PG8_SA(1, 0), a3, voffA);
            PG8_WAIT_V(8); PG8_WAIT_L(0); PG8_BAR; PG8_MMA(1, 0, At, B0); PG8_MMA(1, 1, At, B1); PG8_BAR; PG8_SCHED;
            } else {
            PG8_LDB(B0, 0, 0); PG8_SCHED; PG8_LDA(At, 0, 0); PG8_STAGE(PG8_SA(1, 1), a1 + hstep, voffA);
            PG8_WAIT_L(8); PG8_BAR; PG8_WAIT_L(0); PG8_MMA(0, 0, At, B0); PG8_BAR; PG8_SCHED;
            PG8_LDB(B1, 0, 1); PG8_STAGE(PG8_SB(0, 0), b2, voffB);
            PG8_BAR; PG8_WAIT_L(0); PG8_MMA(0, 1, At, B1); PG8_BAR;
            PG8_LDA(At, 0, 1); PG8_STAGE(PG8_SA(0, 0), a2, voffA);
            PG8_BAR; PG8_WAIT_L(0); PG8_MMA(1, 0, At, B0); PG8_BAR; PG8_SCHED;
            PG8_STAGE(PG8_SB(0, 1), b2 + hstep, voffB);
            PG8_WAIT_V(6); PG8_BAR; PG8_MMA(1, 1, At, B1); PG8_BAR;
            PG8_LDB(B0, 1, 0); PG8_SCHED; PG8_LDA(At, 1, 0); PG8_STAGE(PG8_SA(0, 1), a2 + hstep, voffA);
            PG8_WAIT_L(8); PG8_BAR; PG8_WAIT_L(0); PG8_MMA(0, 0, At, B0); PG8_BAR; PG8_SCHED;
            PG8_LDB(B1, 1, 1); PG8_STAGE(PG8_SB(1, 0), b3, voffB);
            PG8_BAR; PG8_WAIT_L(0); PG8_MMA(0, 1, At, B1); PG8_BAR;
            PG8_LDA(At, 1, 1); PG8_STAGE(PG8_SA(1, 0), a3, voffA);
            PG8_BAR; PG8_WAIT_L(0); PG8_MMA(1, 0, At, B0); PG8_BAR; PG8_SCHED;
            PG8_STAGE(PG8_SB(1, 1), b3 + hstep, voffB);
            PG8_WAIT_V(6); PG8_BAR; PG8_MMA(1, 1, At, B1); PG8_BAR;
            }
        }
        if constexpr (ALIGN_EPI) { if (wr == 0) PG8_BAR; }
        if constexpr (!Epi::AFTER_DRAIN) { E(acc, cur, wr, wc, fr, fq); S.done(cur); }
        if (!has_next) break;
#pragma unroll
        for (int a = 0; a < 2; ++a)
#pragma unroll
            for (int b = 0; b < 2; ++b)
#pragma unroll
                for (int m = 0; m < 4; ++m)
#pragma unroll
                    for (int n = 0; n < 2; ++n) acc[a][b][m][n] = (f32x4){0.f, 0.f, 0.f, 0.f};
        cur = nxt; cA = nA; cB = nB; ++ui;
        if constexpr (ALIGN_EPI) { if (wr == 1) PG8_BAR; }
    }
    PG8_WAIT_V(0);
    if constexpr (!ALIGN_EPI) { if (wr == 0) PG8_BAR; }
    PG8_BAR;
    if constexpr (Epi::AFTER_DRAIN) { E.fused(acc, cur, wr, wc, fr, fq, lds, wid, lane); S.done(cur); }
#undef PG8_SA
#undef PG8_SB
#undef PG8_STAGE
#undef PG8_LDA
#undef PG8_LDB
#undef PG8_MMA
#undef PG8_WAIT_V
#undef PG8_WAIT_L
#undef PG8_BAR
#undef PG8_SCHED
}
}

#define LAS __attribute__((address_space(3)))
typedef unsigned short bf16;
typedef short bf16x8 __attribute__((ext_vector_type(8)));
typedef short s16x4 __attribute__((ext_vector_type(4)));
typedef float f32x4 __attribute__((ext_vector_type(4)));
typedef unsigned u32x4 __attribute__((ext_vector_type(4)));
typedef unsigned u32x2 __attribute__((ext_vector_type(2)));
#define MFMA16(a, b, c) __builtin_amdgcn_mfma_f32_16x16x32_bf16((a), (b), (c), 0, 0, 0)

constexpr int T = 32768, D = 1024, SEQ = 8192, NTHR = 512;
constexpr int LDS_BYTES = 163840, XCH_OFF = 131072;
constexpr size_t MiB = 1u << 20;
constexpr size_t WS_W = 0;
constexpr size_t W_IN = 0, W_SOUT = W_IN + (size_t)6400 * 1024, W_FIN0 = W_SOUT + (size_t)1024 * 2048, W_FIN1 = W_FIN0 + (size_t)5632 * 1024,
                 W_FOUT0 = W_FIN1 + (size_t)5632 * 1024, W_FOUT1 = W_FOUT0 + (size_t)1024 * 2816, W_K = W_FOUT1 + (size_t)1024 * 2816, W_V = W_K + 1048576, W_Q = W_V + 1048576,
                 W_O = W_Q + 1048576, W_END = W_O + 1048576;
static_assert(W_END * 2 <= 58 * MiB, "weights fit");
constexpr size_t WS_MODS = 58 * MiB;
constexpr size_t WS_SUMSQ = 59 * MiB;
constexpr size_t WS_FLAGS = 60 * MiB;
constexpr size_t WS_BAR = 61 * MiB;
constexpr size_t WS_X = 64 * MiB;
constexpr size_t WS_BIG = 192 * MiB;
constexpr size_t WS_END = 448 * MiB;
constexpr int MOD_L = 6144, MOD_KV = 12288, MOD_FIN = 14336, MOD_N = 16384;

#ifdef PROBE
#define STAMP(k) do { if (blockIdx.x == 0 && threadIdx.x == 0) { __threadfence(); TS[k] = __builtin_amdgcn_s_memrealtime(); __threadfence(); } } while (0)
#else
#define STAMP(k) do {} while (0)
#endif
struct Params { const float* in[28]; float* out; unsigned char* ws; };

__device__ __forceinline__ float bf2f(unsigned u) { return __uint_as_float(u << 16); }
typedef float f32x2_t __attribute__((ext_vector_type(2))); typedef __bf16 bf16x2_t __attribute__((ext_vector_type(2)));
__device__ __forceinline__ unsigned pk2(float lo, float hi) { f32x2_t v = {lo, hi}; bf16x2_t b = __builtin_convertvector(v, bf16x2_t); return __builtin_bit_cast(unsigned, b); }
__device__ __forceinline__ unsigned f2bf(float f) { return pk2(f, 0.f) & 0xffffu; }
__device__ __forceinline__ float wave_sum(float v) {
#pragma unroll
    for (int o = 1; o < 64; o <<= 1) v += __shfl_xor(v, o);
    return v;
}
using pg8::silu_f; using pg8::softplus_f;

__device__ __forceinline__ void p0_item(const float* W, int K, int Nsrc, bf16* WT, int dst_n0, int src_n0, int k0, LAS float* scr, int lane) {
    const int c = lane & 7;
    if (src_n0 < 0) {
#pragma unroll
        for (int j = 0; j < 4; ++j) { const int n = (lane >> 3) + 8 * j; *(u32x4*)(WT + (size_t)(dst_n0 + n) * K + k0 + 8 * c) = (u32x4){0u, 0u, 0u, 0u}; }
        return;
    }
#pragma unroll 8
    for (int i = 0; i < 32; ++i) { const int kk = 2 * i + (lane >> 5); scr[kk * 33 + (lane & 31)] = W[(size_t)(k0 + kk) * Nsrc + src_n0 + (lane & 31)]; }
    asm volatile("s_waitcnt lgkmcnt(0)" ::: "memory");
#pragma unroll
    for (int j = 0; j < 4; ++j) { const int n = (lane >> 3) + 8 * j; const LAS float* s = scr + (8 * c) * 33 + n;
        u32x4 o; o.x = pk2(s[0 * 33], s[1 * 33]); o.y = pk2(s[2 * 33], s[3 * 33]); o.z = pk2(s[4 * 33], s[5 * 33]); o.w = pk2(s[6 * 33], s[7 * 33]);
        *(u32x4*)(WT + (size_t)(dst_n0 + n) * K + k0 + 8 * c) = o; }
    asm volatile("s_waitcnt lgkmcnt(0)" ::: "memory");
}
__device__ __forceinline__ void p0_phase(const Params& p, LAS unsigned char* L) {
    const int tid = threadIdx.x, lane = tid & 63, wave = __builtin_amdgcn_readfirstlane(tid >> 6);
    bf16* WB = (bf16*)(p.ws + WS_W);
    float* MODS = (float*)(p.ws + WS_MODS); float* SUMSQ = (float*)(p.ws + WS_SUMSQ);
    if (blockIdx.x == 0 && tid < 64) ((unsigned*)(p.ws + WS_FLAGS))[tid] = 0u;
    LAS float* cs = (LAS float*)L; LAS float* part = (LAS float*)(L + 16384);
    for (int i = tid; i < 4096; i += NTHR) cs[i] = silu_f(p.in[1][i]);
    __syncthreads();
    for (int jb = blockIdx.x; jb < MOD_N / 64; jb += gridDim.x) {
        const int j = jb * 64 + lane; const float* Wsrc; const float* bsrc; int stride, jj;
        if (j < MOD_KV) { const int l = j / MOD_L; jj = j - l * MOD_L; Wsrc = p.in[2] + (size_t)l * D * MOD_L; bsrc = p.in[3] + l * MOD_L; stride = MOD_L; }
        else if (j < MOD_FIN) { jj = j - MOD_KV; Wsrc = p.in[14]; bsrc = p.in[15]; stride = 2048; }
        else { jj = j - MOD_FIN; Wsrc = p.in[25]; bsrc = p.in[26]; stride = 2048; }
        float a0 = 0.f, a1 = 0.f, a2 = 0.f, a3 = 0.f;
#pragma unroll 8
        for (int k = wave * 128; k < wave * 128 + 128; ++k) { const float wv = Wsrc[(size_t)k * stride + jj]; a0 += cs[k] * wv; a1 += cs[1024 + k] * wv; a2 += cs[2048 + k] * wv; a3 += cs[3072 + k] * wv; }
        part[(wave * 4 + 0) * 64 + lane] = a0; part[(wave * 4 + 1) * 64 + lane] = a1; part[(wave * 4 + 2) * 64 + lane] = a2; part[(wave * 4 + 3) * 64 + lane] = a3;
        __syncthreads();
        if (tid < 256) { const int b = tid >> 6; float s = 0.f;
#pragma unroll
            for (int w = 0; w < 8; ++w) s += part[(w * 4 + b) * 64 + lane];
            MODS[(size_t)b * MOD_N + j] = s + bsrc[jj]; }
        __syncthreads();
    }
    LAS float* scr = (LAS float*)(L + wave * 16384);
    const int gw = blockIdx.x * 8 + wave, NGW = gridDim.x * 8;
    constexpr int NI0 = 16 * 200, NI1 = 32 * 32, NI2 = 16 * 176, NI3 = 44 * 32, NI4 = 16 * 32;
    constexpr int NITEMS = NI0 + NI1 + 2 * NI2 + 2 * NI3 + 4 * NI4;
    for (int it = gw; it < NITEMS; it += NGW) {
        int r = it;
        if (r < NI0) { const int kb = r / 200, nb = r % 200; const int dn = nb * 32; const int sn = dn < 2048 ? dn : dn < 2080 ? 6144 + (dn - 2048) : dn < 2304 ? -1 : 2048 + (dn - 2304); p0_item(p.in[6], 1024, 6176, WB + W_IN, dn, sn, kb * 64, scr, lane); continue; } r -= NI0;
        if (r < NI1) { const int kb = r / 32, nb = r % 32; p0_item(p.in[13], 2048, 1024, WB + W_SOUT, nb * 32, nb * 32, kb * 64, scr, lane); continue; } r -= NI1;
        if (r < 2 * NI2) { const int l = r / NI2; r -= l * NI2; const int kb = r / 176, nb = r % 176; const int dn = nb * 32; const int sn = (dn >> 8) * 128 + (dn & 127) + ((dn & 255) >= 128 ? 2816 : 0);
            p0_item(p.in[21] + (size_t)l * 1024 * 5632, 1024, 5632, WB + (l ? W_FIN1 : W_FIN0), dn, sn, kb * 64, scr, lane); continue; } r -= 2 * NI2;
        if (r < 2 * NI3) { const int l = r / NI3; r -= l * NI3; const int kb = r / 32, nb = r % 32;
            p0_item(p.in[24] + (size_t)l * 2816 * 1024, 2816, 1024, WB + (l ? W_FOUT1 : W_FOUT0), nb * 32, nb * 32, kb * 64, scr, lane); continue; } r -= 2 * NI3;
        { const int q = r / NI4; r -= q * NI4; const int kb = r / 32, nb = r % 32; const float* src = q == 0 ? p.in[17] : q == 1 ? p.in[18] : q == 2 ? p.in[19] : p.in[20];
            bf16* dst = WB + (q == 0 ? W_K : q == 1 ? W_V : q == 2 ? W_Q : W_O);
            p0_item(src, 1024, 1024, dst, nb * 32, nb * 32, kb * 64, scr, lane); }
    }
}

template <int NOUT, bool F32OUT>
__device__ __forceinline__ void norm_phase(const float* X, const float* g0, const float* mod0, void* out0, const float* g1, const float* mod1, void* out1) {
    int tid_ = threadIdx.x; asm volatile("" : "+v"(tid_));
    const int tid = tid_, lane = tid & 63, wave = tid >> 6;
    const int gw = blockIdx.x * 8 + wave, NGW = gridDim.x * 8;
    for (int row = gw; row < T; row += NGW) {
        const int b = row >> 13;
        const f32x4* xr = (const f32x4*)(X + (size_t)row * D) + lane;
        f32x4 v[4]; float s = 0.f;
#pragma unroll
        for (int j = 0; j < 4; ++j) { v[j] = xr[64 * j]; s += (v[j].x * v[j].x + v[j].y * v[j].y) + (v[j].z * v[j].z + v[j].w * v[j].w); }
        const float rstd = rsqrtf(wave_sum(s) * (1.f / D) + 1e-6f);
#pragma unroll
        for (int o = 0; o < NOUT; ++o) {
            const float* g = o ? g1 : g0; const float* md = (o ? mod1 : mod0) + (size_t)b * MOD_N; void* out = o ? out1 : out0;
#pragma unroll
            for (int j = 0; j < 4; ++j) { const int col = 4 * lane + 256 * j;
                const f32x4 gv = *(const f32x4*)(g + col), sh = *(const f32x4*)(md + col), sc = *(const f32x4*)(md + 1024 + col);
                const f32x4 y = v[j] * rstd * gv * (sc + 1.0f) + sh;
                if (F32OUT) *(f32x4*)((float*)out + (size_t)row * D + col) = y;
                else { u32x2 w; w.x = pk2(y.x, y.y); w.y = pk2(y.z, y.w); *(u32x2*)((bf16*)out + (size_t)row * D + col) = w; } }
        }
    }
}

template <int NOUT, bool F32OUT>
__device__ __forceinline__ void norm_phase_b(const bf16* X, const float* g0, const float* mod0, void* out0, const float* g1, const float* mod1, void* out1) {
    int tid_ = threadIdx.x; asm volatile("" : "+v"(tid_));
    const int tid = tid_, lane = tid & 63, wave = tid >> 6;
    const int gw = blockIdx.x * 8 + wave, NGW = gridDim.x * 8;
    for (int row = gw; row < T; row += NGW) {
        const int b = row >> 13;
        float v[2][8]; float s = 0.f;
#pragma unroll
        for (int j = 0; j < 2; ++j) { const u32x4 xb = *(const u32x4*)(X + (size_t)row * D + 8 * lane + 512 * j);
#pragma unroll
            for (int e = 0; e < 4; ++e) { v[j][2 * e] = __uint_as_float(xb[e] << 16); v[j][2 * e + 1] = __uint_as_float(xb[e] & 0xffff0000u); }
#pragma unroll
            for (int e = 0; e < 8; ++e) s += v[j][e] * v[j][e]; }
        const float rstd = rsqrtf(wave_sum(s) * (1.f / D) + 1e-6f);
#pragma unroll
        for (int o = 0; o < NOUT; ++o) {
            const float* g = o ? g1 : g0; const float* md = (o ? mod1 : mod0) + (size_t)b * MOD_N; void* out = o ? out1 : out0;
#pragma unroll
            for (int j = 0; j < 2; ++j) { const int col = 8 * lane + 512 * j; float y[8];
#pragma unroll
                for (int q = 0; q < 2; ++q) { const f32x4 gv = *(const f32x4*)(g + col + 4 * q), sh = *(const f32x4*)(md + col + 4 * q), sc = *(const f32x4*)(md + 1024 + col + 4 * q);
#pragma unroll
                    for (int e = 0; e < 4; ++e) y[4 * q + e] = v[j][4 * q + e] * rstd * gv[e] * (sc[e] + 1.0f) + sh[e]; }
                if (F32OUT) { *(f32x4*)((float*)out + (size_t)row * D + col) = (f32x4){y[0], y[1], y[2], y[3]}; *(f32x4*)((float*)out + (size_t)row * D + col + 4) = (f32x4){y[4], y[5], y[6], y[7]}; }
                else { u32x4 w; w.x = pk2(y[0], y[1]); w.y = pk2(y[2], y[3]); w.z = pk2(y[4], y[5]); w.w = pk2(y[6], y[7]); *(u32x4*)((bf16*)out + (size_t)row * D + col) = w; } }
        }
    }
}

__device__ __forceinline__ void fixup_mamba(const float* P, const float* UH, const float* cw, const float* cb, bf16* XBC) {
    const int total = 128 * 3 * 4096;
    for (int i = blockIdx.x * NTHR + threadIdx.x; i < total; i += gridDim.x * NTHR) {
        const int ch = i & 4095, r = (i >> 12) % 3, pm = i / (3 * 4096); const int c = ch;
        float v = P[((size_t)pm * 3 + r) * 4096 + c];
        if (pm & 31) { for (int k = r + 1; k <= 3; ++k) v += cw[(3 - k) * 4096 + ch] * UH[((size_t)(pm - 1) * 3 + (3 + r - k)) * 4096 + c]; }
        XBC[(size_t)(pm * 256 + r) * 4096 + ch] = (bf16)f2bf(silu_f(v));
    }
}
__device__ __forceinline__ void fixup_ffn(const float* P, const float* UH, const float* cw, const float* cb, bf16* G) {
    const int total = 128 * 2 * 2816;
    for (int i = blockIdx.x * NTHR + threadIdx.x; i < total; i += gridDim.x * NTHR) {
        const int j = i % 2816, r = (i / 2816) & 1, pm = i / (2 * 2816); const int cg_ = (j >> 7) * 256 + (j & 127), cv_ = cg_ + 128;
        float g = P[((size_t)pm * 2 + r) * 5632 + cg_], v = P[((size_t)pm * 2 + r) * 5632 + cv_];
        if (pm & 31) { for (int k = r + 1; k <= 2; ++k) { const size_t ro = ((size_t)(pm - 1) * 2 + (2 + r - k)) * 5632;
            g += cw[(2 - k) * 5632 + j] * UH[ro + cg_]; v += cw[(2 - k) * 5632 + 2816 + j] * UH[ro + cv_]; } }
        G[(size_t)(pm * 256 + r) * 2816 + j] = (bf16)f2bf(silu_f(g) * v);
    }
}

constexpr int SSD_CS = 0, SSD_BS = 34816, SSD_XT = 69632, SSD_XDT = 78336, SSD_HS0 = 87040, SSD_HS1 = 95744, SSD_ACS = 104448, SSD_WSCR = 104960;
__device__ __forceinline__ void acs_phase(const float* DT, const float* a_log, float* ACS) {
    const int lane = threadIdx.x & 63, wave = threadIdx.x >> 6;
    const int h = lane & 31, sub = lane >> 5; const float A = -__expf(a_log[h]);
    for (int task = blockIdx.x * 8 + wave; task < 256; task += gridDim.x * 8) {
        const size_t tok0 = (size_t)task * 128 + sub * 64;
        float s = 0.f;
#pragma unroll 8
        for (int i = 0; i < 64; ++i) s += DT[(tok0 + i) * 32 + h] * A;
        const float s0 = __shfl(s, h);
        float run = sub ? s0 : 0.f;
#pragma unroll 8
        for (int i = 0; i < 64; ++i) { run += DT[(tok0 + i) * 32 + h] * A; ACS[(tok0 + i) * 32 + h] = run; }
    }
}
template <int LT> __device__ __forceinline__ void ssd_diag(const LAS bf16* Bs, const LAS bf16* XTs, const LAS float* acs_s, const bf16x8 (&cf)[4], float acs_l, int r16, int quad, f32x4 (&Yd)[2]) {
#pragma unroll
    for (int t = 0; t <= (LT >> 1); ++t) {
        f32x4 mm[2];
#pragma unroll
        for (int hf = 0; hf < 2; ++hf) { const int st = 2 * t + hf; mm[hf] = (f32x4){0.f, 0.f, 0.f, 0.f};
            if (st <= LT) { f32x4 acc = (f32x4){0.f, 0.f, 0.f, 0.f};
#pragma unroll
                for (int ks = 0; ks < 4; ++ks) { const bf16x8 af = *(const LAS bf16x8*)(Bs + (16 * st + r16) * 136 + ks * 32 + quad * 8); acc = MFMA16(af, cf[ks], acc); }
                const f32x4 as4 = *(const LAS f32x4*)(acs_s + 16 * st + 4 * quad);
#pragma unroll
                for (int j = 0; j < 4; ++j) { const float v = acc[j] * __expf(acs_l - as4[j]); mm[hf][j] = (st == LT && (4 * quad + j > r16)) ? 0.f : v; } } }
        u32x4 mp; mp.x = pk2(mm[0][0], mm[0][1]); mp.y = pk2(mm[0][2], mm[0][3]); mp.z = pk2(mm[1][0], mm[1][1]); mp.w = pk2(mm[1][2], mm[1][3]);
        const bf16x8 mf = __builtin_bit_cast(bf16x8, mp);
#pragma unroll
        for (int pt = 0; pt < 2; ++pt) { const LAS bf16* xp = XTs + (16 * pt + r16) * 136 + 32 * t + 4 * quad;
            const u32x2 lo = *(const LAS u32x2*)xp, hi = *(const LAS u32x2*)(xp + 16);
            const bf16x8 xf = __builtin_bit_cast(bf16x8, ((u32x4){lo.x, lo.y, hi.x, hi.y}));
            Yd[pt] = MFMA16(mf, xf, Yd[pt]); }
    }
}
__device__ __forceinline__ void ssreduce_phase(const float* PS, float* RS) {
    for (int t = blockIdx.x * NTHR + threadIdx.x; t < T; t += gridDim.x * NTHR) { float s = 0.f;
#pragma unroll 16
        for (int q = 0; q < 64; ++q) s += PS[(size_t)q * T + t];
        RS[t] = rsqrtf(s * (1.0f / 2048.0f) + 1e-6f); }
}
template <bool REAL, int MODE = 15> __device__ __forceinline__ void ssd_phase(const bf16* XBC, bf16* Zb, const float* DT, const float* ACS, const float* a_log, const float* d_skip, const float* normg, float* SUMSQ, LAS unsigned char* L) {
    int tid_ = threadIdx.x; asm volatile("" : "+v"(tid_));
    const int tid = tid_, lane = tid & 63, w = __builtin_amdgcn_readfirstlane(tid >> 6), r16 = lane & 15, quad = lane >> 4;
    LAS bf16* Cs = (LAS bf16*)(L + SSD_CS); LAS bf16* Bs = (LAS bf16*)(L + SSD_BS); LAS bf16* XTs = (LAS bf16*)(L + SSD_XT); LAS bf16* XDs = (LAS bf16*)(L + SSD_XDT);
    LAS float* acs_s = (LAS float*)(L + SSD_ACS);
    LAS bf16* Wx = (LAS bf16*)(L + SSD_WSCR + w * 3840); LAS bf16* Wz = Wx + 640; LAS bf16* Wy = Wx + 1280;
    const int lt = w < 4 ? w : 11 - w;
    const int vcu = (gridDim.x == 256) ? (int)((blockIdx.x & 7) * 32 + (blockIdx.x >> 3)) : (int)blockIdx.x;
    for (int unit = vcu; unit < 256; unit += gridDim.x) {
        const int b = unit >> 6, h = (unit >> 1) & 31, ph = unit & 1, g = h >> 2;
        const float Dh = d_skip[h];
        const int xcol = h * 64 + ph * 32;
        const float ng0 = normg[xcol + r16], ng1 = normg[xcol + 16 + r16];
        for (int i = tid; i < 8704 / 4; i += NTHR) ((LAS unsigned*)(L + SSD_HS0))[i] = 0u;
        f32x4 Hst[2][2]; Hst[0][0] = Hst[0][1] = Hst[1][0] = Hst[1][1] = (f32x4){0.f, 0.f, 0.f, 0.f};
        int hb = 0;
        const int srow = tid >> 4, sg = tid & 15, lr = lane >> 2, part = lane & 3, lx = 16 * lt + lr;
        u32x4 cv[4], bv[4], xv, zv; float dtl, acl, aclast, a01;
#define SSD_LOAD(c_) do { const size_t tk = (size_t)b * SEQ + (size_t)(c_) * 128; \
            _Pragma("unroll") for (int i = 0; i < 4; ++i) { const bf16* src = XBC + (tk + srow + 32 * i) * 4096 + g * 128 + sg * 8; cv[i] = *(const u32x4*)(src + 3072); bv[i] = *(const u32x4*)(src + 2048); } \
            xv = *(const u32x4*)(XBC + (tk + lx) * 4096 + xcol + part * 8); zv = *(const u32x4*)(Zb + (tk + lx) * 2048 + xcol + part * 8); \
            dtl = DT[(tk + lx) * 32 + h]; acl = ACS[(tk + lx) * 32 + h]; aclast = ACS[(tk + 127) * 32 + h]; a01 = ACS[(tk + 2 * w * 0 + (tid & 127)) * 32 + h]; } while (0)
        SSD_LOAD(0);
        for (int c = 0; c < 64; ++c) {
            const size_t tok0 = (size_t)b * SEQ + (size_t)c * 128;
#pragma unroll
            for (int i = 0; i < 4; ++i) { const int l = srow + 32 * i; *(LAS u32x4*)(Cs + l * 136 + sg * 8) = cv[i]; *(LAS u32x4*)(Bs + l * 136 + sg * 8) = bv[i]; }
            if (tid < 128) acs_s[tid] = a01;
            const float acs_last = aclast;
            { const float dec = __expf(acs_last - acl);
                *(LAS u32x4*)(Wx + lr * 40 + part * 8) = xv; *(LAS u32x4*)(Wz + lr * 40 + part * 8) = zv;
#pragma unroll
                for (int e = 0; e < 8; ++e) { const unsigned xb = (xv[e >> 1] >> (16 * (e & 1))) & 0xffffu; const float xd = bf2f(xb) * dtl;
                    XTs[(part * 8 + e) * 136 + lx] = (bf16)f2bf(xd); XDs[(part * 8 + e) * 136 + lx] = (bf16)f2bf(xd * dec); } }
            __syncthreads();
            if (c < 63) SSD_LOAD(c + 1);
            __builtin_amdgcn_sched_barrier(0);
            bf16x8 cf[4];
#pragma unroll
            for (int ks = 0; ks < 4; ++ks) cf[ks] = *(const LAS bf16x8*)(Cs + (16 * lt + r16) * 136 + ks * 32 + quad * 8);
            const float acs_l = acs_s[16 * lt + r16];
            f32x4 Yd[2], Yo[2]; Yd[0] = Yd[1] = Yo[0] = Yo[1] = (f32x4){0.f, 0.f, 0.f, 0.f};
            if constexpr ((MODE & 1) != 0)
            switch (lt) {
                case 0: ssd_diag<0>(Bs, XTs, acs_s, cf, acs_l, r16, quad, Yd); break; case 1: ssd_diag<1>(Bs, XTs, acs_s, cf, acs_l, r16, quad, Yd); break;
                case 2: ssd_diag<2>(Bs, XTs, acs_s, cf, acs_l, r16, quad, Yd); break; case 3: ssd_diag<3>(Bs, XTs, acs_s, cf, acs_l, r16, quad, Yd); break;
                case 4: ssd_diag<4>(Bs, XTs, acs_s, cf, acs_l, r16, quad, Yd); break; case 5: ssd_diag<5>(Bs, XTs, acs_s, cf, acs_l, r16, quad, Yd); break;
                case 6: ssd_diag<6>(Bs, XTs, acs_s, cf, acs_l, r16, quad, Yd); break; default: ssd_diag<7>(Bs, XTs, acs_s, cf, acs_l, r16, quad, Yd); break; }
            if constexpr ((MODE & 2) != 0)
            { const LAS bf16* Hc = (const LAS bf16*)(L + (hb ? SSD_HS1 : SSD_HS0));
#pragma unroll
                for (int pt = 0; pt < 2; ++pt)
#pragma unroll
                    for (int ks = 0; ks < 4; ++ks) { const bf16x8 hf = *(const LAS bf16x8*)(Hc + (16 * pt + r16) * 136 + ks * 32 + quad * 8); Yo[pt] = MFMA16(cf[ks], hf, Yo[pt]); } }
            if constexpr ((MODE & 4) != 0) {
            float ssq[4] = {0.f, 0.f, 0.f, 0.f};
            { const f32x4 al4 = *(const LAS f32x4*)(acs_s + 16 * lt + 4 * quad);
#pragma unroll
            for (int j = 0; j < 4; ++j) { const int lrow = 4 * quad + j; const float el = __expf(al4[j]);
#pragma unroll
                for (int pt = 0; pt < 2; ++pt) { const int pcol = 16 * pt + r16;
                    float y = Yd[pt][j] + el * Yo[pt][j];
                    y += Dh * bf2f(Wx[lrow * 40 + pcol]);
                    const float gz = y * silu_f(bf2f(Wz[lrow * 40 + pcol])); ssq[j] += gz * gz;
                    Wy[lrow * 40 + pcol] = (bf16)f2bf(gz * (pt ? ng1 : ng0)); } } }
#pragma unroll
            for (int j = 0; j < 4; ++j) { float v = ssq[j]; v += __shfl_xor(v, 1); v += __shfl_xor(v, 2); v += __shfl_xor(v, 4); v += __shfl_xor(v, 8); ssq[j] = v; }
            { const float sv = r16 == 0 ? ssq[0] : r16 == 1 ? ssq[1] : r16 == 2 ? ssq[2] : ssq[3];
                if (r16 < 4) SUMSQ[(size_t)(h * 2 + ph) * T + tok0 + 16 * lt + 4 * quad + r16] = sv; }
            asm volatile("s_waitcnt lgkmcnt(0)" ::: "memory");
            { const u32x4 yv = *(const LAS u32x4*)(Wy + lr * 40 + part * 8);
                if (REAL) *(u32x4*)(Zb + (tok0 + 16 * lt + lr) * 2048 + xcol + part * 8) = yv; }
            } else { if (Yd[0][0] + Yd[1][0] + Yo[0][0] + Yo[1][0] == 12345.f) Wy[0] = 1; }
            if (((MODE & 8) != 0) && w < 4) {
                f32x4 a4[2][2];
#pragma unroll
                for (int q = 0; q < 2; ++q) a4[q][0] = a4[q][1] = (f32x4){0.f, 0.f, 0.f, 0.f};
#pragma unroll
                for (int ks = 0; ks < 4; ++ks) { bf16x8 af[2];
#pragma unroll
                    for (int pt = 0; pt < 2; ++pt) af[pt] = *(const LAS bf16x8*)(XDs + (16 * pt + r16) * 136 + ks * 32 + quad * 8);
#pragma unroll
                    for (int q = 0; q < 2; ++q) { bf16x8 bfr;
#pragma unroll
                        for (int j = 0; j < 8; ++j) bfr[j] = (short)Bs[(ks * 32 + quad * 8 + j) * 136 + 16 * (2 * w + q) + r16];
#pragma unroll
                        for (int pt = 0; pt < 2; ++pt) a4[q][pt] = MFMA16(af[pt], bfr, a4[q][pt]); } }
                const float cd = __expf(acs_last);
                LAS bf16* Hn = (LAS bf16*)(L + (hb ? SSD_HS0 : SSD_HS1));
#pragma unroll
                for (int q = 0; q < 2; ++q)
#pragma unroll
                    for (int pt = 0; pt < 2; ++pt)
#pragma unroll
                        for (int j = 0; j < 4; ++j) { const float hv = Hst[q][pt][j] * cd + a4[q][pt][j]; Hst[q][pt][j] = hv; Hn[(16 * pt + 4 * quad + j) * 136 + 16 * (2 * w + q) + r16] = (bf16)f2bf(hv); }
            }
            hb ^= 1;
            __syncthreads();
        }
#undef SSD_LOAD
    }
}

constexpr int AT_KS = 0, AT_VS = 18432, AT_SMAX = 35840;
template <bool DIAG> __device__ __forceinline__ float att_elem(f32x4 (&S)[8], float suffix, int q_rel, int quad) {
    f32x4 Lg[8];
#pragma unroll
    for (int kt = 0; kt < 8; ++kt) { const f32x4 y = S[kt]; f32x4 sp;
#pragma unroll
        for (int j = 0; j < 4; ++j) sp[j] = __builtin_amdgcn_logf(1.0f + __builtin_amdgcn_exp2f(-__builtin_fabsf(y[j])));
        f32x4 lg = -(sp + __builtin_elementwise_max(y, (f32x4){0.f, 0.f, 0.f, 0.f}));
        if (DIAG) {
#pragma unroll
            for (int j = 0; j < 4; ++j) if (!(16 * kt + 4 * quad + j < q_rel)) lg[j] = 0.f; }
        lg[2] += lg[3]; lg[1] += lg[2]; lg[0] += lg[1]; Lg[kt] = lg; }
    float tail = 0.f;
#pragma unroll
    for (int kt = 7; kt >= 0; --kt) { const float a = Lg[kt][0]; const float bq = __shfl_xor(a, 16), cq = __shfl_xor(a, 32), dq = __shfl_xor(bq, 32);
        const float E = quad == 0 ? (bq + cq + dq) : quad == 1 ? (cq + dq) : quad == 2 ? bq : 0.f;
        Lg[kt] = Lg[kt] + (E + tail);
        tail += (a + bq) + (cq + dq); }
#pragma unroll
    for (int kt = 0; kt < 8; ++kt) { const f32x4 lw = (S[kt] + Lg[kt]) + suffix;
#pragma unroll
        for (int j = 0; j < 4; ++j) { float wv = __builtin_amdgcn_exp2f(lw[j]); if (DIAG && !(16 * kt + 4 * quad + j < q_rel)) wv = 0.f; S[kt][j] = wv; } }
    return tail;
}
template <bool REAL> __device__ __forceinline__ void attn_phase(bf16* QO, const bf16* Kb, const bf16* VT, LAS unsigned char* L) {
    int tid_ = threadIdx.x; asm volatile("" : "+v"(tid_));
    const int tid = tid_, lane = tid & 63, w = __builtin_amdgcn_readfirstlane(tid >> 6), r16 = lane & 15, quad = lane >> 4;
    LAS bf16* Ks = (LAS bf16*)(L + AT_KS); LAS bf16* Vs = (LAS bf16*)(L + AT_VS); LAS float* smax_s = (LAS float*)(L + AT_SMAX);
    const int ks_s = tid >> 2, ks_p = tid & 3, vs_d = tid >> 3, vs_p = tid & 7;
    u32x4 pk0, pk1, pv0, pv1; bf16x8 qn[2];
#define ATT_LOAD(b_, h_, kb_) do { const bf16* src = Kb + ((size_t)(b_) * SEQ + (kb_) * 128 + ks_s) * 1024 + (h_) * 64 + ks_p * 16; pk0 = *(const u32x4*)src; pk1 = *(const u32x4*)(src + 8); \
        const bf16* vsrc = VT + (size_t)((h_) * 64 + vs_d) * T + (size_t)(b_) * SEQ + (kb_) * 128 + vs_p * 16; pv0 = *(const u32x4*)vsrc; pv1 = *(const u32x4*)(vsrc + 8); } while (0)
#define ATT_QLOAD(b_, h_, qb_) do { const size_t rq_ = (size_t)(b_) * SEQ + (qb_) * 128 + 16 * w; \
        _Pragma("unroll") for (int ks = 0; ks < 2; ++ks) qn[ks] = *(const bf16x8*)(QO + (rq_ + r16) * 1024 + (h_) * 64 + ks * 32 + quad * 8); } while (0)
    if ((int)blockIdx.x < 4096) { const int u0 = blockIdx.x, bh0 = u0 & 63, qb0 = 63 - (u0 >> 6); ATT_QLOAD(bh0 >> 4, bh0 & 15, qb0); ATT_LOAD(bh0 >> 4, bh0 & 15, qb0); }
    for (int unit = blockIdx.x; unit < 4096; unit += gridDim.x) {
        const int bh = unit & 63, qb = 63 - (unit >> 6), b = bh >> 4, h = bh & 15;
        const size_t rowq = (size_t)b * SEQ + qb * 128 + 16 * w;
        bf16x8 qf[2]; qf[0] = qn[0]; qf[1] = qn[1];
        f32x4 O[4]; O[0] = O[1] = O[2] = O[3] = (f32x4){0.f, 0.f, 0.f, 0.f};
        float suffix = 0.f, wsm = 0.f;
        const int q_rel = 16 * w + r16;
        for (int kb = qb; kb >= 0; --kb) {
            *(LAS u32x4*)(Ks + ks_s * 72 + ks_p * 16) = pk0; *(LAS u32x4*)(Ks + ks_s * 72 + ks_p * 16 + 8) = pk1;
            *(LAS u32x4*)(Vs + vs_d * 136 + vs_p * 16) = pv0; *(LAS u32x4*)(Vs + vs_d * 136 + vs_p * 16 + 8) = pv1;
            __syncthreads();
            if (kb > 0) ATT_LOAD(b, h, kb - 1);
            __builtin_amdgcn_sched_barrier(0);
            if (wsm > -160.f) {
                const bool diag = (kb == qb);
                f32x4 S[8];
#pragma unroll
                for (int kt = 0; kt < 8; ++kt) { S[kt] = (f32x4){0.f, 0.f, 0.f, 0.f};
#pragma unroll
                    for (int ks = 0; ks < 2; ++ks) { const bf16x8 kf = *(const LAS bf16x8*)(Ks + (16 * kt + r16) * 72 + ks * 32 + quad * 8); S[kt] = MFMA16(kf, qf[ks], S[kt]); } }
                const float tail = diag ? att_elem<true>(S, suffix, q_rel, quad) : att_elem<false>(S, suffix, q_rel, quad);
                suffix += tail;
#pragma unroll
                for (int t = 0; t < 4; ++t) { u32x4 wp; wp.x = pk2(S[2 * t][0], S[2 * t][1]); wp.y = pk2(S[2 * t][2], S[2 * t][3]); wp.z = pk2(S[2 * t + 1][0], S[2 * t + 1][1]); wp.w = pk2(S[2 * t + 1][2], S[2 * t + 1][3]);
                    const bf16x8 wf = __builtin_bit_cast(bf16x8, wp);
#pragma unroll
                    for (int dt = 0; dt < 4; ++dt) { const LAS bf16* vp = Vs + (16 * dt + r16) * 136 + 32 * t + 4 * quad;
                        const u32x2 lo = *(const LAS u32x2*)vp, hi = *(const LAS u32x2*)(vp + 16);
                        const bf16x8 vf = __builtin_bit_cast(bf16x8, ((u32x4){lo.x, lo.y, hi.x, hi.y}));
                        O[dt] = MFMA16(wf, vf, O[dt]); } }
                float sm = suffix; sm = fmaxf(sm, __shfl_xor(sm, 1)); sm = fmaxf(sm, __shfl_xor(sm, 2)); sm = fmaxf(sm, __shfl_xor(sm, 4)); sm = fmaxf(sm, __shfl_xor(sm, 8));
                wsm = sm;
            }
            if (lane == 0) smax_s[w] = wsm;
            __syncthreads();
            float mall = smax_s[0];
#pragma unroll
            for (int i = 1; i < 8; ++i) mall = fmaxf(mall, smax_s[i]);
            if (mall < -160.f) break;
        }
        { const int nu = unit + gridDim.x; if (nu < 4096) { const int nbh = nu & 63, nqb = 63 - (nu >> 6); ATT_QLOAD(nbh >> 4, nbh & 15, nqb); ATT_LOAD(nbh >> 4, nbh & 15, nqb); } }
        __builtin_amdgcn_sched_barrier(0);
#pragma unroll
        for (int dt = 0; dt < 4; ++dt)
#pragma unroll
            for (int j = 0; j < 4; ++j) if (REAL) QO[(rowq + 4 * quad + j) * 1024 + h * 64 + 16 * dt + r16] = (bf16)f2bf(O[dt][j]);
    }
}
#undef ATT_LOAD
#undef ATT_QLOAD

#define XB_TMO      128
#define XB_XCNT(j)  (256  + 64 * (j))
#define XB_XSUB(j)  (1280 + 64 * (j))
#define XB_XGEN(j)  (2304 + 64 * (j))
#define XB_TOP      3328
#define XB_TOPGEN   3392
#define XCD_BAR_WORDS 3456
#define XB_SPIN_CAP (1u << 20)

__device__ __forceinline__ unsigned xb_ld(unsigned* p)              { return __hip_atomic_load(p, __ATOMIC_RELAXED, __HIP_MEMORY_SCOPE_AGENT); }
__device__ __forceinline__ unsigned xb_add(unsigned* p, unsigned v) { return __hip_atomic_fetch_add(p, v, __ATOMIC_RELAXED, __HIP_MEMORY_SCOPE_AGENT); }
__device__ __forceinline__ unsigned xb_xcc_id() { return (unsigned)__builtin_amdgcn_s_getreg((3 << 11) | 20) & 0xFu; }
#define XB_SPIN(cond, bar) do { unsigned _sp = 0; while (cond) { __builtin_amdgcn_s_sleep(1); \
    if ((++_sp & 255u) == 0u) { if (xb_ld(&(bar)[XB_TMO])) break; if (_sp > XB_SPIN_CAP) { atomicAdd(&(bar)[XB_TMO], 1u); break; } } } } while (0)

struct XcdBarrier {
    unsigned* bar; unsigned x;
    volatile LAS unsigned* st;
};

__device__ __forceinline__ XcdBarrier xcd_barrier_post(unsigned* bar, volatile LAS unsigned* st) {
    XcdBarrier b; b.bar = bar; b.x = xb_xcc_id(); b.st = st;
    if (threadIdx.x == 0) (void)xb_add(&bar[XB_XCNT(b.x)], 1u);
    return b;
}
__device__ __forceinline__ void xcd_barrier_complete(unsigned* bar, unsigned x, unsigned& nloc, unsigned& nx) {
    const unsigned G = gridDim.x * gridDim.y * gridDim.z;
    unsigned sum, cnt, mine, sp = 0u;
    for (;;) {
        sum = 0u; cnt = 0u; mine = 0u;
#pragma unroll
        for (unsigned j = 0; j < 16; ++j) { const unsigned c = xb_ld(&bar[XB_XCNT(j)]); sum += c; cnt += (c > 0u) ? 1u : 0u; mine = (j == x) ? c : mine; }
        if (sum == G) break;
        __builtin_amdgcn_s_sleep(1);
        if ((++sp & 255u) == 0u) { if (xb_ld(&bar[XB_TMO])) break; if (sp > XB_SPIN_CAP) { atomicAdd(&bar[XB_TMO], 1u); break; } }
    }
    nloc = mine > 0u ? mine : 1u; nx = cnt > 0u ? cnt : 1u;
}

__device__ __forceinline__ void xcd_barrier(const XcdBarrier& b) {
    asm volatile("s_waitcnt vmcnt(0)" ::: "memory");
    __syncthreads();
    if (threadIdx.x == 0) {
        unsigned* bar = b.bar;
        __builtin_amdgcn_s_waitcnt(0);
        unsigned nloc = b.st[0], nx = b.st[1];
        if (nloc == 0u) { xcd_barrier_complete(bar, b.x, nloc, nx); b.st[0] = nloc; b.st[1] = nx; }
        const unsigned old = xb_add(&bar[XB_XSUB(b.x)], 1u);
        const unsigned gen = old / nloc;
        if (old + 1u == (gen + 1u) * nloc) {
            __builtin_amdgcn_fence(__ATOMIC_RELEASE, "agent");
            asm volatile("s_waitcnt vmcnt(0)" ::: "memory");
            const unsigned og = xb_add(&bar[XB_TOP], 1u);
            const unsigned tg = og / nx;
            if (og + 1u == (tg + 1u) * nx) xb_add(&bar[XB_TOPGEN], 1u);
            else XB_SPIN(xb_ld(&bar[XB_TOPGEN]) == tg, bar);
            __builtin_amdgcn_fence(__ATOMIC_ACQUIRE, "agent");
            xb_add(&bar[XB_XGEN(b.x)], 1u);
            asm volatile("s_waitcnt vmcnt(0)" ::: "memory");
        } else {
            XB_SPIN(xb_ld(&bar[XB_XGEN(b.x)]) == gen, bar);
            __builtin_amdgcn_fence(__ATOMIC_ACQUIRE, "agent");
            asm volatile("s_waitcnt vmcnt(0)" ::: "memory");
        }
    }
    __syncthreads();
}

#ifndef DUPMASK
#define DUPMASK 0
#endif
#ifndef SSD_DMODE
#define SSD_DMODE 15
#endif
#define DUP(k) constexpr ((DUPMASK >> (k)) & 1)
__global__ void __launch_bounds__(NTHR, 2) yoco_fwd(Params p) {
    extern __shared__ __attribute__((aligned(16))) unsigned char lds[];
    LAS unsigned char* L = (LAS unsigned char*)lds;
    cg::grid_group grid = cg::this_grid();
    if (threadIdx.x < 2) ((LAS unsigned*)(L + LDS_BYTES - 16))[threadIdx.x] = 0u;
    __syncthreads();
    const XcdBarrier xbar = xcd_barrier_post((unsigned*)(p.ws + WS_BAR), (volatile LAS unsigned*)(L + LDS_BYTES - 16));
    if (gridDim.x > 65536u) grid.sync();
#define GSYNC() xcd_barrier(xbar)
    unsigned char* ws = p.ws;
    bf16* WB = (bf16*)(ws + WS_W);
    float* MODS = (float*)(ws + WS_MODS); float* SUMSQ = (float*)(ws + WS_SUMSQ);
    bf16* X = (bf16*)(ws + WS_X);
    bf16* H0 = (bf16*)(ws + WS_X); float* DTb = (float*)(ws + WS_X + 64 * MiB); float* ACSb = (float*)(ws + WS_X + 92 * MiB); float* PSb = (float*)(ws + WS_X + 96 * MiB); float* P0b = (float*)(ws + WS_X + 68 * MiB); float* UH0 = (float*)(ws + WS_X + 80 * MiB);
    bf16* XBC = (bf16*)(ws + WS_BIG); bf16* Gb = (bf16*)(ws + WS_BIG); bf16* H = (bf16*)(ws + WS_BIG + 176 * MiB);
    float* P1b = (float*)(ws + WS_BIG + 240 * MiB); float* UH1 = (float*)(ws + WS_BIG + 248 * MiB);
    bf16* HK = (bf16*)(ws + WS_BIG); bf16* QO = (bf16*)(ws + WS_BIG + 64 * MiB);
    bf16* Zb = (bf16*)p.out; bf16* Kb = (bf16*)p.out; bf16* VT = (bf16*)((unsigned char*)p.out + 64 * MiB);
    LAS float* xch = (LAS float*)(L + XCH_OFF);
    const int G_ = gridDim.x, c_ = blockIdx.x;
    using pg8::Gemm; using pg8::StaticOrder;

#ifndef PHM
#define PHM 0xffff
#endif
#define EN(x) constexpr ((PHM >> (x)) & 1)
    unsigned long long* TS = (unsigned long long*)(ws + WS_FLAGS + 4096);
    STAMP(0);
if DUP(1) { if EN(0) p0_phase(p, L); GSYNC(); }
        if EN(0) p0_phase(p, L);
    GSYNC(); STAMP(1);
if DUP(2) { if EN(1) norm_phase<1, false>(p.in[0], p.in[4], MODS + 0, H0, nullptr, nullptr, nullptr); GSYNC(); }
        if EN(1) norm_phase<1, false>(p.in[0], p.in[4], MODS + 0, H0, nullptr, nullptr, nullptr);
    GSYNC(); STAMP(2);
    if DUP(3) { if EN(2) {
        Gemm g{H0, WB + W_IN, T, 2304, 1024}; StaticOrder S; S.init(T, 2304, G_, c_);
        pg8::EpiZdt E{Zb, DTb, p.in[9]};
        pg8::gemm_phase<pg8::EpiZdt, StaticOrder, true, true>(L, g, S, E);
    }
    if EN(2) {
        Gemm g{H0, WB + W_IN + (size_t)2304 * 1024, T, 4096, 1024}; StaticOrder S; S.init(T, 4096, G_, c_);
        pg8::EpiMamba E{XBC, P0b, UH0, p.in[7], p.in[8], xch};
        pg8::gemm_phase<pg8::EpiMamba, StaticOrder, true, true>(L, g, S, E);
    } GSYNC(); }
    if EN(2) {
        Gemm g{H0, WB + W_IN, T, 2304, 1024}; StaticOrder S; S.init(T, 2304, G_, c_);
        pg8::EpiZdt E{Zb, DTb, p.in[9]};
        pg8::gemm_phase<pg8::EpiZdt, StaticOrder, true, true>(L, g, S, E);
    }
    if EN(2) {
        Gemm g{H0, WB + W_IN + (size_t)2304 * 1024, T, 4096, 1024}; StaticOrder S; S.init(T, 4096, G_, c_);
        pg8::EpiMamba E{XBC, P0b, UH0, p.in[7], p.in[8], xch};
        pg8::gemm_phase<pg8::EpiMamba, StaticOrder, true, true>(L, g, S, E);
    }
    GSYNC(); STAMP(3);
#ifdef XSYNC
    for (int i = 0; i < XSYNC; ++i) GSYNC();
#endif
    if EN(3) { fixup_mamba(P0b, UH0, p.in[7], p.in[8], XBC); acs_phase(DTb, p.in[10], ACSb); }
    GSYNC(); STAMP(4);
    if DUP(5) { ssd_phase<false, SSD_DMODE>(XBC, Zb, DTb, ACSb, p.in[10], p.in[11], p.in[12], PSb, L); GSYNC(); }
    if EN(4) ssd_phase<true>(XBC, Zb, DTb, ACSb, p.in[10], p.in[11], p.in[12], PSb, L);
    GSYNC();
    ssreduce_phase(PSb, SUMSQ);
    GSYNC(); STAMP(5);
    if DUP(6) { if EN(5) {
        Gemm g{Zb, WB + W_SOUT, T, 1024, 2048}; StaticOrder S; S.init(T, 1024, G_, c_);
        pg8::EpiRes<true> E{p.in[0], X, MODS + 2048, SUMSQ};
        pg8::gemm_phase<pg8::EpiRes<true>, StaticOrder, true, true>(L, g, S, E);
    } GSYNC(); }
    if EN(5) {
        Gemm g{Zb, WB + W_SOUT, T, 1024, 2048}; StaticOrder S; S.init(T, 1024, G_, c_);
        pg8::EpiRes<true> E{p.in[0], X, MODS + 2048, SUMSQ};
        pg8::gemm_phase<pg8::EpiRes<true>, StaticOrder, true, true>(L, g, S, E);
    }
    GSYNC(); STAMP(6);
    {
        const float* md = MODS;
if DUP(7) { norm_phase_b<1, false>(X, p.in[5] + 0, md + 3072, H, nullptr, nullptr, nullptr); GSYNC(); }
            norm_phase_b<1, false>(X, p.in[5] + 0, md + 3072, H, nullptr, nullptr, nullptr);
        GSYNC(); STAMP(7);
        if DUP(8) { if EN(9) { Gemm g{H, WB + (W_FIN0), T, 5632, 1024}; StaticOrder S; S.init(T, 5632, G_, c_);
          pg8::EpiFFN E{Gb, P1b, UH1, p.in[22] + 0, p.in[23] + 0, xch};
          pg8::gemm_phase<pg8::EpiFFN, StaticOrder, true, true>(L, g, S, E); } GSYNC(); }
    if EN(9) { Gemm g{H, WB + (W_FIN0), T, 5632, 1024}; StaticOrder S; S.init(T, 5632, G_, c_);
          pg8::EpiFFN E{Gb, P1b, UH1, p.in[22] + 0, p.in[23] + 0, xch};
          pg8::gemm_phase<pg8::EpiFFN, StaticOrder, true, true>(L, g, S, E); }
        GSYNC(); STAMP(8);
        if EN(10) fixup_ffn(P1b, UH1, p.in[22] + 0, p.in[23] + 0, Gb);
        GSYNC(); STAMP(9);
        if DUP(10) { if EN(11) { Gemm g{Gb, WB + (W_FOUT0), T, 1024, 2816}; StaticOrder S; S.init(T, 1024, G_, c_); pg8::EpiRes<false> E{X, (bf16*)p.out, md + 5120, nullptr};
          pg8::gemm_phase<pg8::EpiRes<false>, StaticOrder, true, true>(L, g, S, E); } GSYNC(); }
    if EN(11) { Gemm g{Gb, WB + (W_FOUT0), T, 1024, 2816}; StaticOrder S; S.init(T, 1024, G_, c_); pg8::EpiRes<false> E{X, X, md + 5120, nullptr};
          pg8::gemm_phase<pg8::EpiRes<false>, StaticOrder, true, true>(L, g, S, E); }
        GSYNC(); STAMP(10);
    }
    {
        const float* md = MODS + MOD_L;
if DUP(11) { norm_phase_b<2, false>(X, p.in[16], MODS + MOD_KV, HK, p.in[4] + 1024, md + 0, H); GSYNC(); }
                norm_phase_b<2, false>(X, p.in[16], MODS + MOD_KV, HK, p.in[4] + 1024, md + 0, H);
            GSYNC(); STAMP(11);
            if DUP(12) { if EN(6) { Gemm g{HK, WB + W_K, T, 1024, 1024}; StaticOrder S; S.init(T, 1024, G_, c_); pg8::EpiStore E{Kb, 1024, 1.0f};
              pg8::gemm_phase<pg8::EpiStore, StaticOrder, true, true>(L, g, S, E); }
            if EN(6) { Gemm g{WB + W_V, HK, 1024, T, 1024}; StaticOrder S; S.init(1024, T, G_, c_); pg8::EpiStore E{VT, T, 1.0f};
              pg8::gemm_phase<pg8::EpiStore, StaticOrder, true, true>(L, g, S, E); }
            if EN(6) { Gemm g{H, WB + W_Q, T, 1024, 1024}; StaticOrder S; S.init(T, 1024, G_, c_); pg8::EpiStore E{QO, 1024, 0.125f * 1.4426950408889634f};
              pg8::gemm_phase<pg8::EpiStore, StaticOrder, true, true>(L, g, S, E); } GSYNC(); }
    if EN(6) { Gemm g{HK, WB + W_K, T, 1024, 1024}; StaticOrder S; S.init(T, 1024, G_, c_); pg8::EpiStore E{Kb, 1024, 1.0f};
              pg8::gemm_phase<pg8::EpiStore, StaticOrder, true, true>(L, g, S, E); }
            if EN(6) { Gemm g{WB + W_V, HK, 1024, T, 1024}; StaticOrder S; S.init(1024, T, G_, c_); pg8::EpiStore E{VT, T, 1.0f};
              pg8::gemm_phase<pg8::EpiStore, StaticOrder, true, true>(L, g, S, E); }
            if EN(6) { Gemm g{H, WB + W_Q, T, 1024, 1024}; StaticOrder S; S.init(T, 1024, G_, c_); pg8::EpiStore E{QO, 1024, 0.125f * 1.4426950408889634f};
              pg8::gemm_phase<pg8::EpiStore, StaticOrder, true, true>(L, g, S, E); }
            GSYNC(); STAMP(12);
            if DUP(13) { attn_phase<false>(QO, Kb, VT, L); GSYNC(); }
            if EN(7) attn_phase<true>(QO, Kb, VT, L);
            GSYNC(); STAMP(13);
            if DUP(14) { if EN(8) { Gemm g{QO, WB + W_O, T, 1024, 1024}; StaticOrder S; S.init(T, 1024, G_, c_); pg8::EpiRes<false> E{X, (bf16*)p.out, md + 2048, nullptr};
              pg8::gemm_phase<pg8::EpiRes<false>, StaticOrder, true, true>(L, g, S, E); } GSYNC(); }
    if EN(8) { Gemm g{QO, WB + W_O, T, 1024, 1024}; StaticOrder S; S.init(T, 1024, G_, c_); pg8::EpiRes<false> E{X, X, md + 2048, nullptr};
              pg8::gemm_phase<pg8::EpiRes<false>, StaticOrder, true, true>(L, g, S, E); }
            GSYNC(); STAMP(14);
if DUP(15) { norm_phase_b<1, false>(X, p.in[5] + 1024, md + 3072, H, nullptr, nullptr, nullptr); GSYNC(); }
            norm_phase_b<1, false>(X, p.in[5] + 1024, md + 3072, H, nullptr, nullptr, nullptr);
        GSYNC(); STAMP(15);
        if DUP(16) { if EN(9) { Gemm g{H, WB + (W_FIN1), T, 5632, 1024}; StaticOrder S; S.init(T, 5632, G_, c_);
          pg8::EpiFFN E{Gb, P1b, UH1, p.in[22] + 16896, p.in[23] + 5632, xch};
          pg8::gemm_phase<pg8::EpiFFN, StaticOrder, true, true>(L, g, S, E); } GSYNC(); }
    if EN(9) { Gemm g{H, WB + (W_FIN1), T, 5632, 1024}; StaticOrder S; S.init(T, 5632, G_, c_);
          pg8::EpiFFN E{Gb, P1b, UH1, p.in[22] + 16896, p.in[23] + 5632, xch};
          pg8::gemm_phase<pg8::EpiFFN, StaticOrder, true, true>(L, g, S, E); }
        GSYNC(); STAMP(16);
        if EN(10) fixup_ffn(P1b, UH1, p.in[22] + 16896, p.in[23] + 5632, Gb);
        GSYNC(); STAMP(17);
        if DUP(18) { if EN(11) { Gemm g{Gb, WB + (W_FOUT1), T, 1024, 2816}; StaticOrder S; S.init(T, 1024, G_, c_); pg8::EpiRes<false> E{X, (bf16*)p.out, md + 5120, nullptr};
          pg8::gemm_phase<pg8::EpiRes<false>, StaticOrder, true, true>(L, g, S, E); } GSYNC(); }
    if EN(11) { Gemm g{Gb, WB + (W_FOUT1), T, 1024, 2816}; StaticOrder S; S.init(T, 1024, G_, c_); pg8::EpiRes<false> E{X, X, md + 5120, nullptr};
          pg8::gemm_phase<pg8::EpiRes<false>, StaticOrder, true, true>(L, g, S, E); }
        GSYNC(); STAMP(18);
    }
if DUP(19) { norm_phase_b<1, true>(X, p.in[27], MODS + MOD_FIN, p.out, nullptr, nullptr, nullptr); GSYNC(); }
        norm_phase_b<1, true>(X, p.in[27], MODS + MOD_FIN, p.out, nullptr, nullptr, nullptr);
#ifdef PROBE
    GSYNC(); STAMP(19);
    __threadfence();
    {   volatile unsigned long long* tsv = TS; float ta = 0.f, tb = 0.f;
        for (int k = 1; k <= 19; ++k) { const float d = (float)(tsv[k] - tsv[k - 1]) * 0.01f; if ((PROBE_A >> k) & 1) ta += d; if ((PROBE_B >> k) & 1) tb += d; }
        for (int i = blockIdx.x * NTHR + threadIdx.x; i < (1 << 22); i += gridDim.x * NTHR) p.out[(1 << 24) + i] = tb;
        if (blockIdx.x == 0 && threadIdx.x == 0) p.out[0] = ta * 10.0f; }
#endif
}

extern "C" void kernel_launch(void* const* d_in, const int* in_sizes, int n_in, void* d_out, int out_size, void* d_ws, size_t ws_size, hipStream_t stream) {
    static int grid = 0;
    if (grid == 0) {
        if (n_in != 28 || out_size != T * D || ws_size < WS_END) { fprintf(stderr, "kernel_launch: unexpected shapes (n_in %d out %d ws %zu)\n", n_in, out_size, ws_size); grid = -1; return; }
        int dev = 0, cus = 0, per_cu = 0;
        hipGetDevice(&dev); hipDeviceGetAttribute(&cus, hipDeviceAttributeMultiprocessorCount, dev);
        hipFuncSetAttribute((const void*)yoco_fwd, hipFuncAttributeMaxDynamicSharedMemorySize, LDS_BYTES);
        hipOccupancyMaxActiveBlocksPerMultiprocessor(&per_cu, (const void*)yoco_fwd, NTHR, LDS_BYTES);
        if (per_cu < 1) per_cu = 1;
        grid = cus * per_cu; if (grid > 256) grid = 256;
        (void)hipGetLastError();
    }
    if (grid < 0) return;
    Params p{};
    for (int i = 0; i < 28; ++i) p.in[i] = (const float*)d_in[i];
    p.out = (float*)d_out; p.ws = (unsigned char*)d_ws;
    (void)hipMemsetAsync((unsigned char*)d_ws + WS_BAR, 0, 16384, stream);
    void* args[] = {&p};
    hipError_t e = hipLaunchCooperativeKernel((const void*)yoco_fwd, dim3(grid), dim3(NTHR), args, LDS_BYTES, stream);
    if (e != hipSuccess) fprintf(stderr, "cooperative launch failed: %s (grid %d)\n", hipGetErrorString(e), grid);
}
```

```cpp
#include <hip/hip_runtime.h>
#include <hip/hip_cooperative_groups.h>
#include <cstdio>
#include <cstdint>
namespace cg = cooperative_groups;
#ifndef DBG
#define DBG 0
#endif
namespace pg8 {
#define PG8_LAS __attribute__((address_space(3)))
typedef unsigned short bf16_t;
typedef short bf16x8 __attribute__((ext_vector_type(8)));
typedef float f32x4 __attribute__((ext_vector_type(4)));
typedef unsigned u32x4 __attribute__((ext_vector_type(4)));
constexpr int BM = 256, BK = 64, HALF = 128, HTB = HALF * BK * 2  , STAGE_BYTES = 8 * HTB, NXCD = 8, WGM = 8;

__host__ __device__ __forceinline__ int lds_byte(int r, int c) { const int st = (r >> 4) * 2 + (c >> 5), rr = r & 15, cc = c & 31, ob = rr * 64 + cc * 2; return st * 1024 + (ob ^ (((ob >> 9) & 1) << 5)); }
__host__ __device__ __forceinline__ void stage_rc(int b, int& R, int& C) { const int st = b / 1024, sb = b % 1024, swz = sb ^ (((sb >> 9) & 1) << 5); R = (st >> 1) * 16 + swz / 64; C = (st & 1) * 32 + (swz % 64) / 2; }
__host__ __device__ __forceinline__ int perm32(int rho) { const int n = rho >> 4, i = rho & 15; return 8 * (i >> 2) + 4 * n + (i & 3); }

struct Unit { int pm, pn; };
struct Gemm { const bf16_t* A; const bf16_t* Bt; int M, N, K; };

struct StaticOrder {
    int nM, nN, nwg, G, c;
    __host__ __device__ void init(int M, int N, int G_, int c_) { nM = M / BM; nN = N / BM; nwg = nM * nN; G = G_; c = c_; }
    __host__ __device__ bool next(int i, Unit& u) const {
        const long L = (long)i * G + c; if (L >= nwg) return false;
        int wgid = (int)L; { const int q = nwg / NXCD, r = nwg % NXCD, xcd = wgid % NXCD, off = wgid / NXCD; wgid = (xcd < r ? xcd * (q + 1) : r * (q + 1) + (xcd - r) * q) + off; }
        const int nig = WGM * nN, gid = wgid / nig, fm = gid * WGM, gsz = (nM - fm) < WGM ? (nM - fm) : WGM;
        u.pm = fm + ((wgid % nig) % gsz); u.pn = (wgid % nig) / gsz; return true;
    }
    __device__ __forceinline__ void a_ready(const Unit&) const {}
    __device__ __forceinline__ void done(const Unit&) const {}
};

__device__ __forceinline__ unsigned cvt_pk_bf16(float lo, float hi) { unsigned r; asm volatile("v_cvt_pk_bf16_f32 %0, %1, %2" : "=v"(r) : "v"(lo), "v"(hi)); return r; }

typedef unsigned u32x2 __attribute__((ext_vector_type(2)));
typedef float f32x2 __attribute__((ext_vector_type(2)));
__device__ __forceinline__ float silu_f(float x) { return x * __builtin_amdgcn_rcpf(1.f + __expf(-x)); }
__device__ __forceinline__ f32x2 silu2(f32x2 x) { const f32x2 t = x * (-1.4426950408889634f); f32x2 d; d.x = __builtin_amdgcn_exp2f(t.x); d.y = __builtin_amdgcn_exp2f(t.y); d = d + 1.0f;
    f32x2 r; r.x = __builtin_amdgcn_rcpf(d.x); r.y = __builtin_amdgcn_rcpf(d.y); return x * r; }
__device__ __forceinline__ float softplus_f(float x) { return fmaxf(x, 0.f) + __logf(1.f + __expf(-fabsf(x))); }
template <int K> __device__ __forceinline__ float dpp_ror(float v) { return __int_as_float(__builtin_amdgcn_update_dpp(0, __float_as_int(v), 0x120 + K, 0xf, 0xf, false)); }
template <int K> __device__ __forceinline__ float dpp_shr_keep(float cur, float old) { return __int_as_float(__builtin_amdgcn_update_dpp(__float_as_int(old), __float_as_int(cur), 0x110 + K, 0xf, 0xf, false)); }
template <int K> __device__ __forceinline__ float shift1(float cur, float prev, float halo, bool first) { const float old = first ? halo : dpp_ror<K>(prev); return dpp_shr_keep<K>(cur, old); }
template <int K> __device__ __forceinline__ f32x4 shift_rows(const f32x4 cur, const f32x4 prev, const f32x4 halo, bool first) {
    f32x4 r;
#pragma unroll
    for (int e = 0; e < 4; ++e) { const float old = first ? halo[e] : dpp_ror<K>(prev[e]); r[e] = dpp_shr_keep<K>(cur[e], old); }
    return r;
}

struct EpiStore {
    static constexpr bool PERM = true, AFTER_DRAIN = false, ROWPERM = false;
    bf16_t* O; int ldc; float sc;
    __device__ __forceinline__ void operator()(const f32x4 (&acc)[2][2][4][2], const Unit& u, int wr, int wc, int fr, int fq) const {
        asm volatile("" : "+v"(fr), "+v"(fq));
        const int row0 = u.pm * BM + wr * 64 + fr, col0 = u.pn * BM + wc * 32 + 8 * fq;
#pragma unroll
        for (int ai = 0; ai < 2; ++ai)
#pragma unroll
            for (int m = 0; m < 4; ++m) { bf16_t* rowp = O + (size_t)(row0 + ai * HALF + m * 16) * ldc + col0;
#pragma unroll
                for (int bj = 0; bj < 2; ++bj) { const f32x4 v0 = acc[ai][bj][m][0] * sc, v1 = acc[ai][bj][m][1] * sc;
                    u32x4 w; w.x = cvt_pk_bf16(v0[0], v0[1]); w.y = cvt_pk_bf16(v0[2], v0[3]); w.z = cvt_pk_bf16(v1[0], v1[1]); w.w = cvt_pk_bf16(v1[2], v1[3]);
                    *(u32x4*)(rowp + bj * HALF) = w; } }
    }
};

template <bool XIN_F32> struct EpiRes {
    static constexpr bool PERM = true, AFTER_DRAIN = false, ROWPERM = false;
    const void* xin; bf16_t* xout; const float* gate; const float* sumsq;
    __device__ __forceinline__ void operator()(const f32x4 (&acc)[2][2][4][2], const Unit& u, int wr, int wc, int fr, int fq) const {
        asm volatile("" : "+v"(fr), "+v"(fq));
        const int row0 = u.pm * BM + wr * 64 + fr, col0 = u.pn * BM + wc * 32 + 8 * fq;
        const float* gp = gate + (size_t)(u.pm >> 5) * 16384 + col0;
        f32x4 gv[2][2];
#pragma unroll
        for (int bj = 0; bj < 2; ++bj)
#pragma unroll
            for (int n = 0; n < 2; ++n) gv[bj][n] = *(const f32x4*)(gp + bj * HALF + n * 4);
#pragma unroll
        for (int ai = 0; ai < 2; ++ai)
#pragma unroll
            for (int m = 0; m < 4; ++m) { const int row = row0 + ai * HALF + m * 16;
                const float rs = sumsq ? sumsq[row] : 1.0f;
                const size_t off = (size_t)row * 1024 + col0;
#pragma unroll
                for (int bj = 0; bj < 2; ++bj) {
                    f32x4 x0, x1;
                    if (XIN_F32) { x0 = *(const f32x4*)((const float*)xin + off + bj * HALF); x1 = *(const f32x4*)((const float*)xin + off + bj * HALF + 4); }
                    else { const u32x4 xb = *(const u32x4*)((const bf16_t*)xin + off + bj * HALF);
                        x0 = (f32x4){__uint_as_float(xb.x << 16), __uint_as_float(xb.x & 0xffff0000u), __uint_as_float(xb.y << 16), __uint_as_float(xb.y & 0xffff0000u)};
                        x1 = (f32x4){__uint_as_float(xb.z << 16), __uint_as_float(xb.z & 0xffff0000u), __uint_as_float(xb.w << 16), __uint_as_float(xb.w & 0xffff0000u)}; }
                    const f32x4 v0 = x0 + gv[bj][0] * acc[ai][bj][m][0] * rs, v1 = x1 + gv[bj][1] * acc[ai][bj][m][1] * rs;
                    u32x4 w; w.x = cvt_pk_bf16(v0[0], v0[1]); w.y = cvt_pk_bf16(v0[2], v0[3]); w.z = cvt_pk_bf16(v1[0], v1[1]); w.w = cvt_pk_bf16(v1[2], v1[3]);
                    *(u32x4*)(xout + off + bj * HALF) = w; } }
    }
};

struct EpiZdt {
    static constexpr bool PERM = true, AFTER_DRAIN = false, ROWPERM = false;
    bf16_t* Z; float* DT; const float* dtb;
    __device__ __forceinline__ void operator()(const f32x4 (&acc)[2][2][4][2], const Unit& u, int wr, int wc, int fr, int fq) const {
        asm volatile("" : "+v"(fr), "+v"(fq));
        const int row0 = u.pm * BM + wr * 64 + fr;
        if (u.pn < 8) {
            const int col0 = u.pn * BM + wc * 32 + 8 * fq;
#pragma unroll
            for (int ai = 0; ai < 2; ++ai)
#pragma unroll
                for (int m = 0; m < 4; ++m) { bf16_t* rowp = Z + (size_t)(row0 + ai * HALF + m * 16) * 2048 + col0;
#pragma unroll
                    for (int bj = 0; bj < 2; ++bj) { const f32x4 v0 = acc[ai][bj][m][0], v1 = acc[ai][bj][m][1];
                        u32x4 w; w.x = cvt_pk_bf16(v0[0], v0[1]); w.y = cvt_pk_bf16(v0[2], v0[3]); w.z = cvt_pk_bf16(v1[0], v1[1]); w.w = cvt_pk_bf16(v1[2], v1[3]);
                        *(u32x4*)(rowp + bj * HALF) = w; } }
            return;
        }
        {
            if (wc == 0) {
#pragma unroll
                for (int n = 0; n < 2; ++n) { const f32x4 bv = *(const f32x4*)(dtb + 8 * fq + 4 * n);
#pragma unroll
                    for (int ai = 0; ai < 2; ++ai)
#pragma unroll
                        for (int m = 0; m < 4; ++m) { f32x4 v = acc[ai][0][m][n] + bv;
#pragma unroll
                            for (int e = 0; e < 4; ++e) v[e] = softplus_f(v[e]);
                            *(f32x4*)(DT + (size_t)(row0 + ai * HALF + m * 16) * 32 + 8 * fq + 4 * n) = v; } }
            }
            return;
        }
    }
};

struct EpiMamba {
    static constexpr bool PERM = true, AFTER_DRAIN = false, ROWPERM = true;
    static constexpr int NC = 4096;
    bf16_t* XBC; float* P; float* UH; const float* cw; const float* cb; PG8_LAS float* xch;
    __device__ __forceinline__ void operator()(const f32x4 (&acc)[2][2][4][2], const Unit& u, int wr, int wc, int fr, int fq) const {
        asm volatile("" : "+v"(fr), "+v"(fq));
        const int row0 = u.pm * BM + wr * 64 + 4 * fr;
        const int cpos0 = 32 * wc + 8 * fq;
        PG8_LAS float* wt = xch + 3072;
        { const int tid = (wr * 4 + wc) * 64 + fq * 16 + fr;
#pragma unroll
            for (int j = 0; j < 3; ++j) { const int i = tid + 512 * j; if (i < 5 * 256) { const int t = i >> 8, cp = i & 255; wt[i] = t < 4 ? cw[t * 4096 + u.pn * BM + cp] : cb[u.pn * BM + cp]; } } }
        if (fr == 15) {
#pragma unroll
            for (int ai = 0; ai < 2; ++ai)
#pragma unroll
                for (int bj = 0; bj < 2; ++bj)
#pragma unroll
                    for (int n = 0; n < 2; ++n)
#pragma unroll
                        for (int m = 1; m < 4; ++m) {
                            *(PG8_LAS f32x4*)(xch + ((2 * ai + wr) * 3 + (m - 1)) * 256 + 128 * bj + cpos0 + 4 * n) = acc[ai][bj][m][n];
                            if (ai == 1 && wr == 1) *(f32x4*)(UH + ((size_t)u.pm * 3 + (m - 1)) * NC + u.pn * BM + 128 * bj + cpos0 + 4 * n) = acc[1][bj][m][n]; }
        }
        asm volatile("s_waitcnt lgkmcnt(0)" ::: "memory"); __builtin_amdgcn_s_barrier(); asm volatile("" ::: "memory");
#pragma unroll
        for (int ai = 0; ai < 2; ++ai) {
            const int seg = 2 * ai + wr; const bool has_prev = seg > 0; const int sp = has_prev ? seg - 1 : 0;
#pragma unroll
            for (int bj = 0; bj < 2; ++bj) {
                const int ch0 = u.pn * BM + 128 * bj + cpos0;
#pragma unroll
                for (int n = 0; n < 2; ++n) {
                    unsigned pk[4][2];
#pragma unroll
                    for (int eh = 0; eh < 2; ++eh) {
                        const int cpos = 128 * bj + cpos0 + 4 * n + 2 * eh; const int ch = ch0 + 4 * n + 2 * eh;
                        f32x2 h1 = *(const PG8_LAS f32x2*)(xch + (sp * 3 + 2) * 256 + cpos), h2 = *(const PG8_LAS f32x2*)(xch + (sp * 3 + 1) * 256 + cpos), h3 = *(const PG8_LAS f32x2*)(xch + (sp * 3 + 0) * 256 + cpos);
                        if (!has_prev) { h1 = (f32x2){0.f, 0.f}; h2 = h1; h3 = h1; }
                        const f32x2 w0 = *(const PG8_LAS f32x2*)(wt + 0 * 256 + cpos), w1 = *(const PG8_LAS f32x2*)(wt + 1 * 256 + cpos), w2 = *(const PG8_LAS f32x2*)(wt + 2 * 256 + cpos),
                                    w3 = *(const PG8_LAS f32x2*)(wt + 3 * 256 + cpos), bb = *(const PG8_LAS f32x2*)(wt + 4 * 256 + cpos);
                        f32x2 o[4], v[4];
#pragma unroll
                        for (int m = 0; m < 4; ++m) v[m] = (f32x2){acc[ai][bj][m][n][2 * eh], acc[ai][bj][m][n][2 * eh + 1]};
                        const f32x2 s1 = (f32x2){dpp_shr_keep<1>(v[3].x, h1.x), dpp_shr_keep<1>(v[3].y, h1.y)}, s2 = (f32x2){dpp_shr_keep<1>(v[2].x, h2.x), dpp_shr_keep<1>(v[2].y, h2.y)},
                                    s3 = (f32x2){dpp_shr_keep<1>(v[1].x, h3.x), dpp_shr_keep<1>(v[1].y, h3.y)};
                        o[0] = bb + w3 * v[0] + w2 * s1 + w1 * s2 + w0 * s3;
                        o[1] = bb + w3 * v[1] + w2 * v[0] + w1 * s1 + w0 * s2;
                        o[2] = bb + w3 * v[2] + w2 * v[1] + w1 * v[0] + w0 * s1;
                        o[3] = bb + w3 * v[3] + w2 * v[2] + w1 * v[1] + w0 * v[0];
                        if (seg == 0 && fr == 0) {
#pragma unroll
                            for (int m = 0; m < 3; ++m) *(f32x2*)(P + ((size_t)u.pm * 3 + m) * NC + u.pn * BM + cpos) = o[m]; }
#pragma unroll
                        for (int m = 0; m < 4; ++m) { const f32x2 r = silu2(o[m]); pk[m][eh] = cvt_pk_bf16(r.x, r.y); }
                    }
#pragma unroll
                    for (int m = 0; m < 4; ++m) { u32x2 w; w.x = pk[m][0]; w.y = pk[m][1]; *(u32x2*)(XBC + (size_t)(row0 + ai * HALF + m) * 4096 + ch0 + 4 * n) = w; }
                }
            }
        }
    }
};

struct EpiFFN {
    static constexpr bool PERM = true, AFTER_DRAIN = false, ROWPERM = true;
    static constexpr int NC = 5632, F = 2816;
    bf16_t* G; float* P; float* UH; const float* cw; const float* cb; PG8_LAS float* xch;
    __device__ __forceinline__ void operator()(const f32x4 (&acc)[2][2][4][2], const Unit& u, int wr, int wc, int fr, int fq) const {
        asm volatile("" : "+v"(fr), "+v"(fq));
        const int row0 = u.pm * BM + wr * 64 + 4 * fr;
        const int cpos0 = 32 * wc + 8 * fq;
        PG8_LAS float* wt = xch + 3072;
        { const int tid = (wr * 4 + wc) * 64 + fq * 16 + fr;
#pragma unroll
            for (int j = 0; j < 2; ++j) { const int i = tid + 512 * j; const int t = i >> 8, cp = i & 255; const int chs = (cp >> 7) * F + u.pn * 128 + (cp & 127); wt[i] = t < 3 ? cw[t * NC + chs] : cb[chs]; } }
        if (fr == 15) {
#pragma unroll
            for (int ai = 0; ai < 2; ++ai)
#pragma unroll
                for (int bj = 0; bj < 2; ++bj)
#pragma unroll
                    for (int n = 0; n < 2; ++n)
#pragma unroll
                        for (int m = 2; m < 4; ++m) {
                            *(PG8_LAS f32x4*)(xch + ((2 * ai + wr) * 2 + (m - 2)) * 256 + 128 * bj + cpos0 + 4 * n) = acc[ai][bj][m][n];
                            if (ai == 1 && wr == 1) *(f32x4*)(UH + ((size_t)u.pm * 2 + (m - 2)) * NC + u.pn * BM + 128 * bj + cpos0 + 4 * n) = acc[1][bj][m][n]; }
        }
        asm volatile("s_waitcnt lgkmcnt(0)" ::: "memory"); __builtin_amdgcn_s_barrier(); asm volatile("" ::: "memory");
        const int j0 = u.pn * 128 + cpos0;
#pragma unroll
        for (int ai = 0; ai < 2; ++ai) {
            const int seg = 2 * ai + wr; const bool has_prev = seg > 0; const int sp = has_prev ? seg - 1 : 0;
#pragma unroll
            for (int n = 0; n < 2; ++n) {
                unsigned pk[4][2];
#pragma unroll
                for (int eh = 0; eh < 2; ++eh) {
                    f32x2 og[2][4];
#pragma unroll
                    for (int bj = 0; bj < 2; ++bj) {
                        const int cpos = 128 * bj + cpos0 + 4 * n + 2 * eh;
                        f32x2 h1 = *(const PG8_LAS f32x2*)(xch + (sp * 2 + 1) * 256 + cpos), h2 = *(const PG8_LAS f32x2*)(xch + (sp * 2 + 0) * 256 + cpos);
                        if (!has_prev) { h1 = (f32x2){0.f, 0.f}; h2 = h1; }
                        const f32x2 w0 = *(const PG8_LAS f32x2*)(wt + 0 * 256 + cpos), w1 = *(const PG8_LAS f32x2*)(wt + 1 * 256 + cpos), w2 = *(const PG8_LAS f32x2*)(wt + 2 * 256 + cpos), bb = *(const PG8_LAS f32x2*)(wt + 3 * 256 + cpos);
                        f32x2 v[4];
#pragma unroll
                        for (int m = 0; m < 4; ++m) v[m] = (f32x2){acc[ai][bj][m][n][2 * eh], acc[ai][bj][m][n][2 * eh + 1]};
                        const f32x2 s1 = (f32x2){dpp_shr_keep<1>(v[3].x, h1.x), dpp_shr_keep<1>(v[3].y, h1.y)}, s2 = (f32x2){dpp_shr_keep<1>(v[2].x, h2.x), dpp_shr_keep<1>(v[2].y, h2.y)};
                        og[bj][0] = bb + w2 * v[0] + w1 * s1 + w0 * s2;
                        og[bj][1] = bb + w2 * v[1] + w1 * v[0] + w0 * s1;
                        og[bj][2] = bb + w2 * v[2] + w1 * v[1] + w0 * v[0];
                        og[bj][3] = bb + w2 * v[3] + w1 * v[2] + w0 * v[1];
                        if (seg == 0 && fr == 0) {
#pragma unroll
                            for (int m = 0; m < 2; ++m) *(f32x2*)(P + ((size_t)u.pm * 2 + m) * NC + u.pn * BM + cpos) = og[bj][m]; }
                    }
#pragma unroll
                    for (int m = 0; m < 4; ++m) { const f32x2 r = silu2(og[0][m]) * og[1][m]; pk[m][eh] = cvt_pk_bf16(r.x, r.y); }
                }
#pragma unroll
                for (int m = 0; m < 4; ++m) { u32x2 w; w.x = pk[m][0]; w.y = pk[m][1]; *(u32x2*)(G + (size_t)(row0 + ai * HALF + m) * F + j0 + 4 * n) = w; }
            }
        }
    }
};
template <class Epi, class Sched, bool ALIGN_EPI = false, bool SP2 = false>
__device__ __forceinline__ void gemm_phase(PG8_LAS unsigned char* lds, const Gemm g, const Sched& S, const Epi& E) {
    int tid_ = threadIdx.x; asm volatile("" : "+v"(tid_));
    const int tid = tid_, wid = __builtin_amdgcn_readfirstlane(tid >> 6), lane = tid & 63, wr = wid >> 2, wc = wid & 3, fr = lane & 15, fq = lane >> 4;
    const int K = g.K, nt = K / BK;
    unsigned voffA[2], voffB[2];
#pragma unroll
    for (int i = 0; i < 2; ++i) { int R, C; stage_rc(tid * 16 + i * 8192, R, C); const int Rb = Epi::PERM ? ((R & ~31) + perm32(R & 31)) : R;
        const int Ra = Epi::ROWPERM ? ((R & ~63) + 4 * (R & 15) + ((R >> 4) & 3)) : R;
        voffA[i] = (unsigned)(Ra * K + C) * 2u; voffB[i] = (unsigned)(Rb * K + C) * 2u; }
    const size_t kstep = (size_t)(BK * 2);
    const size_t hstep = (size_t)HALF * K * 2;
    const size_t tstep = 2 * hstep;
    const unsigned ldsw = (unsigned)wid * 1024u;
    const int aoff = lds_byte(wr * 64 + fr, fq * 8), boff = lds_byte(wc * 32 + fr, fq * 8);
#define PG8_SA(b, h) (((b) * 2 + (h)) * HTB)
#define PG8_SB(b, h) ((4 + (b) * 2 + (h)) * HTB)
#define PG8_STAGE(bufoff, gbase, voff) do { _Pragma("unroll") for (int _i = 0; _i < 2; ++_i) \
        __builtin_amdgcn_global_load_lds((const unsigned*)((const char*)(gbase) + (voff)[_i]), (PG8_LAS unsigned*)(lds + (bufoff) + ldsw + _i * 8192), 16, 0, 0); } while (0)
#define PG8_LDA(dst, b, h) do { _Pragma("unroll") for (int m = 0; m < 4; ++m) _Pragma("unroll") for (int k = 0; k < 2; ++k) dst[m][k] = *(const PG8_LAS bf16x8*)(lds + PG8_SA(b, h) + aoff + m * 2048 + k * 1024); } while (0)
#define PG8_LDB(dst, b, h) do { _Pragma("unroll") for (int n = 0; n < 2; ++n) _Pragma("unroll") for (int k = 0; k < 2; ++k) dst[n][k] = *(const PG8_LAS bf16x8*)(lds + PG8_SB(b, h) + boff + n * 2048 + k * 1024); } while (0)
#define PG8_MMA(ai, bj, At, Bt) do { __builtin_amdgcn_s_setprio(1); _Pragma("unroll") for (int m = 0; m < 4; ++m) _Pragma("unroll") for (int n = 0; n < 2; ++n) _Pragma("unroll") for (int k = 0; k < 2; ++k) \
        acc[ai][bj][m][n] = __builtin_amdgcn_mfma_f32_16x16x32_bf16(Bt[n][k], At[m][k], acc[ai][bj][m][n], 0, 0, 0); __builtin_amdgcn_s_setprio(0); } while (0)
#define PG8_WAIT_V(n) asm volatile("s_waitcnt vmcnt(" #n ")" ::: "memory")
#define PG8_WAIT_L(n) asm volatile("s_waitcnt lgkmcnt(" #n ")" ::: "memory")
#define PG8_BAR __builtin_amdgcn_s_barrier()
#define PG8_SCHED __builtin_amdgcn_sched_barrier(0)
    Unit cur, nxt; int ui = 0;
    if (!S.next(0, cur)) return;
    f32x4 acc[2][2][4][2];
#pragma unroll
    for (int a = 0; a < 2; ++a)
#pragma unroll
        for (int b = 0; b < 2; ++b)
#pragma unroll
            for (int m = 0; m < 4; ++m)
#pragma unroll
                for (int n = 0; n < 2; ++n) acc[a][b][m][n] = (f32x4){0.f, 0.f, 0.f, 0.f};
    bf16x8 At[4][2], B0[2][2], B1[2][2];
    const char* cA = (const char*)g.A + (size_t)cur.pm * tstep; const char* cB = (const char*)g.Bt + (size_t)cur.pn * tstep;
    S.a_ready(cur);
    if constexpr (SP2) {
        PG8_STAGE(PG8_SB(0, 0), cB, voffB); PG8_STAGE(PG8_SB(0, 1), cB + hstep, voffB); PG8_STAGE(PG8_SA(0, 0), cA, voffA); PG8_STAGE(PG8_SA(0, 1), cA + hstep, voffA);
        if (wr == 1) PG8_BAR;
        PG8_WAIT_V(2); PG8_BAR;
        PG8_STAGE(PG8_SB(1, 0), cB + kstep, voffB); PG8_STAGE(PG8_SA(1, 0), cA + kstep, voffA); PG8_STAGE(PG8_SB(1, 1), cB + hstep + kstep, voffB);
        PG8_WAIT_V(6); PG8_BAR;
    } else {
        PG8_STAGE(PG8_SB(0, 0), cB, voffB); PG8_STAGE(PG8_SA(0, 0), cA, voffA); PG8_STAGE(PG8_SB(0, 1), cB + hstep, voffB); PG8_STAGE(PG8_SA(0, 1), cA + hstep, voffA);
        if (wr == 1) PG8_BAR;
        PG8_WAIT_V(4); PG8_BAR;
        PG8_STAGE(PG8_SB(1, 0), cB + kstep, voffB); PG8_STAGE(PG8_SA(1, 0), cA + kstep, voffA); PG8_STAGE(PG8_SB(1, 1), cB + hstep + kstep, voffB);
        PG8_WAIT_V(6); PG8_BAR;
    }
    for (;;) {
        const bool has_next = S.next(ui + 1, nxt);
        const char* nA = has_next ? (const char*)g.A + (size_t)nxt.pm * tstep : cA; const char* nB = has_next ? (const char*)g.Bt + (size_t)nxt.pn * tstep : cB;
        for (int t = 0; t < nt; t += 2) {
            const bool last = (t == nt - 2);
            const char* a1 = cA + (size_t)(t + 1) * kstep;
            const char* a2 = last ? nA : cA + (size_t)(t + 2) * kstep; const char* b2 = last ? nB : cB + (size_t)(t + 2) * kstep;
            const char* a3 = a2 + kstep; const char* b3 = b2 + kstep;
            if (last && has_next) S.a_ready(nxt);
            if constexpr (SP2) {
            PG8_LDB(B0, 0, 0); PG8_LDB(B1, 0, 1); PG8_SCHED; PG8_LDA(At, 0, 0); PG8_STAGE(PG8_SA(1, 1), a1 + hstep, voffA);
            PG8_WAIT_V(8); PG8_WAIT_L(0); PG8_BAR; PG8_MMA(0, 0, At, B0); PG8_MMA(0, 1, At, B1); PG8_BAR; PG8_SCHED;
            PG8_LDA(At, 0, 1); PG8_STAGE(PG8_SB(0, 0), b2, voffB); PG8_STAGE(PG8_SB(0, 1), b2 + hstep, voffB); PG8_STAGE(PG8_SA(0, 0), a2, voffA);
            PG8_WAIT_V(8); PG8_WAIT_L(0); PG8_BAR; PG8_MMA(1, 0, At, B0); PG8_MMA(1, 1, At, B1); PG8_BAR; PG8_SCHED;
            PG8_LDB(B0, 1, 0); PG8_LDB(B1, 1, 1); PG8_SCHED; PG8_LDA(At, 1, 0); PG8_STAGE(PG8_SA(0, 1), a2 + hstep, voffA);
            PG8_WAIT_V(8); PG8_WAIT_L(0); PG8_BAR; PG8_MMA(0, 0, At, B0); PG8_MMA(0, 1, At, B1); PG8_BAR; PG8_SCHED;
            PG8_LDA(At, 1, 1); PG8_STAGE(PG8_SB(1, 0), b3, voffB); PG8_STAGE(PG8_SB(1, 1), b3 + hstep, voffB); PG8_STAGE(PG8_SA(1, 0), a3, voffA);
            PG8_WAIT_V(8); PG8_WAIT_L(0); PG8_BAR; PG8_MMA(1, 0, At, B0); PG8_MMA(1, 1, At, B1); PG8_BAR; PG8_SCHED;
            } else {
            PG8_LDB(B0, 0, 0); PG8_SCHED; PG8_LDA(At, 0, 0); PG8_STAGE(PG8_SA(1, 1), a1 + hstep, voffA);
            PG8_WAIT_L(8); PG8_BAR; PG8_WAIT_L(0); PG8_MMA(0, 0, At, B0); PG8_BAR; PG8_SCHED;
            PG8_LDB(B1, 0, 1); PG8_STAGE(PG8_SB(0, 0), b2, voffB);
            PG8_BAR; PG8_WAIT_L(0); PG8_MMA(0, 1, At, B1); PG8_BAR;
            PG8_LDA(At, 0, 1); PG8_STAGE(PG8_SA(0, 0), a2, voffA);
            PG8_BAR; PG8_WAIT_L(0); PG8_MMA(1, 0, At, B0); PG8_BAR; PG8_SCHED;
            PG8_STAGE(PG8_SB(0, 1), b2 + hstep, voffB);
            PG8_WAIT_V(6); PG8_BAR; PG8_MMA(1, 1, At, B1); PG8_BAR;
            PG8_LDB(B0, 1, 0); PG8_SCHED; PG8_LDA(At, 1, 0); PG8_STAGE(PG8_SA(0, 1), a2 + hstep, voffA);
            PG8_WAIT_L(8); PG8_BAR; PG8_WAIT_L(0); PG8_MMA(0, 0, At, B0); PG8_BAR; PG8_SCHED;
            PG8_LDB(B1, 1, 1); PG8_STAGE(PG8_SB(1, 0), b3, voffB);
            PG8_BAR; PG8_WAIT_L(0); PG8_MMA(0, 1, At, B1); PG8_BAR;
            PG8_LDA(At, 1, 1); PG8_STAGE(PG8_SA(1, 0), a3, voffA);
            PG8_BAR; PG8_WAIT_L(0); PG8_MMA(1, 0, At, B0); PG8_BAR; PG8_SCHED;
            PG8_STAGE(PG8_SB(1, 1), b3 + hstep, voffB);
            PG8_WAIT_V(6); PG8_BAR; PG8_MMA(1, 1, At, B1); PG8_BAR;
            }
        }
        if constexpr (ALIGN_EPI) { if (wr == 0) PG8_BAR; }
        if constexpr (!Epi::AFTER_DRAIN) { E(acc, cur, wr, wc, fr, fq); S.done(cur); }
        if (!has_next) break;
#pragma unroll
        for (int a = 0; a < 2; ++a)
#pragma unroll
            for (int b = 0; b < 2; ++b)
#pragma unroll
                for (int m = 0; m < 4; ++m)
#pragma unroll
                    for (int n = 0; n < 2; ++n) acc[a][b][m][n] = (f32x4){0.f, 0.f, 0.f, 0.f};
        cur = nxt; cA = nA; cB = nB; ++ui;
        if constexpr (ALIGN_EPI) { if (wr == 1) PG8_BAR; }
    }
    PG8_WAIT_V(0);
    if constexpr (!ALIGN_EPI) { if (wr == 0) PG8_BAR; }
    PG8_BAR;
    if constexpr (Epi::AFTER_DRAIN) { E.fused(acc, cur, wr, wc, fr, fq, lds, wid, lane); S.done(cur); }
#undef PG8_SA
#undef PG8_SB
#undef PG8_STAGE
#undef PG8_LDA
#undef PG8_LDB
#undef PG8_MMA
#undef PG8_WAIT_V
#undef PG8_WAIT_L
#undef PG8_BAR
#undef PG8_SCHED
}
}

#define LAS __attribute__((address_space(3)))
typedef unsigned short bf16;
typedef short bf16x8 __attribute__((ext_vector_type(8)));
typedef short s16x4 __attribute__((ext_vector_type(4)));
typedef float f32x4 __attribute__((ext_vector_type(4)));
typedef unsigned u32x4 __attribute__((ext_vector_type(4)));
typedef unsigned u32x2 __attribute__((ext_vector_type(2)));
#define MFMA16(a, b, c) __builtin_amdgcn_mfma_f32_16x16x32_bf16((a), (b), (c), 0, 0, 0)

constexpr int T = 32768, D = 1024, SEQ = 8192, NTHR = 512;
constexpr int LDS_BYTES = 163840, XCH_OFF = 131072;
constexpr size_t MiB = 1u << 20;
constexpr size_t WS_W = 0;
constexpr size_t W_IN = 0, W_SOUT = W_IN + (size_t)6400 * 1024, W_FIN0 = W_SOUT + (size_t)1024 * 2048, W_FIN1 = W_FIN0 + (size_t)5632 * 1024,
                 W_FOUT0 = W_FIN1 + (size_t)5632 * 1024, W_FOUT1 = W_FOUT0 + (size_t)1024 * 2816, W_K = W_FOUT1 + (size_t)1024 * 2816, W_V = W_K + 1048576, W_Q = W_V + 1048576,
                 W_O = W_Q + 1048576, W_END = W_O + 1048576;
static_assert(W_END * 2 <= 58 * MiB, "weights fit");
constexpr size_t WS_MODS = 58 * MiB;
constexpr size_t WS_SUMSQ = 59 * MiB;
constexpr size_t WS_FLAGS = 60 * MiB;
constexpr size_t WS_BAR = 61 * MiB;
constexpr size_t WS_X = 64 * MiB;
constexpr size_t WS_BIG = 192 * MiB;
constexpr size_t WS_END = 448 * MiB;
constexpr int MOD_L = 6144, MOD_KV = 12288, MOD_FIN = 14336, MOD_N = 16384;

#ifdef PROBE
#define STAMP(k) do { if (blockIdx.x == 0 && threadIdx.x == 0) { __threadfence(); TS[k] = __builtin_amdgcn_s_memrealtime(); __threadfence(); } } while (0)
#else
#define STAMP(k) do {} while (0)
#endif
struct Params { const float* in[28]; float* out; unsigned char* ws; };

__device__ __forceinline__ float bf2f(unsigned u) { return __uint_as_float(u << 16); }
typedef float f32x2_t __attribute__((ext_vector_type(2))); typedef __bf16 bf16x2_t __attribute__((ext_vector_type(2)));
__device__ __forceinline__ unsigned pk2(float lo, float hi) { f32x2_t v = {lo, hi}; bf16x2_t b = __builtin_convertvector(v, bf16x2_t); return __builtin_bit_cast(unsigned, b); }
__device__ __forceinline__ unsigned f2bf(float f) { return pk2(f, 0.f) & 0xffffu; }
__device__ __forceinline__ float wave_sum(float v) {
#pragma unroll
    for (int o = 1; o < 64; o <<= 1) v += __shfl_xor(v, o);
    return v;
}
using pg8::silu_f; using pg8::softplus_f;

__device__ __forceinline__ void p0_item(const float* W, int K, int Nsrc, bf16* WT, int dst_n0, int src_n0, int k0, LAS float* scr, int lane) {
    const int c = lane & 7;
    if (src_n0 < 0) {
#pragma unroll
        for (int j = 0; j < 4; ++j) { const int n = (lane >> 3) + 8 * j; *(u32x4*)(WT + (size_t)(dst_n0 + n) * K + k0 + 8 * c) = (u32x4){0u, 0u, 0u, 0u}; }
        return;
    }
#pragma unroll 8
    for (int i = 0; i < 32; ++i) { const int kk = 2 * i + (lane >> 5); scr[kk * 33 + (lane & 31)] = W[(size_t)(k0 + kk) * Nsrc + src_n0 + (lane & 31)]; }
    asm volatile("s_waitcnt lgkmcnt(0)" ::: "memory");
#pragma unroll
    for (int j = 0; j < 4; ++j) { const int n = (lane >> 3) + 8 * j; const LAS float* s = scr + (8 * c) * 33 + n;
        u32x4 o; o.x = pk2(s[0 * 33], s[1 * 33]); o.y = pk2(s[2 * 33], s[3 * 33]); o.z = pk2(s[4 * 33], s[5 * 33]); o.w = pk2(s[6 * 33], s[7 * 33]);
        *(u32x4*)(WT + (size_t)(dst_n0 + n) * K + k0 + 8 * c) = o; }
    asm volatile("s_waitcnt lgkmcnt(0)" ::: "memory");
}
__device__ __forceinline__ void p0_phase(const Params& p, LAS unsigned char* L) {
    const int tid = threadIdx.x, lane = tid & 63, wave = __builtin_amdgcn_readfirstlane(tid >> 6);
    bf16* WB = (bf16*)(p.ws + WS_W);
    float* MODS = (float*)(p.ws + WS_MODS); float* SUMSQ = (float*)(p.ws + WS_SUMSQ);
    if (blockIdx.x == 0 && tid < 64) ((unsigned*)(p.ws + WS_FLAGS))[tid] = 0u;
    LAS float* cs = (LAS float*)L; LAS float* part = (LAS float*)(L + 16384);
    for (int i = tid; i < 4096; i += NTHR) cs[i] = silu_f(p.in[1][i]);
    __syncthreads();
    for (int jb = blockIdx.x; jb < MOD_N / 64; jb += gridDim.x) {
        const int j = jb * 64 + lane; const float* Wsrc; const float* bsrc; int stride, jj;
        if (j < MOD_KV) { const int l = j / MOD_L; jj = j - l * MOD_L; Wsrc = p.in[2] + (size_t)l * D * MOD_L; bsrc = p.in[3] + l * MOD_L; stride = MOD_L; }
        else if (j < MOD_FIN) { jj = j - MOD_KV; Wsrc = p.in[14]; bsrc = p.in[15]; stride = 2048; }
        else { jj = j - MOD_FIN; Wsrc = p.in[25]; bsrc = p.in[26]; stride = 2048; }
        float a0 = 0.f, a1 = 0.f, a2 = 0.f, a3 = 0.f;
#pragma unroll 8
        for (int k = wave * 128; k < wave * 128 + 128; ++k) { const float wv = Wsrc[(size_t)k * stride + jj]; a0 += cs[k] * wv; a1 += cs[1024 + k] * wv; a2 += cs[2048 + k] * wv; a3 += cs[3072 + k] * wv; }
        part[(wave * 4 + 0) * 64 + lane] = a0; part[(wave * 4 + 1) * 64 + lane] = a1; part[(wave * 4 + 2) * 64 + lane] = a2; part[(wave * 4 + 3) * 64 + lane] = a3;
        __syncthreads();
        if (tid < 256) { const int b = tid >> 6; float s = 0.f;
#pragma unroll
            for (int w = 0; w < 8; ++w) s += part[(w * 4 + b) * 64 + lane];
            MODS[(size_t)b * MOD_N + j] = s + bsrc[jj]; }
        __syncthreads();
    }
    LAS float* scr = (LAS float*)(L + wave * 16384);
    const int gw = blockIdx.x * 8 + wave, NGW = gridDim.x * 8;
    constexpr int NI0 = 16 * 200, NI1 = 32 * 32, NI2 = 16 * 176, NI3 = 44 * 32, NI4 = 16 * 32;
    constexpr int NITEMS = NI0 + NI1 + 2 * NI2 + 2 * NI3 + 4 * NI4;
    for (int it = gw; it < NITEMS; it += NGW) {
        int r = it;
        if (r < NI0) { const int kb = r / 200, nb = r % 200; const int dn = nb * 32; const int sn = dn < 2048 ? dn : dn < 2080 ? 6144 + (dn - 2048) : dn < 2304 ? -1 : 2048 + (dn - 2304); p0_item(p.in[6], 1024, 6176, WB + W_IN, dn, sn, kb * 64, scr, lane); continue; } r -= NI0;
        if (r < NI1) { const int kb = r / 32, nb = r % 32; p0_item(p.in[13], 2048, 1024, WB + W_SOUT, nb * 32, nb * 32, kb * 64, scr, lane); continue; } r -= NI1;
        if (r < 2 * NI2) { const int l = r / NI2; r -= l * NI2; const int kb = r / 176, nb = r % 176; const int dn = nb * 32; const int sn = (dn >> 8) * 128 + (dn & 127) + ((dn & 255) >= 128 ? 2816 : 0);
            p0_item(p.in[21] + (size_t)l * 1024 * 5632, 1024, 5632, WB + (l ? W_FIN1 : W_FIN0), dn, sn, kb * 64, scr, lane); continue; } r -= 2 * NI2;
        if (r < 2 * NI3) { const int l = r / NI3; r -= l * NI3; const int kb = r / 32, nb = r % 32;
            p0_item(p.in[24] + (size_t)l * 2816 * 1024, 2816, 1024, WB + (l ? W_FOUT1 : W_FOUT0), nb * 32, nb * 32, kb * 64, scr, lane); continue; } r -= 2 * NI3;
        { const int q = r / NI4; r -= q * NI4; const int kb = r / 32, nb = r % 32; const float* src = q == 0 ? p.in[17] : q == 1 ? p.in[18] : q == 2 ? p.in[19] : p.in[20];
            bf16* dst = WB + (q == 0 ? W_K : q == 1 ? W_V : q == 2 ? W_Q : W_O);
            p0_item(src, 1024, 1024, dst, nb * 32, nb * 32, kb * 64, scr, lane); }
    }
}

template <int NOUT, bool F32OUT>
__device__ __forceinline__ void norm_phase(const float* X, const float* g0, const float* mod0, void* out0, const float* g1, const float* mod1, void* out1) {
    int tid_ = threadIdx.x; asm volatile("" : "+v"(tid_));
    const int tid = tid_, lane = tid & 63, wave = tid >> 6;
    const int gw = blockIdx.x * 8 + wave, NGW = gridDim.x * 8;
    for (int row = gw; row < T; row += NGW) {
        const int b = row >> 13;
        const f32x4* xr = (const f32x4*)(X + (size_t)row * D) + lane;
        f32x4 v[4]; float s = 0.f;
#pragma unroll
        for (int j = 0; j < 4; ++j) { v[j] = xr[64 * j]; s += (v[j].x * v[j].x + v[j].y * v[j].y) + (v[j].z * v[j].z + v[j].w * v[j].w); }
        const float rstd = rsqrtf(wave_sum(s) * (1.f / D) + 1e-6f);
#pragma unroll
        for (int o = 0; o < NOUT; ++o) {
            const float* g = o ? g1 : g0; const float* md = (o ? mod1 : mod0) + (size_t)b * MOD_N; void* out = o ? out1 : out0;
#pragma unroll
            for (int j = 0; j < 4; ++j) { const int col = 4 * lane + 256 * j;
                const f32x4 gv = *(const f32x4*)(g + col), sh = *(const f32x4*)(md + col), sc = *(const f32x4*)(md + 1024 + col);
                const f32x4 y = v[j] * rstd * gv * (sc + 1.0f) + sh;
                if (F32OUT) *(f32x4*)((float*)out + (size_t)row * D + col) = y;
                else { u32x2 w; w.x = pk2(y.x, y.y); w.y = pk2(y.z, y.w); *(u32x2*)((bf16*)out + (size_t)row * D + col) = w; } }
        }
    }
}

template <int NOUT, bool F32OUT>
__device__ __forceinline__ void norm_phase_b(const bf16* X, const float* g0, const float* mod0, void* out0, const float* g1, const float* mod1, void* out1) {
    int tid_ = threadIdx.x; asm volatile("" : "+v"(tid_));
    const int tid = tid_, lane = tid & 63, wave = tid >> 6;
    const int gw = blockIdx.x * 8 + wave, NGW = gridDim.x * 8;
    for (int row = gw; row < T; row += NGW) {
        const int b = row >> 13;
        float v[2][8]; float s = 0.f;
#pragma unroll
        for (int j = 0; j < 2; ++j) { const u32x4 xb = *(const u32x4*)(X + (size_t)row * D + 8 * lane + 512 * j);
#pragma unroll
            for (int e = 0; e < 4; ++e) { v[j][2 * e] = __uint_as_float(xb[e] << 16); v[j][2 * e + 1] = __uint_as_float(xb[e] & 0xffff0000u); }
#pragma unroll
            for (int e = 0; e < 8; ++e) s += v[j][e] * v[j][e]; }
        const float rstd = rsqrtf(wave_sum(s) * (1.f / D) + 1e-6f);
#pragma unroll
        for (int o = 0; o < NOUT; ++o) {
            const float* g = o ? g1 : g0; const float* md = (o ? mod1 : mod0) + (size_t)b * MOD_N; void* out = o ? out1 : out0;
#pragma unroll
            for (int j = 0; j < 2; ++j) { const int col = 8 * lane + 512 * j; float y[8];
#pragma unroll
                for (int q = 0; q < 2; ++q) { const f32x4 gv = *(const f32x4*)(g + col + 4 * q), sh = *(const f32x4*)(md + col + 4 * q), sc = *(const f32x4*)(md + 1024 + col + 4 * q);
#pragma unroll
                    for (int e = 0; e < 4; ++e) y[4 * q + e] = v[j][4 * q + e] * rstd * gv[e] * (sc[e] + 1.0f) + sh[e]; }
                if (F32OUT) { *(f32x4*)((float*)out + (size_t)row * D + col) = (f32x4){y[0], y[1], y[2], y[3]}; *(f32x4*)((float*)out + (size_t)row * D + col + 4) = (f32x4){y[4], y[5], y[6], y[7]}; }
                else { u32x4 w; w.x = pk2(y[0], y[1]); w.y = pk2(y[2], y[3]); w.z = pk2(y[4], y[5]); w.w = pk2(y[6], y[7]); *(u32x4*)((bf16*)out + (size_t)row * D + col) = w; } }
        }
    }
}

__device__ __forceinline__ void fixup_mamba(const float* P, const float* UH, const float* cw, const float* cb, bf16* XBC) {
    const int total = 128 * 3 * 4096;
    for (int i = blockIdx.x * NTHR + threadIdx.x; i < total; i += gridDim.x * NTHR) {
        const int ch = i & 4095, r = (i >> 12) % 3, pm = i / (3 * 4096); const int c = ch;
        float v = P[((size_t)pm * 3 + r) * 4096 + c];
        if (pm & 31) { for (int k = r + 1; k <= 3; ++k) v += cw[(3 - k) * 4096 + ch] * UH[((size_t)(pm - 1) * 3 + (3 + r - k)) * 4096 + c]; }
        XBC[(size_t)(pm * 256 + r) * 4096 + ch] = (bf16)f2bf(silu_f(v));
    }
}
__device__ __forceinline__ void fixup_ffn(const float* P, const float* UH, const float* cw, const float* cb, bf16* G) {
    const int total = 128 * 2 * 2816;
    for (int i = blockIdx.x * NTHR + threadIdx.x; i < total; i += gridDim.x * NTHR) {
        const int j = i % 2816, r = (i / 2816) & 1, pm = i / (2 * 2816); const int cg_ = (j >> 7) * 256 + (j & 127), cv_ = cg_ + 128;
        float g = P[((size_t)pm * 2 + r) * 5632 + cg_], v = P[((size_t)pm * 2 + r) * 5632 + cv_];
        if (pm & 31) { for (int k = r + 1; k <= 2; ++k) { const size_t ro = ((size_t)(pm - 1) * 2 + (2 + r - k)) * 5632;
            g += cw[(2 - k) * 5632 + j] * UH[ro + cg_]; v += cw[(2 - k) * 5632 + 2816 + j] * UH[ro + cv_]; } }
        G[(size_t)(pm * 256 + r) * 2816 + j] = (bf16)f2bf(silu_f(g) * v);
    }
}

constexpr int SSD_CS = 0, SSD_BS = 34816, SSD_XT = 69632, SSD_XDT = 78336, SSD_HS0 = 87040, SSD_HS1 = 95744, SSD_ACS = 104448, SSD_WSCR = 104960;
__device__ __forceinline__ void acs_phase(const float* DT, const float* a_log, float* ACS) {
    const int lane = threadIdx.x & 63, wave = threadIdx.x >> 6;
    const int h = lane & 31, sub = lane >> 5; const float A = -__expf(a_log[h]);
    for (int task = blockIdx.x * 8 + wave; task < 256; task += gridDim.x * 8) {
        const size_t tok0 = (size_t)task * 128 + sub * 64;
        float s = 0.f;
#pragma unroll 8
        for (int i = 0; i < 64; ++i) s += DT[(tok0 + i) * 32 + h] * A;
        const float s0 = __shfl(s, h);
        float run = sub ? s0 : 0.f;
#pragma unroll 8
        for (int i = 0; i < 64; ++i) { run += DT[(tok0 + i) * 32 + h] * A; ACS[(tok0 + i) * 32 + h] = run; }
    }
}
template <int LT> __device__ __forceinline__ void ssd_diag(const LAS bf16* Bs, const LAS bf16* XTs, const LAS float* acs_s, const bf16x8 (&cf)[4], float acs_l, int r16, int quad, f32x4 (&Yd)[2]) {
#pragma unroll
    for (int t = 0; t <= (LT >> 1); ++t) {
        f32x4 mm[2];
#pragma unroll
        for (int hf = 0; hf < 2; ++hf) { const int st = 2 * t + hf; mm[hf] = (f32x4){0.f, 0.f, 0.f, 0.f};
            if (st <= LT) { f32x4 acc = (f32x4){0.f, 0.f, 0.f, 0.f};
#pragma unroll
                for (int ks = 0; ks < 4; ++ks) { const bf16x8 af = *(const LAS bf16x8*)(Bs + (16 * st + r16) * 136 + ks * 32 + quad * 8); acc = MFMA16(af, cf[ks], acc); }
                const f32x4 as4 = *(const LAS f32x4*)(acs_s + 16 * st + 4 * quad);
#pragma unroll
                for (int j = 0; j < 4; ++j) { const float v = acc[j] * __expf(acs_l - as4[j]); mm[hf][j] = (st == LT && (4 * quad + j > r16)) ? 0.f : v; } } }
        u32x4 mp; mp.x = pk2(mm[0][0], mm[0][1]); mp.y = pk2(mm[0][2], mm[0][3]); mp.z = pk2(mm[1][0], mm[1][1]); mp.w = pk2(mm[1][2], mm[1][3]);
        const bf16x8 mf = __builtin_bit_cast(bf16x8, mp);
#pragma unroll
        for (int pt = 0; pt < 2; ++pt) { const LAS bf16* xp = XTs + (16 * pt + r16) * 136 + 32 * t + 4 * quad;
            const u32x2 lo = *(const LAS u32x2*)xp, hi = *(const LAS u32x2*)(xp + 16);
            const bf16x8 xf = __builtin_bit_cast(bf16x8, ((u32x4){lo.x, lo.y, hi.x, hi.y}));
            Yd[pt] = MFMA16(mf, xf, Yd[pt]); }
    }
}
__device__ __forceinline__ void ssreduce_phase(const float* PS, float* RS) {
    for (int t = blockIdx.x * NTHR + threadIdx.x; t < T; t += gridDim.x * NTHR) { float s = 0.f;
#pragma unroll 16
        for (int q = 0; q < 64; ++q) s += PS[(size_t)q * T + t];
        RS[t] = rsqrtf(s * (1.0f / 2048.0f) + 1e-6f); }
}
template <bool REAL, int MODE = 15> __device__ __forceinline__ void ssd_phase(const bf16* XBC, bf16* Zb, const float* DT, const float* ACS, const float* a_log, const float* d_skip, const float* normg, float* SUMSQ, LAS unsigned char* L) {
    int tid_ = threadIdx.x; asm volatile("" : "+v"(tid_));
    const int tid = tid_, lane = tid & 63, w = __builtin_amdgcn_readfirstlane(tid >> 6), r16 = lane & 15, quad = lane >> 4;
    LAS bf16* Cs = (LAS bf16*)(L + SSD_CS); LAS bf16* Bs = (LAS bf16*)(L + SSD_BS); LAS bf16* XTs = (LAS bf16*)(L + SSD_XT); LAS bf16* XDs = (LAS bf16*)(L + SSD_XDT);
    LAS float* acs_s = (LAS float*)(L + SSD_ACS);
    LAS bf16* Wx = (LAS bf16*)(L + SSD_WSCR + w * 3840); LAS bf16* Wz = Wx + 640; LAS bf16* Wy = Wx + 1280;
    const int lt = w < 4 ? w : 11 - w;
    const int vcu = (gridDim.x == 256) ? (int)((blockIdx.x & 7) * 32 + (blockIdx.x >> 3)) : (int)blockIdx.x;
    for (int unit = vcu; unit < 256; unit += gridDim.x) {
        const int b = unit >> 6, h = (unit >> 1) & 31, ph = unit & 1, g = h >> 2;
        const float Dh = d_skip[h];
        const int xcol = h * 64 + ph * 32;
        const float ng0 = normg[xcol + r16], ng1 = normg[xcol + 16 + r16];
        for (int i = tid; i < 8704 / 4; i += NTHR) ((LAS unsigned*)(L + SSD_HS0))[i] = 0u;
        f32x4 Hst[2][2]; Hst[0][0] = Hst[0][1] = Hst[1][0] = Hst[1][1] = (f32x4){0.f, 0.f, 0.f, 0.f};
        int hb = 0;
        const int srow = tid >> 4, sg = tid & 15, lr = lane >> 2, part = lane & 3, lx = 16 * lt + lr;
        u32x4 cv[4], bv[4], xv, zv; float dtl, acl, aclast, a01;
#define SSD_LOAD(c_) do { const size_t tk = (size_t)b * SEQ + (size_t)(c_) * 128; \
            _Pragma("unroll") for (int i = 0; i < 4; ++i) { const bf16* src = XBC + (tk + srow + 32 * i) * 4096 + g * 128 + sg * 8; cv[i] = *(const u32x4*)(src + 3072); bv[i] = *(const u32x4*)(src + 2048); } \
            xv = *(const u32x4*)(XBC + (tk + lx) * 4096 + xcol + part * 8); zv = *(const u32x4*)(Zb + (tk + lx) * 2048 + xcol + part * 8); \
            dtl = DT[(tk + lx) * 32 + h]; acl = ACS[(tk + lx) * 32 + h]; aclast = ACS[(tk + 127) * 32 + h]; a01 = ACS[(tk + 2 * w * 0 + (tid & 127)) * 32 + h]; } while (0)
        SSD_LOAD(0);
        for (int c = 0; c < 64; ++c) {
            const size_t tok0 = (size_t)b * SEQ + (size_t)c * 128;
#pragma unroll
            for (int i = 0; i < 4; ++i) { const int l = srow + 32 * i; *(LAS u32x4*)(Cs + l * 136 + sg * 8) = cv[i]; *(LAS u32x4*)(Bs + l * 136 + sg * 8) = bv[i]; }
            if (tid < 128) acs_s[tid] = a01;
            const float acs_last = aclast;
            { const float dec = __expf(acs_last - acl);
                *(LAS u32x4*)(Wx + lr * 40 + part * 8) = xv; *(LAS u32x4*)(Wz + lr * 40 + part * 8) = zv;
#pragma unroll
                for (int e = 0; e < 8; ++e) { const unsigned xb = (xv[e >> 1] >> (16 * (e & 1))) & 0xffffu; const float xd = bf2f(xb) * dtl;
                    XTs[(part * 8 + e) * 136 + lx] = (bf16)f2bf(xd); XDs[(part * 8 + e) * 136 + lx] = (bf16)f2bf(xd * dec); } }
            __syncthreads();
            if (c < 63) SSD_LOAD(c + 1);
            __builtin_amdgcn_sched_barrier(0);
            bf16x8 cf[4];
#pragma unroll
            for (int ks = 0; ks < 4; ++ks) cf[ks] = *(const LAS bf16x8*)(Cs + (16 * lt + r16) * 136 + ks * 32 + quad * 8);
            const float acs_l = acs_s[16 * lt + r16];
            f32x4 Yd[2], Yo[2]; Yd[0] = Yd[1] = Yo[0] = Yo[1] = (f32x4){0.f, 0.f, 0.f, 0.f};
            if constexpr ((MODE & 1) != 0)
            switch (lt) {
                case 0: ssd_diag<0>(Bs, XTs, acs_s, cf, acs_l, r16, quad, Yd); break; case 1: ssd_diag<1>(Bs, XTs, acs_s, cf, acs_l, r16, quad, Yd); break;
                case 2: ssd_diag<2>(Bs, XTs, acs_s, cf, acs_l, r16, quad, Yd); break; case 3: ssd_diag<3>(Bs, XTs, acs_s, cf, acs_l, r16, quad, Yd); break;
                case 4: ssd_diag<4>(Bs, XTs, acs_s, cf, acs_l, r16, quad, Yd); break; case 5: ssd_diag<5>(Bs, XTs, acs_s, cf, acs_l, r16, quad, Yd); break;
                case 6: ssd_diag<6>(Bs, XTs, acs_s, cf, acs_l, r16, quad, Yd); break; default: ssd_diag<7>(Bs, XTs, acs_s, cf, acs_l, r16, quad, Yd); break; }
            if constexpr ((MODE & 2) != 0)
            { const LAS bf16* Hc = (const LAS bf16*)(L + (hb ? SSD_HS1 : SSD_HS0));
#pragma unroll
                for (int pt = 0; pt < 2; ++pt)
#pragma unroll
                    for (int ks = 0; ks < 4; ++ks) { const bf16x8 hf = *(const LAS bf16x8*)(Hc + (16 * pt + r16) * 136 + ks * 32 + quad * 8); Yo[pt] = MFMA16(cf[ks], hf, Yo[pt]); } }
            if constexpr ((MODE & 4) != 0) {
            float ssq[4] = {0.f, 0.f, 0.f, 0.f};
            { const f32x4 al4 = *(const LAS f32x4*)(acs_s + 16 * lt + 4 * quad);
#pragma unroll
            for (int j = 0; j < 4; ++j) { const int lrow = 4 * quad + j; const float el = __expf(al4[j]);
#pragma unroll
                for (int pt = 0; pt < 2; ++pt) { const int pcol = 16 * pt + r16;
                    float y = Yd[pt][j] + el * Yo[pt][j];
                    y += Dh * bf2f(Wx[lrow * 40 + pcol]);
                    const float gz = y * silu_f(bf2f(Wz[lrow * 40 + pcol])); ssq[j] += gz * gz;
                    Wy[lrow * 40 + pcol] = (bf16)f2bf(gz * (pt ? ng1 : ng0)); } } }
#pragma unroll
            for (int j = 0; j < 4; ++j) { float v = ssq[j]; v += __shfl_xor(v, 1); v += __shfl_xor(v, 2); v += __shfl_xor(v, 4); v += __shfl_xor(v, 8); ssq[j] = v; }
            { const float sv = r16 == 0 ? ssq[0] : r16 == 1 ? ssq[1] : r16 == 2 ? ssq[2] : ssq[3];
                if (r16 < 4) SUMSQ[(size_t)(h * 2 + ph) * T + tok0 + 16 * lt + 4 * quad + r16] = sv; }
            asm volatile("s_waitcnt lgkmcnt(0)" ::: "memory");
            { const u32x4 yv = *(const LAS u32x4*)(Wy + lr * 40 + part * 8);
                if (REAL) *(u32x4*)(Zb + (tok0 + 16 * lt + lr) * 2048 + xcol + part * 8) = yv; }
            } else { if (Yd[0][0] + Yd[1][0] + Yo[0][0] + Yo[1][0] == 12345.f) Wy[0] = 1; }
            if (((MODE & 8) != 0) && w < 4) {
                f32x4 a4[2][2];
#pragma unroll
                for (int q = 0; q < 2; ++q) a4[q][0] = a4[q][1] = (f32x4){0.f, 0.f, 0.f, 0.f};
#pragma unroll
                for (int ks = 0; ks < 4; ++ks) { bf16x8 af[2];
#pragma unroll
                    for (int pt = 0; pt < 2; ++pt) af[pt] = *(const LAS bf16x8*)(XDs + (16 * pt + r16) * 136 + ks * 32 + quad * 8);
#pragma unroll
                    for (int q = 0; q < 2; ++q) { bf16x8 bfr;
#pragma unroll
                        for (int j = 0; j < 8; ++j) bfr[j] = (short)Bs[(ks * 32 + quad * 8 + j) * 136 + 16 * (2 * w + q) + r16];
#pragma unroll
                        for (int pt = 0; pt < 2; ++pt) a4[q][pt] = MFMA16(af[pt], bfr, a4[q][pt]); } }
                const float cd = __expf(acs_last);
                LAS bf16* Hn = (LAS bf16*)(L + (hb ? SSD_HS0 : SSD_HS1));
#pragma unroll
                for (int q = 0; q < 2; ++q)
#pragma unroll
                    for (int pt = 0; pt < 2; ++pt)
#pragma unroll
                        for (int j = 0; j < 4; ++j) { const float hv = Hst[q][pt][j] * cd + a4[q][pt][j]; Hst[q][pt][j] = hv; Hn[(16 * pt + 4 * quad + j) * 136 + 16 * (2 * w + q) + r16] = (bf16)f2bf(hv); }
            }
            hb ^= 1;
            __syncthreads();
        }
#undef SSD_LOAD
    }
}

constexpr int AT_KS = 0, AT_VS = 18432, AT_SMAX = 35840;
template <bool DIAG, int NKT> __device__ __forceinline__ float att_elem(f32x4 (&S)[8], float suffix, int q_rel, int quad) {
    f32x4 Lg[8];
#pragma unroll
    for (int kt = 0; kt < NKT; ++kt) { const f32x4 y = S[kt]; f32x4 sp;
#pragma unroll
        for (int j = 0; j < 4; ++j) sp[j] = __builtin_amdgcn_logf(1.0f + __builtin_amdgcn_exp2f(-__builtin_fabsf(y[j])));
        f32x4 lg = -(sp + __builtin_elementwise_max(y, (f32x4){0.f, 0.f, 0.f, 0.f}));
        if (DIAG) {
#pragma unroll
            for (int j = 0; j < 4; ++j) if (!(16 * kt + 4 * quad + j < q_rel)) lg[j] = 0.f; }
        lg[2] += lg[3]; lg[1] += lg[2]; lg[0] += lg[1]; Lg[kt] = lg; }
    float tail = 0.f;
#pragma unroll
    for (int kt = NKT - 1; kt >= 0; --kt) { const float a = Lg[kt][0]; const float bq = __shfl_xor(a, 16), cq = __shfl_xor(a, 32), dq = __shfl_xor(bq, 32);
        const float E = quad == 0 ? (bq + cq + dq) : quad == 1 ? (cq + dq) : quad == 2 ? bq : 0.f;
        Lg[kt] = Lg[kt] + (E + tail);
        tail += (a + bq) + (cq + dq); }
#pragma unroll
    for (int kt = 0; kt < NKT; ++kt) { const f32x4 lw = (S[kt] + Lg[kt]) + suffix;
#pragma unroll
        for (int j = 0; j < 4; ++j) { float wv = __builtin_amdgcn_exp2f(lw[j]); if (DIAG && !(16 * kt + 4 * quad + j < q_rel)) wv = 0.f; S[kt][j] = wv; } }
    return tail;
}
template <bool DIAG, int NKT> __device__ __forceinline__ float att_block(const LAS bf16* Ks, const LAS bf16* Vs, const bf16x8 (&qf)[2], f32x4 (&O)[4], float suffix, int q_rel, int r16, int quad) {
    f32x4 S[8];
#pragma unroll
    for (int kt = 0; kt < 8; ++kt) S[kt] = (f32x4){0.f, 0.f, 0.f, 0.f};
#pragma unroll
    for (int kt = 0; kt < NKT; ++kt)
#pragma unroll
        for (int ks = 0; ks < 2; ++ks) { const bf16x8 kf = *(const LAS bf16x8*)(Ks + (16 * kt + r16) * 72 + ks * 32 + quad * 8); S[kt] = MFMA16(kf, qf[ks], S[kt]); }
    const float tail = att_elem<DIAG, NKT>(S, suffix, q_rel, quad);
#pragma unroll
    for (int t = 0; t < (NKT + 1) / 2; ++t) { u32x4 wp; wp.x = pk2(S[2 * t][0], S[2 * t][1]); wp.y = pk2(S[2 * t][2], S[2 * t][3]); wp.z = pk2(S[2 * t + 1][0], S[2 * t + 1][1]); wp.w = pk2(S[2 * t + 1][2], S[2 * t + 1][3]);
        const bf16x8 wf = __builtin_bit_cast(bf16x8, wp);
#pragma unroll
        for (int dt = 0; dt < 4; ++dt) { const LAS bf16* vp = Vs + (16 * dt + r16) * 136 + 32 * t + 4 * quad;
            const u32x2 lo = *(const LAS u32x2*)vp, hi = *(const LAS u32x2*)(vp + 16);
            const bf16x8 vf = __builtin_bit_cast(bf16x8, ((u32x4){lo.x, lo.y, hi.x, hi.y}));
            O[dt] = MFMA16(wf, vf, O[dt]); } }
    return tail;
}
template <bool REAL> __device__ __forceinline__ void attn_phase(bf16* QO, const bf16* Kb, const bf16* VT, LAS unsigned char* L) {
    int tid_ = threadIdx.x; asm volatile("" : "+v"(tid_));
    const int tid = tid_, lane = tid & 63, w = __builtin_amdgcn_readfirstlane(tid >> 6), r16 = lane & 15, quad = lane >> 4;
    LAS bf16* Ks = (LAS bf16*)(L + AT_KS); LAS bf16* Vs = (LAS bf16*)(L + AT_VS); LAS float* smax_s = (LAS float*)(L + AT_SMAX);
    const int ks_s = tid >> 2, ks_p = tid & 3, vs_d = tid >> 3, vs_p = tid & 7;
    u32x4 pk0, pk1, pv0, pv1; bf16x8 qn[2];
#define ATT_LOAD(b_, h_, kb_) do { const bf16* src = Kb + ((size_t)(b_) * SEQ + (kb_) * 128 + ks_s) * 1024 + (h_) * 64 + ks_p * 16; pk0 = *(const u32x4*)src; pk1 = *(const u32x4*)(src + 8); \
        const bf16* vsrc = VT + (size_t)((h_) * 64 + vs_d) * T + (size_t)(b_) * SEQ + (kb_) * 128 + vs_p * 16; pv0 = *(const u32x4*)vsrc; pv1 = *(const u32x4*)(vsrc + 8); } while (0)
#define ATT_QLOAD(b_, h_, qb_) do { const size_t rq_ = (size_t)(b_) * SEQ + (qb_) * 128 + 16 * w; \
        _Pragma("unroll") for (int ks = 0; ks < 2; ++ks) qn[ks] = *(const bf16x8*)(QO + (rq_ + r16) * 1024 + (h_) * 64 + ks * 32 + quad * 8); } while (0)
    if ((int)blockIdx.x < 4096) { const int u0 = blockIdx.x, bh0 = u0 & 63, qb0 = 63 - (u0 >> 6); ATT_QLOAD(bh0 >> 4, bh0 & 15, qb0); ATT_LOAD(bh0 >> 4, bh0 & 15, qb0); }
    for (int unit = blockIdx.x; unit < 4096; unit += gridDim.x) {
        const int bh = unit & 63, qb = 63 - (unit >> 6), b = bh >> 4, h = bh & 15;
        const size_t rowq = (size_t)b * SEQ + qb * 128 + 16 * w;
        bf16x8 qf[2]; qf[0] = qn[0]; qf[1] = qn[1];
        f32x4 O[4]; O[0] = O[1] = O[2] = O[3] = (f32x4){0.f, 0.f, 0.f, 0.f};
        float suffix = 0.f, wsm = 0.f;
        const int q_rel = 16 * w + r16;
        for (int kb = qb; kb >= 0; --kb) {
            *(LAS u32x4*)(Ks + ks_s * 72 + ks_p * 16) = pk0; *(LAS u32x4*)(Ks + ks_s * 72 + ks_p * 16 + 8) = pk1;
            *(LAS u32x4*)(Vs + vs_d * 136 + vs_p * 16) = pv0; *(LAS u32x4*)(Vs + vs_d * 136 + vs_p * 16 + 8) = pv1;
            __syncthreads();
            if (kb > 0) ATT_LOAD(b, h, kb - 1);
            __builtin_amdgcn_sched_barrier(0);
            if (wsm > -160.f) {
                float tail;
                if (kb != qb) tail = att_block<false, 8>(Ks, Vs, qf, O, suffix, q_rel, r16, quad);
                else switch (w) {
                    case 0: tail = att_block<true, 1>(Ks, Vs, qf, O, suffix, q_rel, r16, quad); break; case 1: tail = att_block<true, 2>(Ks, Vs, qf, O, suffix, q_rel, r16, quad); break;
                    case 2: tail = att_block<true, 3>(Ks, Vs, qf, O, suffix, q_rel, r16, quad); break; case 3: tail = att_block<true, 4>(Ks, Vs, qf, O, suffix, q_rel, r16, quad); break;
                    case 4: tail = att_block<true, 5>(Ks, Vs, qf, O, suffix, q_rel, r16, quad); break; case 5: tail = att_block<true, 6>(Ks, Vs, qf, O, suffix, q_rel, r16, quad); break;
                    case 6: tail = att_block<true, 7>(Ks, Vs, qf, O, suffix, q_rel, r16, quad); break; default: tail = att_block<true, 8>(Ks, Vs, qf, O, suffix, q_rel, r16, quad); break; }
                suffix += tail;
                float sm = suffix; sm = fmaxf(sm, __shfl_xor(sm, 1)); sm = fmaxf(sm, __shfl_xor(sm, 2)); sm = fmaxf(sm, __shfl_xor(sm, 4)); sm = fmaxf(sm, __shfl_xor(sm, 8));
                wsm = sm;
            }
            if (lane == 0) smax_s[w] = wsm;
            __syncthreads();
            float mall = smax_s[0];
#pragma unroll
            for (int i = 1; i < 8; ++i) mall = fmaxf(mall, smax_s[i]);
            if (mall < -160.f) break;
        }
        { const int nu = unit + gridDim.x; if (nu < 4096) { const int nbh = nu & 63, nqb = 63 - (nu >> 6); ATT_QLOAD(nbh >> 4, nbh & 15, nqb); ATT_LOAD(nbh >> 4, nbh & 15, nqb); } }
        __builtin_amdgcn_sched_barrier(0);
#pragma unroll
        for (int dt = 0; dt < 4; ++dt)
#pragma unroll
            for (int j = 0; j < 4; ++j) if (REAL) QO[(rowq + 4 * quad + j) * 1024 + h * 64 + 16 * dt + r16] = (bf16)f2bf(O[dt][j]);
    }
}
#undef ATT_LOAD
#undef ATT_QLOAD

#define XB_TMO      128
#define XB_XCNT(j)  (256  + 64 * (j))
#define XB_XSUB(j)  (1280 + 64 * (j))
#define XB_XGEN(j)  (2304 + 64 * (j))
#define XB_TOP      3328
#define XB_TOPGEN   3392
#define XCD_BAR_WORDS 3456
#define XB_SPIN_CAP (1u << 20)

__device__ __forceinline__ unsigned xb_ld(unsigned* p)              { return __hip_atomic_load(p, __ATOMIC_RELAXED, __HIP_MEMORY_SCOPE_AGENT); }
__device__ __forceinline__ unsigned xb_add(unsigned* p, unsigned v) { return __hip_atomic_fetch_add(p, v, __ATOMIC_RELAXED, __HIP_MEMORY_SCOPE_AGENT); }
__device__ __forceinline__ unsigned xb_xcc_id() { return (unsigned)__builtin_amdgcn_s_getreg((3 << 11) | 20) & 0xFu; }
#define XB_SPIN(cond, bar) do { unsigned _sp = 0; while (cond) { __builtin_amdgcn_s_sleep(1); \
    if ((++_sp & 255u) == 0u) { if (xb_ld(&(bar)[XB_TMO])) break; if (_sp > XB_SPIN_CAP) { atomicAdd(&(bar)[XB_TMO], 1u); break; } } } } while (0)

struct XcdBarrier {
    unsigned* bar; unsigned x;
    volatile LAS unsigned* st;
};

__device__ __forceinline__ XcdBarrier xcd_barrier_post(unsigned* bar, volatile LAS unsigned* st) {
    XcdBarrier b; b.bar = bar; b.x = xb_xcc_id(); b.st = st;
    if (threadIdx.x == 0) (void)xb_add(&bar[XB_XCNT(b.x)], 1u);
    return b;
}
__device__ __forceinline__ void xcd_barrier_complete(unsigned* bar, unsigned x, unsigned& nloc, unsigned& nx) {
    const unsigned G = gridDim.x * gridDim.y * gridDim.z;
    unsigned sum, cnt, mine, sp = 0u;
    for (;;) {
        sum = 0u; cnt = 0u; mine = 0u;
#pragma unroll
        for (unsigned j = 0; j < 16; ++j) { const unsigned c = xb_ld(&bar[XB_XCNT(j)]); sum += c; cnt += (c > 0u) ? 1u : 0u; mine = (j == x) ? c : mine; }
        if (sum == G) break;
        __builtin_amdgcn_s_sleep(1);
        if ((++sp & 255u) == 0u) { if (xb_ld(&bar[XB_TMO])) break; if (sp > XB_SPIN_CAP) { atomicAdd(&bar[XB_TMO], 1u); break; } }
    }
    nloc = mine > 0u ? mine : 1u; nx = cnt > 0u ? cnt : 1u;
}

__device__ __forceinline__ void xcd_barrier(const XcdBarrier& b) {
    asm volatile("s_waitcnt vmcnt(0)" ::: "memory");
    __syncthreads();
    if (threadIdx.x == 0) {
        unsigned* bar = b.bar;
        __builtin_amdgcn_s_waitcnt(0);
        unsigned nloc = b.st[0], nx = b.st[1];
        if (nloc == 0u) { xcd_barrier_complete(bar, b.x, nloc, nx); b.st[0] = nloc; b.st[1] = nx; }
        const unsigned old = xb_add(&bar[XB_XSUB(b.x)], 1u);
        const unsigned gen = old / nloc;
        if (old + 1u == (gen + 1u) * nloc) {
            __builtin_amdgcn_fence(__ATOMIC_RELEASE, "agent");
            asm volatile("s_waitcnt vmcnt(0)" ::: "memory");
            const unsigned og = xb_add(&bar[XB_TOP], 1u);
            const unsigned tg = og / nx;
            if (og + 1u == (tg + 1u) * nx) xb_add(&bar[XB_TOPGEN], 1u);
            else XB_SPIN(xb_ld(&bar[XB_TOPGEN]) == tg, bar);
            __builtin_amdgcn_fence(__ATOMIC_ACQUIRE, "agent");
            xb_add(&bar[XB_XGEN(b.x)], 1u);
            asm volatile("s_waitcnt vmcnt(0)" ::: "memory");
        } else {
            XB_SPIN(xb_ld(&bar[XB_XGEN(b.x)]) == gen, bar);
            __builtin_amdgcn_fence(__ATOMIC_ACQUIRE, "agent");
            asm volatile("s_waitcnt vmcnt(0)" ::: "memory");
        }
    }
    __syncthreads();
}

#ifndef DUPMASK
#define DUPMASK 0
#endif
#ifndef SSD_DMODE
#define SSD_DMODE 15
#endif
#define DUP(k) constexpr ((DUPMASK >> (k)) & 1)
__global__ void __launch_bounds__(NTHR, 2) yoco_fwd(Params p) {
    extern __shared__ __attribute__((aligned(16))) unsigned char lds[];
    LAS unsigned char* L = (LAS unsigned char*)lds;
    cg::grid_group grid = cg::this_grid();
    if (threadIdx.x < 2) ((LAS unsigned*)(L + LDS_BYTES - 16))[threadIdx.x] = 0u;
    __syncthreads();
    const XcdBarrier xbar = xcd_barrier_post((unsigned*)(p.ws + WS_BAR), (volatile LAS unsigned*)(L + LDS_BYTES - 16));
    if (gridDim.x > 65536u) grid.sync();
#define GSYNC() xcd_barrier(xbar)
    unsigned char* ws = p.ws;
    bf16* WB = (bf16*)(ws + WS_W);
    float* MODS = (float*)(ws + WS_MODS); float* SUMSQ = (float*)(ws + WS_SUMSQ);
    bf16* X = (bf16*)(ws + WS_X);
    bf16* H0 = (bf16*)(ws + WS_X); float* DTb = (float*)(ws + WS_X + 64 * MiB); float* ACSb = (float*)(ws + WS_X + 92 * MiB); float* PSb = (float*)(ws + WS_X + 96 * MiB); float* P0b = (float*)(ws + WS_X + 68 * MiB); float* UH0 = (float*)(ws + WS_X + 80 * MiB);
    bf16* XBC = (bf16*)(ws + WS_BIG); bf16* Gb = (bf16*)(ws + WS_BIG); bf16* H = (bf16*)(ws + WS_BIG + 176 * MiB);
    float* P1b = (float*)(ws + WS_BIG + 240 * MiB); float* UH1 = (float*)(ws + WS_BIG + 248 * MiB);
    bf16* HK = (bf16*)(ws + WS_BIG); bf16* QO = (bf16*)(ws + WS_BIG + 64 * MiB);
    bf16* Zb = (bf16*)p.out; bf16* Kb = (bf16*)p.out; bf16* VT = (bf16*)((unsigned char*)p.out + 64 * MiB);
    LAS float* xch = (LAS float*)(L + XCH_OFF);
    const int G_ = gridDim.x, c_ = blockIdx.x;
    using pg8::Gemm; using pg8::StaticOrder;

#ifndef PHM
#define PHM 0xffff
#endif
#define EN(x) constexpr ((PHM >> (x)) & 1)
    unsigned long long* TS = (unsigned long long*)(ws + WS_FLAGS + 4096);
    STAMP(0);
if DUP(1) { if EN(0) p0_phase(p, L); GSYNC(); }
        if EN(0) p0_phase(p, L);
    GSYNC(); STAMP(1);
if DUP(2) { if EN(1) norm_phase<1, false>(p.in[0], p.in[4], MODS + 0, H0, nullptr, nullptr, nullptr); GSYNC(); }
        if EN(1) norm_phase<1, false>(p.in[0], p.in[4], MODS + 0, H0, nullptr, nullptr, nullptr);
    GSYNC(); STAMP(2);
    if DUP(3) { if EN(2) {
        Gemm g{H0, WB + W_IN, T, 2304, 1024}; StaticOrder S; S.init(T, 2304, G_, c_);
        pg8::EpiZdt E{Zb, DTb, p.in[9]};
        pg8::gemm_phase<pg8::EpiZdt, StaticOrder, true, true>(L, g, S, E);
    }
    if EN(2) {
        Gemm g{H0, WB + W_IN + (size_t)2304 * 1024, T, 4096, 1024}; StaticOrder S; S.init(T, 4096, G_, c_);
        pg8::EpiMamba E{XBC, P0b, UH0, p.in[7], p.in[8], xch};
        pg8::gemm_phase<pg8::EpiMamba, StaticOrder, true, true>(L, g, S, E);
    } GSYNC(); }
    if EN(2) {
        Gemm g{H0, WB + W_IN, T, 2304, 1024}; StaticOrder S; S.init(T, 2304, G_, c_);
        pg8::EpiZdt E{Zb, DTb, p.in[9]};
        pg8::gemm_phase<pg8::EpiZdt, StaticOrder, true, true>(L, g, S, E);
    }
    if EN(2) {
        Gemm g{H0, WB + W_IN + (size_t)2304 * 1024, T, 4096, 1024}; StaticOrder S; S.init(T, 4096, G_, c_);
        pg8::EpiMamba E{XBC, P0b, UH0, p.in[7], p.in[8], xch};
        pg8::gemm_phase<pg8::EpiMamba, StaticOrder, true, true>(L, g, S, E);
    }
    GSYNC(); STAMP(3);
#ifdef XSYNC
    for (int i = 0; i < XSYNC; ++i) GSYNC();
#endif
    if EN(3) { fixup_mamba(P0b, UH0, p.in[7], p.in[8], XBC); acs_phase(DTb, p.in[10], ACSb); }
    GSYNC(); STAMP(4);
    if DUP(5) { ssd_phase<false, SSD_DMODE>(XBC, Zb, DTb, ACSb, p.in[10], p.in[11], p.in[12], PSb, L); GSYNC(); }
    if EN(4) ssd_phase<true>(XBC, Zb, DTb, ACSb, p.in[10], p.in[11], p.in[12], PSb, L);
    GSYNC();
    ssreduce_phase(PSb, SUMSQ);
    GSYNC(); STAMP(5);
    if DUP(6) { if EN(5) {
        Gemm g{Zb, WB + W_SOUT, T, 1024, 2048}; StaticOrder S; S.init(T, 1024, G_, c_);
        pg8::EpiRes<true> E{p.in[0], X, MODS + 2048, SUMSQ};
        pg8::gemm_phase<pg8::EpiRes<true>, StaticOrder, true, true>(L, g, S, E);
    } GSYNC(); }
    if EN(5) {
        Gemm g{Zb, WB + W_SOUT, T, 1024, 2048}; StaticOrder S; S.init(T, 1024, G_, c_);
        pg8::EpiRes<true> E{p.in[0], X, MODS + 2048, SUMSQ};
        pg8::gemm_phase<pg8::EpiRes<true>, StaticOrder, true, true>(L, g, S, E);
    }
    GSYNC(); STAMP(6);
    {
        const float* md = MODS;
if DUP(7) { norm_phase_b<1, false>(X, p.in[5] + 0, md + 3072, H, nullptr, nullptr, nullptr); GSYNC(); }
            norm_phase_b<1, false>(X, p.in[5] + 0, md + 3072, H, nullptr, nullptr, nullptr);
        GSYNC(); STAMP(7);
        if DUP(8) { if EN(9) { Gemm g{H, WB + (W_FIN0), T, 5632, 1024}; StaticOrder S; S.init(T, 5632, G_, c_);
          pg8::EpiFFN E{Gb, P1b, UH1, p.in[22] + 0, p.in[23] + 0, xch};
          pg8::gemm_phase<pg8::EpiFFN, StaticOrder, true, true>(L, g, S, E); } GSYNC(); }
    if EN(9) { Gemm g{H, WB + (W_FIN0), T, 5632, 1024}; StaticOrder S; S.init(T, 5632, G_, c_);
          pg8::EpiFFN E{Gb, P1b, UH1, p.in[22] + 0, p.in[23] + 0, xch};
          pg8::gemm_phase<pg8::EpiFFN, StaticOrder, true, true>(L, g, S, E); }
        GSYNC(); STAMP(8);
        if EN(10) fixup_ffn(P1b, UH1, p.in[22] + 0, p.in[23] + 0, Gb);
        GSYNC(); STAMP(9);
        if DUP(10) { if EN(11) { Gemm g{Gb, WB + (W_FOUT0), T, 1024, 2816}; StaticOrder S; S.init(T, 1024, G_, c_); pg8::EpiRes<false> E{X, (bf16*)p.out, md + 5120, nullptr};
          pg8::gemm_phase<pg8::EpiRes<false>, StaticOrder, true, true>(L, g, S, E); } GSYNC(); }
    if EN(11) { Gemm g{Gb, WB + (W_FOUT0), T, 1024, 2816}; StaticOrder S; S.init(T, 1024, G_, c_); pg8::EpiRes<false> E{X, X, md + 5120, nullptr};
          pg8::gemm_phase<pg8::EpiRes<false>, StaticOrder, true, true>(L, g, S, E); }
        GSYNC(); STAMP(10);
    }
    {
        const float* md = MODS + MOD_L;
if DUP(11) { norm_phase_b<2, false>(X, p.in[16], MODS + MOD_KV, HK, p.in[4] + 1024, md + 0, H); GSYNC(); }
                norm_phase_b<2, false>(X, p.in[16], MODS + MOD_KV, HK, p.in[4] + 1024, md + 0, H);
            GSYNC(); STAMP(11);
            if DUP(12) { if EN(6) { Gemm g{HK, WB + W_K, T, 1024, 1024}; StaticOrder S; S.init(T, 1024, G_, c_); pg8::EpiStore E{Kb, 1024, 1.0f};
              pg8::gemm_phase<pg8::EpiStore, StaticOrder, true, true>(L, g, S, E); }
            if EN(6) { Gemm g{WB + W_V, HK, 1024, T, 1024}; StaticOrder S; S.init(1024, T, G_, c_); pg8::EpiStore E{VT, T, 1.0f};
              pg8::gemm_phase<pg8::EpiStore, StaticOrder, true, true>(L, g, S, E); }
            if EN(6) { Gemm g{H, WB + W_Q, T, 1024, 1024}; StaticOrder S; S.init(T, 1024, G_, c_); pg8::EpiStore E{QO, 1024, 0.125f * 1.4426950408889634f};
              pg8::gemm_phase<pg8::EpiStore, StaticOrder, true, true>(L, g, S, E); } GSYNC(); }
    if EN(6) { Gemm g{HK, WB + W_K, T, 1024, 1024}; StaticOrder S; S.init(T, 1024, G_, c_); pg8::EpiStore E{Kb, 1024, 1.0f};
              pg8::gemm_phase<pg8::EpiStore, StaticOrder, true, true>(L, g, S, E); }
            if EN(6) { Gemm g{WB + W_V, HK, 1024, T, 1024}; StaticOrder S; S.init(1024, T, G_, c_); pg8::EpiStore E{VT, T, 1.0f};
              pg8::gemm_phase<pg8::EpiStore, StaticOrder, true, true>(L, g, S, E); }
            if EN(6) { Gemm g{H, WB + W_Q, T, 1024, 1024}; StaticOrder S; S.init(T, 1024, G_, c_); pg8::EpiStore E{QO, 1024, 0.125f * 1.4426950408889634f};
              pg8::gemm_phase<pg8::EpiStore, StaticOrder, true, true>(L, g, S, E); }
            GSYNC(); STAMP(12);
            if DUP(13) { attn_phase<false>(QO, Kb, VT, L); GSYNC(); }
            if EN(7) attn_phase<true>(QO, Kb, VT, L);
            GSYNC(); STAMP(13);
            if DUP(14) { if EN(8) { Gemm g{QO, WB + W_O, T, 1024, 1024}; StaticOrder S; S.init(T, 1024, G_, c_); pg8::EpiRes<false> E{X, (bf16*)p.out, md + 2048, nullptr};
              pg8::gemm_phase<pg8::EpiRes<false>, StaticOrder, true, true>(L, g, S, E); } GSYNC(); }
    if EN(8) { Gemm g{QO, WB + W_O, T, 1024, 1024}; StaticOrder S; S.init(T, 1024, G_, c_); pg8::EpiRes<false> E{X, X, md + 2048, nullptr};
              pg8::gemm_phase<pg8::EpiRes<false>, StaticOrder, true, true>(L, g, S, E); }
            GSYNC(); STAMP(14);
if DUP(15) { norm_phase_b<1, false>(X, p.in[5] + 1024, md + 3072, H, nullptr, nullptr, nullptr); GSYNC(); }
            norm_phase_b<1, false>(X, p.in[5] + 1024, md + 3072, H, nullptr, nullptr, nullptr);
        GSYNC(); STAMP(15);
        if DUP(16) { if EN(9) { Gemm g{H, WB + (W_FIN1), T, 5632, 1024}; StaticOrder S; S.init(T, 5632, G_, c_);
          pg8::EpiFFN E{Gb, P1b, UH1, p.in[22] + 16896, p.in[23] + 5632, xch};
          pg8::gemm_phase<pg8::EpiFFN, StaticOrder, true, true>(L, g, S, E); } GSYNC(); }
    if EN(9) { Gemm g{H, WB + (W_FIN1), T, 5632, 1024}; StaticOrder S; S.init(T, 5632, G_, c_);
          pg8::EpiFFN E{Gb, P1b, UH1, p.in[22] + 16896, p.in[23] + 5632, xch};
          pg8::gemm_phase<pg8::EpiFFN, StaticOrder, true, true>(L, g, S, E); }
        GSYNC(); STAMP(16);
        if EN(10) fixup_ffn(P1b, UH1, p.in[22] + 16896, p.in[23] + 5632, Gb);
        GSYNC(); STAMP(17);
        if DUP(18) { if EN(11) { Gemm g{Gb, WB + (W_FOUT1), T, 1024, 2816}; StaticOrder S; S.init(T, 1024, G_, c_); pg8::EpiRes<false> E{X, (bf16*)p.out, md + 5120, nullptr};
          pg8::gemm_phase<pg8::EpiRes<false>, StaticOrder, true, true>(L, g, S, E); } GSYNC(); }
    if EN(11) { Gemm g{Gb, WB + (W_FOUT1), T, 1024, 2816}; StaticOrder S; S.init(T, 1024, G_, c_); pg8::EpiRes<false> E{X, X, md + 5120, nullptr};
          pg8::gemm_phase<pg8::EpiRes<false>, StaticOrder, true, true>(L, g, S, E); }
        GSYNC(); STAMP(18);
    }
if DUP(19) { norm_phase_b<1, true>(X, p.in[27], MODS + MOD_FIN, p.out, nullptr, nullptr, nullptr); GSYNC(); }
        norm_phase_b<1, true>(X, p.in[27], MODS + MOD_FIN, p.out, nullptr, nullptr, nullptr);
#ifdef PROBE
    GSYNC(); STAMP(19);
    __threadfence();
    {   volatile unsigned long long* tsv = TS; float ta = 0.f, tb = 0.f;
        for (int k = 1; k <= 19; ++k) { const float d = (float)(tsv[k] - tsv[k - 1]) * 0.01f; if ((PROBE_A >> k) & 1) ta += d; if ((PROBE_B >> k) & 1) tb += d; }
        for (int i = blockIdx.x * NTHR + threadIdx.x; i < (1 << 22); i += gridDim.x * NTHR) p.out[(1 << 24) + i] = tb;
        if (blockIdx.x == 0 && threadIdx.x == 0) p.out[0] = ta * 10.0f; }
#endif
}

extern "C" void kernel_launch(void* const* d_in, const int* in_sizes, int n_in, void* d_out, int out_size, void* d_ws, size_t ws_size, hipStream_t stream) {
    static int grid = 0;
    if (grid == 0) {
        if (n_in != 28 || out_size != T * D || ws_size < WS_END) { fprintf(stderr, "kernel_launch: unexpected shapes (n_in %d out %d ws %zu)\n", n_in, out_size, ws_size); grid = -1; return; }
        int dev = 0, cus = 0, per_cu = 0;
        hipGetDevice(&dev); hipDeviceGetAttribute(&cus, hipDeviceAttributeMultiprocessorCount, dev);
        hipFuncSetAttribute((const void*)yoco_fwd, hipFuncAttributeMaxDynamicSharedMemorySize, LDS_BYTES);
        hipOccupancyMaxActiveBlocksPerMultiprocessor(&per_cu, (const void*)yoco_fwd, NTHR, LDS_BYTES);
        if (per_cu < 1) per_cu = 1;
        grid = cus * per_cu; if (grid > 256) grid = 256;
        (void)hipGetLastError();
    }
    if (grid < 0) return;
    Params p{};
    for (int i = 0; i < 28; ++i) p.in[i] = (const float*)d_in[i];
    p.out = (float*)d_out; p.ws = (unsigned char*)d_ws;
    (void)hipMemsetAsync((unsigned char*)d_ws + WS_BAR, 0, 16384, stream);
    void* args[] = {&p};
    hipError_t e = hipLaunchCooperativeKernel((const void*)yoco_fwd, dim3(grid), dim3(NTHR), args, LDS_BYTES, stream);
    if (e != hipSuccess) fprintf(stderr, "cooperative launch failed: %s (grid %d)\n", hipGetErrorString(e), grid);
}
```

```cpp
#include <hip/hip_runtime.h>
#include <hip/hip_cooperative_groups.h>
#include <cstdio>
#include <cstdint>
namespace cg = cooperative_groups;
#ifndef DBG
#define DBG 0
#endif
namespace pg8 {
#define PG8_LAS __attribute__((address_space(3)))
typedef unsigned short bf16_t;
typedef short bf16x8 __attribute__((ext_vector_type(8)));
typedef float f32x4 __attribute__((ext_vector_type(4)));
typedef unsigned u32x4 __attribute__((ext_vector_type(4)));
constexpr int BM = 256, BK = 64, HALF = 128, HTB = HALF * BK * 2  , STAGE_BYTES = 8 * HTB, NXCD = 8, WGM = 8;

__host__ __device__ __forceinline__ int lds_byte(int r, int c) { const int st = (r >> 4) * 2 + (c >> 5), rr = r & 15, cc = c & 31, ob = rr * 64 + cc * 2; return st * 1024 + (ob ^ (((ob >> 9) & 1) << 5)); }
__host__ __device__ __forceinline__ void stage_rc(int b, int& R, int& C) { const int st = b / 1024, sb = b % 1024, swz = sb ^ (((sb >> 9) & 1) << 5); R = (st >> 1) * 16 + swz / 64; C = (st & 1) * 32 + (swz % 64) / 2; }
__host__ __device__ __forceinline__ int perm32(int rho) { const int n = rho >> 4, i = rho & 15; return 8 * (i >> 2) + 4 * n + (i & 3); }

struct Unit { int pm, pn; };
struct Gemm { const bf16_t* A; const bf16_t* Bt; int M, N, K; };

struct StaticOrder {
    int nM, nN, nwg, G, c;
    __host__ __device__ void init(int M, int N, int G_, int c_) { nM = M / BM; nN = N / BM; nwg = nM * nN; G = G_; c = c_; }
    __host__ __device__ bool next(int i, Unit& u) const {
        const long L = (long)i * G + c; if (L >= nwg) return false;
        int wgid = (int)L; { const int q = nwg / NXCD, r = nwg % NXCD, xcd = wgid % NXCD, off = wgid / NXCD; wgid = (xcd < r ? xcd * (q + 1) : r * (q + 1) + (xcd - r) * q) + off; }
        const int nig = WGM * nN, gid = wgid / nig, fm = gid * WGM, gsz = (nM - fm) < WGM ? (nM - fm) : WGM;
        u.pm = fm + ((wgid % nig) % gsz); u.pn = (wgid % nig) / gsz; return true;
    }
    __device__ __forceinline__ void a_ready(const Unit&) const {}
    __device__ __forceinline__ void done(const Unit&) const {}
};

__device__ __forceinline__ unsigned cvt_pk_bf16(float lo, float hi) { unsigned r; asm volatile("v_cvt_pk_bf16_f32 %0, %1, %2" : "=v"(r) : "v"(lo), "v"(hi)); return r; }

typedef unsigned u32x2 __attribute__((ext_vector_type(2)));
typedef float f32x2 __attribute__((ext_vector_type(2)));
__device__ __forceinline__ float silu_f(float x) { return x * __builtin_amdgcn_rcpf(1.f + __expf(-x)); }
__device__ __forceinline__ f32x2 silu2(f32x2 x) { const f32x2 t = x * (-1.4426950408889634f); f32x2 d; d.x = __builtin_amdgcn_exp2f(t.x); d.y = __builtin_amdgcn_exp2f(t.y); d = d + 1.0f;
    f32x2 r; r.x = __builtin_amdgcn_rcpf(d.x); r.y = __builtin_amdgcn_rcpf(d.y); return x * r; }
__device__ __forceinline__ float softplus_f(float x) { return fmaxf(x, 0.f) + __logf(1.f + __expf(-fabsf(x))); }
template <int K> __device__ __forceinline__ float dpp_ror(float v) { return __int_as_float(__builtin_amdgcn_update_dpp(0, __float_as_int(v), 0x120 + K, 0xf, 0xf, false)); }
template <int K> __device__ __forceinline__ float dpp_shr_keep(float cur, float old) { return __int_as_float(__builtin_amdgcn_update_dpp(__float_as_int(old), __float_as_int(cur), 0x110 + K, 0xf, 0xf, false)); }
template <int K> __device__ __forceinline__ float shift1(float cur, float prev, float halo, bool first) { const float old = first ? halo : dpp_ror<K>(prev); return dpp_shr_keep<K>(cur, old); }
template <int K> __device__ __forceinline__ f32x4 shift_rows(const f32x4 cur, const f32x4 prev, const f32x4 halo, bool first) {
    f32x4 r;
#pragma unroll
    for (int e = 0; e < 4; ++e) { const float old = first ? halo[e] : dpp_ror<K>(prev[e]); r[e] = dpp_shr_keep<K>(cur[e], old); }
    return r;
}

struct EpiStore {
    static constexpr bool PERM = true, AFTER_DRAIN = false, ROWPERM = false;
    bf16_t* O; int ldc; float sc;
    __device__ __forceinline__ void operator()(const f32x4 (&acc)[2][2][4][2], const Unit& u, int wr, int wc, int fr, int fq) const {
        asm volatile("" : "+v"(fr), "+v"(fq));
        const int row0 = u.pm * BM + wr * 64 + fr, col0 = u.pn * BM + wc * 32 + 8 * fq;
#pragma unroll
        for (int ai = 0; ai < 2; ++ai)
#pragma unroll
            for (int m = 0; m < 4; ++m) { bf16_t* rowp = O + (size_t)(row0 + ai * HALF + m * 16) * ldc + col0;
#pragma unroll
                for (int bj = 0; bj < 2; ++bj) { const f32x4 v0 = acc[ai][bj][m][0] * sc, v1 = acc[ai][bj][m][1] * sc;
                    u32x4 w; w.x = cvt_pk_bf16(v0[0], v0[1]); w.y = cvt_pk_bf16(v0[2], v0[3]); w.z = cvt_pk_bf16(v1[0], v1[1]); w.w = cvt_pk_bf16(v1[2], v1[3]);
                    *(u32x4*)(rowp + bj * HALF) = w; } }
    }
};

template <bool XIN_F32> struct EpiRes {
    static constexpr bool PERM = true, AFTER_DRAIN = false, ROWPERM = false;
    const void* xin; bf16_t* xout; const float* gate; const float* sumsq;
    __device__ __forceinline__ void operator()(const f32x4 (&acc)[2][2][4][2], const Unit& u, int wr, int wc, int fr, int fq) const {
        asm volatile("" : "+v"(fr), "+v"(fq));
        const int row0 = u.pm * BM + wr * 64 + fr, col0 = u.pn * BM + wc * 32 + 8 * fq;
        const float* gp = gate + (size_t)(u.pm >> 5) * 16384 + col0;
        f32x4 gv[2][2];
#pragma unroll
        for (int bj = 0; bj < 2; ++bj)
#pragma unroll
            for (int n = 0; n < 2; ++n) gv[bj][n] = *(const f32x4*)(gp + bj * HALF + n * 4);
#pragma unroll
        for (int ai = 0; ai < 2; ++ai)
#pragma unroll
            for (int m = 0; m < 4; ++m) { const int row = row0 + ai * HALF + m * 16;
                const float rs = sumsq ? sumsq[row] : 1.0f;
                const size_t off = (size_t)row * 1024 + col0;
#pragma unroll
                for (int bj = 0; bj < 2; ++bj) {
                    f32x4 x0, x1;
                    if (XIN_F32) { x0 = __builtin_nontemporal_load((const f32x4*)((const float*)xin + off + bj * HALF)); x1 = __builtin_nontemporal_load((const f32x4*)((const float*)xin + off + bj * HALF + 4)); }
                    else { const u32x4 xb = *(const u32x4*)((const bf16_t*)xin + off + bj * HALF);
                        x0 = (f32x4){__uint_as_float(xb.x << 16), __uint_as_float(xb.x & 0xffff0000u), __uint_as_float(xb.y << 16), __uint_as_float(xb.y & 0xffff0000u)};
                        x1 = (f32x4){__uint_as_float(xb.z << 16), __uint_as_float(xb.z & 0xffff0000u), __uint_as_float(xb.w << 16), __uint_as_float(xb.w & 0xffff0000u)}; }
                    const f32x4 v0 = x0 + gv[bj][0] * acc[ai][bj][m][0] * rs, v1 = x1 + gv[bj][1] * acc[ai][bj][m][1] * rs;
                    u32x4 w; w.x = cvt_pk_bf16(v0[0], v0[1]); w.y = cvt_pk_bf16(v0[2], v0[3]); w.z = cvt_pk_bf16(v1[0], v1[1]); w.w = cvt_pk_bf16(v1[2], v1[3]);
                    *(u32x4*)(xout + off + bj * HALF) = w; } }
    }
};

struct EpiZdt {
    static constexpr bool PERM = true, AFTER_DRAIN = false, ROWPERM = false;
    bf16_t* Z; float* DT; const float* dtb;
    __device__ __forceinline__ void operator()(const f32x4 (&acc)[2][2][4][2], const Unit& u, int wr, int wc, int fr, int fq) const {
        asm volatile("" : "+v"(fr), "+v"(fq));
        const int row0 = u.pm * BM + wr * 64 + fr;
        if (u.pn < 8) {
            const int col0 = u.pn * BM + wc * 32 + 8 * fq;
#pragma unroll
            for (int ai = 0; ai < 2; ++ai)
#pragma unroll
                for (int m = 0; m < 4; ++m) { bf16_t* rowp = Z + (size_t)(row0 + ai * HALF + m * 16) * 2048 + col0;
#pragma unroll
                    for (int bj = 0; bj < 2; ++bj) { const f32x4 v0 = acc[ai][bj][m][0], v1 = acc[ai][bj][m][1];
                        u32x4 w; w.x = cvt_pk_bf16(v0[0], v0[1]); w.y = cvt_pk_bf16(v0[2], v0[3]); w.z = cvt_pk_bf16(v1[0], v1[1]); w.w = cvt_pk_bf16(v1[2], v1[3]);
                        *(u32x4*)(rowp + bj * HALF) = w; } }
            return;
        }
        {
            if (wc == 0) {
#pragma unroll
                for (int n = 0; n < 2; ++n) { const f32x4 bv = *(const f32x4*)(dtb + 8 * fq + 4 * n);
#pragma unroll
                    for (int ai = 0; ai < 2; ++ai)
#pragma unroll
                        for (int m = 0; m < 4; ++m) { f32x4 v = acc[ai][0][m][n] + bv;
#pragma unroll
                            for (int e = 0; e < 4; ++e) v[e] = softplus_f(v[e]);
                            *(f32x4*)(DT + (size_t)(row0 + ai * HALF + m * 16) * 32 + 8 * fq + 4 * n) = v; } }
            }
            return;
        }
    }
};

struct EpiMamba {
    static constexpr bool PERM = true, AFTER_DRAIN = false, ROWPERM = true;
    static constexpr int NC = 4096;
    bf16_t* XBC; float* P; float* UH; const float* cw; const float* cb; PG8_LAS float* xch;
    __device__ __forceinline__ void operator()(const f32x4 (&acc)[2][2][4][2], const Unit& u, int wr, int wc, int fr, int fq) const {
        asm volatile("" : "+v"(fr), "+v"(fq));
        const int row0 = u.pm * BM + wr * 64 + 4 * fr;
        const int cpos0 = 32 * wc + 8 * fq;
        PG8_LAS float* wt = xch + 3072;
        { const int tid = (wr * 4 + wc) * 64 + fq * 16 + fr;
#pragma unroll
            for (int j = 0; j < 3; ++j) { const int i = tid + 512 * j; if (i < 5 * 256) { const int t = i >> 8, cp = i & 255; wt[i] = t < 4 ? cw[t * 4096 + u.pn * BM + cp] : cb[u.pn * BM + cp]; } } }
        if (fr == 15) {
#pragma unroll
            for (int ai = 0; ai < 2; ++ai)
#pragma unroll
                for (int bj = 0; bj < 2; ++bj)
#pragma unroll
                    for (int n = 0; n < 2; ++n)
#pragma unroll
                        for (int m = 1; m < 4; ++m) {
                            *(PG8_LAS f32x4*)(xch + ((2 * ai + wr) * 3 + (m - 1)) * 256 + 128 * bj + cpos0 + 4 * n) = acc[ai][bj][m][n];
                            if (ai == 1 && wr == 1) *(f32x4*)(UH + ((size_t)u.pm * 3 + (m - 1)) * NC + u.pn * BM + 128 * bj + cpos0 + 4 * n) = acc[1][bj][m][n]; }
        }
        asm volatile("s_waitcnt lgkmcnt(0)" ::: "memory"); __builtin_amdgcn_s_barrier(); asm volatile("" ::: "memory");
#pragma unroll
        for (int ai = 0; ai < 2; ++ai) {
            const int seg = 2 * ai + wr; const bool has_prev = seg > 0; const int sp = has_prev ? seg - 1 : 0;
#pragma unroll
            for (int bj = 0; bj < 2; ++bj) {
                const int ch0 = u.pn * BM + 128 * bj + cpos0;
#pragma unroll
                for (int n = 0; n < 2; ++n) {
                    unsigned pk[4][2];
#pragma unroll
                    for (int eh = 0; eh < 2; ++eh) {
                        const int cpos = 128 * bj + cpos0 + 4 * n + 2 * eh; const int ch = ch0 + 4 * n + 2 * eh;
                        f32x2 h1 = *(const PG8_LAS f32x2*)(xch + (sp * 3 + 2) * 256 + cpos), h2 = *(const PG8_LAS f32x2*)(xch + (sp * 3 + 1) * 256 + cpos), h3 = *(const PG8_LAS f32x2*)(xch + (sp * 3 + 0) * 256 + cpos);
                        if (!has_prev) { h1 = (f32x2){0.f, 0.f}; h2 = h1; h3 = h1; }
                        const f32x2 w0 = *(const PG8_LAS f32x2*)(wt + 0 * 256 + cpos), w1 = *(const PG8_LAS f32x2*)(wt + 1 * 256 + cpos), w2 = *(const PG8_LAS f32x2*)(wt + 2 * 256 + cpos),
                                    w3 = *(const PG8_LAS f32x2*)(wt + 3 * 256 + cpos), bb = *(const PG8_LAS f32x2*)(wt + 4 * 256 + cpos);
                        f32x2 o[4], v[4];
#pragma unroll
                        for (int m = 0; m < 4; ++m) v[m] = (f32x2){acc[ai][bj][m][n][2 * eh], acc[ai][bj][m][n][2 * eh + 1]};
                        const f32x2 s1 = (f32x2){dpp_shr_keep<1>(v[3].x, h1.x), dpp_shr_keep<1>(v[3].y, h1.y)}, s2 = (f32x2){dpp_shr_keep<1>(v[2].x, h2.x), dpp_shr_keep<1>(v[2].y, h2.y)},
                                    s3 = (f32x2){dpp_shr_keep<1>(v[1].x, h3.x), dpp_shr_keep<1>(v[1].y, h3.y)};
                        o[0] = bb + w3 * v[0] + w2 * s1 + w1 * s2 + w0 * s3;
                        o[1] = bb + w3 * v[1] + w2 * v[0] + w1 * s1 + w0 * s2;
                        o[2] = bb + w3 * v[2] + w2 * v[1] + w1 * v[0] + w0 * s1;
                        o[3] = bb + w3 * v[3] + w2 * v[2] + w1 * v[1] + w0 * v[0];
                        if (seg == 0 && fr == 0) {
#pragma unroll
                            for (int m = 0; m < 3; ++m) *(f32x2*)(P + ((size_t)u.pm * 3 + m) * NC + u.pn * BM + cpos) = o[m]; }
#pragma unroll
                        for (int m = 0; m < 4; ++m) { const f32x2 r = silu2(o[m]); pk[m][eh] = cvt_pk_bf16(r.x, r.y); }
                    }
#pragma unroll
                    for (int m = 0; m < 4; ++m) { u32x2 w; w.x = pk[m][0]; w.y = pk[m][1]; *(u32x2*)(XBC + (size_t)(row0 + ai * HALF + m) * 4096 + ch0 + 4 * n) = w; }
                }
            }
        }
    }
};

struct EpiFFN {
    static constexpr bool PERM = true, AFTER_DRAIN = false, ROWPERM = true;
    static constexpr int NC = 5632, F = 2816;
    bf16_t* G; float* P; float* UH; const float* cw; const float* cb; PG8_LAS float* xch;
    __device__ __forceinline__ void operator()(const f32x4 (&acc)[2][2][4][2], const Unit& u, int wr, int wc, int fr, int fq) const {
        asm volatile("" : "+v"(fr), "+v"(fq));
        const int row0 = u.pm * BM + wr * 64 + 4 * fr;
        const int cpos0 = 32 * wc + 8 * fq;
        PG8_LAS float* wt = xch + 3072;
        { const int tid = (wr * 4 + wc) * 64 + fq * 16 + fr;
#pragma unroll
            for (int j = 0; j < 2; ++j) { const int i = tid + 512 * j; const int t = i >> 8, cp = i & 255; const int chs = (cp >> 7) * F + u.pn * 128 + (cp & 127); wt[i] = t < 3 ? cw[t * NC + chs] : cb[chs]; } }
        if (fr == 15) {
#pragma unroll
            for (int ai = 0; ai < 2; ++ai)
#pragma unroll
                for (int bj = 0; bj < 2; ++bj)
#pragma unroll
                    for (int n = 0; n < 2; ++n)
#pragma unroll
                        for (int m = 2; m < 4; ++m) {
                            *(PG8_LAS f32x4*)(xch + ((2 * ai + wr) * 2 + (m - 2)) * 256 + 128 * bj + cpos0 + 4 * n) = acc[ai][bj][m][n];
                            if (ai == 1 && wr == 1) *(f32x4*)(UH + ((size_t)u.pm * 2 + (m - 2)) * NC + u.pn * BM + 128 * bj + cpos0 + 4 * n) = acc[1][bj][m][n]; }
        }
        asm volatile("s_waitcnt lgkmcnt(0)" ::: "memory"); __builtin_amdgcn_s_barrier(); asm volatile("" ::: "memory");
        const int j0 = u.pn * 128 + cpos0;
#pragma unroll
        for (int ai = 0; ai < 2; ++ai) {
            const int seg = 2 * ai + wr; const bool has_prev = seg > 0; const int sp = has_prev ? seg - 1 : 0;
#pragma unroll
            for (int n = 0; n < 2; ++n) {
                unsigned pk[4][2];
#pragma unroll
                for (int eh = 0; eh < 2; ++eh) {
                    f32x2 og[2][4];
#pragma unroll
                    for (int bj = 0; bj < 2; ++bj) {
                        const int cpos = 128 * bj + cpos0 + 4 * n + 2 * eh;
                        f32x2 h1 = *(const PG8_LAS f32x2*)(xch + (sp * 2 + 1) * 256 + cpos), h2 = *(const PG8_LAS f32x2*)(xch + (sp * 2 + 0) * 256 + cpos);
                        if (!has_prev) { h1 = (f32x2){0.f, 0.f}; h2 = h1; }
                        const f32x2 w0 = *(const PG8_LAS f32x2*)(wt + 0 * 256 + cpos), w1 = *(const PG8_LAS f32x2*)(wt + 1 * 256 + cpos), w2 = *(const PG8_LAS f32x2*)(wt + 2 * 256 + cpos), bb = *(const PG8_LAS f32x2*)(wt + 3 * 256 + cpos);
                        f32x2 v[4];
#pragma unroll
                        for (int m = 0; m < 4; ++m) v[m] = (f32x2){acc[ai][bj][m][n][2 * eh], acc[ai][bj][m][n][2 * eh + 1]};
                        const f32x2 s1 = (f32x2){dpp_shr_keep<1>(v[3].x, h1.x), dpp_shr_keep<1>(v[3].y, h1.y)}, s2 = (f32x2){dpp_shr_keep<1>(v[2].x, h2.x), dpp_shr_keep<1>(v[2].y, h2.y)};
                        og[bj][0] = bb + w2 * v[0] + w1 * s1 + w0 * s2;
                        og[bj][1] = bb + w2 * v[1] + w1 * v[0] + w0 * s1;
                        og[bj][2] = bb + w2 * v[2] + w1 * v[1] + w0 * v[0];
                        og[bj][3] = bb + w2 * v[3] + w1 * v[2] + w0 * v[1];
                        if (seg == 0 && fr == 0) {
#pragma unroll
                            for (int m = 0; m < 2; ++m) *(f32x2*)(P + ((size_t)u.pm * 2 + m) * NC + u.pn * BM + cpos) = og[bj][m]; }
                    }
#pragma unroll
                    for (int m = 0; m < 4; ++m) { const f32x2 r = silu2(og[0][m]) * og[1][m]; pk[m][eh] = cvt_pk_bf16(r.x, r.y); }
                }
#pragma unroll
                for (int m = 0; m < 4; ++m) { u32x2 w; w.x = pk[m][0]; w.y = pk[m][1]; *(u32x2*)(G + (size_t)(row0 + ai * HALF + m) * F + j0 + 4 * n) = w; }
            }
        }
    }
};
template <class Epi, class Sched, bool ALIGN_EPI = false, bool SP2 = false>
__device__ __forceinline__ void gemm_phase(PG8_LAS unsigned char* lds, const Gemm g, const Sched& S, const Epi& E) {
    int tid_ = threadIdx.x; asm volatile("" : "+v"(tid_));
    const int tid = tid_, wid = __builtin_amdgcn_readfirstlane(tid >> 6), lane = tid & 63, wr = wid >> 2, wc = wid & 3, fr = lane & 15, fq = lane >> 4;
    const int K = g.K, nt = K / BK;
    unsigned voffA[2], voffB[2];
#pragma unroll
    for (int i = 0; i < 2; ++i) { int R, C; stage_rc(tid * 16 + i * 8192, R, C); const int Rb = Epi::PERM ? ((R & ~31) + perm32(R & 31)) : R;
        const int Ra = Epi::ROWPERM ? ((R & ~63) + 4 * (R & 15) + ((R >> 4) & 3)) : R;
        voffA[i] = (unsigned)(Ra * K + C) * 2u; voffB[i] = (unsigned)(Rb * K + C) * 2u; }
    const size_t kstep = (size_t)(BK * 2);
    const size_t hstep = (size_t)HALF * K * 2;
    const size_t tstep = 2 * hstep;
    const unsigned ldsw = (unsigned)wid * 1024u;
    const int aoff = lds_byte(wr * 64 + fr, fq * 8), boff = lds_byte(wc * 32 + fr, fq * 8);
#define PG8_SA(b, h) (((b) * 2 + (h)) * HTB)
#define PG8_SB(b, h) ((4 + (b) * 2 + (h)) * HTB)
#define PG8_STAGE(bufoff, gbase, voff) do { _Pragma("unroll") for (int _i = 0; _i < 2; ++_i) \
        __builtin_amdgcn_global_load_lds((const unsigned*)((const char*)(gbase) + (voff)[_i]), (PG8_LAS unsigned*)(lds + (bufoff) + ldsw + _i * 8192), 16, 0, 0); } while (0)
#define PG8_LDA(dst, b, h) do { _Pragma("unroll") for (int m = 0; m < 4; ++m) _Pragma("unroll") for (int k = 0; k < 2; ++k) dst[m][k] = *(const PG8_LAS bf16x8*)(lds + PG8_SA(b, h) + aoff + m * 2048 + k * 1024); } while (0)
#define PG8_LDB(dst, b, h) do { _Pragma("unroll") for (int n = 0; n < 2; ++n) _Pragma("unroll") for (int k = 0; k < 2; ++k) dst[n][k] = *(const PG8_LAS bf16x8*)(lds + PG8_SB(b, h) + boff + n * 2048 + k * 1024); } while (0)
#define PG8_MMA(ai, bj, At, Bt) do { __builtin_amdgcn_s_setprio(1); _Pragma("unroll") for (int m = 0; m < 4; ++m) _Pragma("unroll") for (int n = 0; n < 2; ++n) _Pragma("unroll") for (int k = 0; k < 2; ++k) \
        acc[ai][bj][m][n] = __builtin_amdgcn_mfma_f32_16x16x32_bf16(Bt[n][k], At[m][k], acc[ai][bj][m][n], 0, 0, 0); __builtin_amdgcn_s_setprio(0); } while (0)
#define PG8_WAIT_V(n) asm volatile("s_waitcnt vmcnt(" #n ")" ::: "memory")
#define PG8_WAIT_L(n) asm volatile("s_waitcnt lgkmcnt(" #n ")" ::: "memory")
#define PG8_BAR __builtin_amdgcn_s_barrier()
#define PG8_SCHED __builtin_amdgcn_sched_barrier(0)
    Unit cur, nxt; int ui = 0;
    if (!S.next(0, cur)) return;
    f32x4 acc[2][2][4][2];
#pragma unroll
    for (int a = 0; a < 2; ++a)
#pragma unroll
        for (int b = 0; b < 2; ++b)
#pragma unroll
            for (int m = 0; m < 4; ++m)
#pragma unroll
                for (int n = 0; n < 2; ++n) acc[a][b][m][n] = (f32x4){0.f, 0.f, 0.f, 0.f};
    bf16x8 At[4][2], B0[2][2], B1[2][2];
    const char* cA = (const char*)g.A + (size_t)cur.pm * tstep; const char* cB = (const char*)g.Bt + (size_t)cur.pn * tstep;
    S.a_ready(cur);
    if constexpr (SP2) {
        PG8_STAGE(PG8_SB(0, 0), cB, voffB); PG8_STAGE(PG8_SB(0, 1), cB + hstep, voffB); PG8_STAGE(PG8_SA(0, 0), cA, voffA); PG8_STAGE(PG8_SA(0, 1), cA + hstep, voffA);
        if (wr == 1) PG8_BAR;
        PG8_WAIT_V(2); PG8_BAR;
        PG8_STAGE(PG8_SB(1, 0), cB + kstep, voffB); PG8_STAGE(PG8_SA(1, 0), cA + kstep, voffA); PG8_STAGE(PG8_SB(1, 1), cB + hstep + kstep, voffB);
        PG8_WAIT_V(6); PG8_BAR;
    } else {
        PG8_STAGE(PG8_SB(0, 0), cB, voffB); PG8_STAGE(PG8_SA(0, 0), cA, voffA); PG8_STAGE(PG8_SB(0, 1), cB + hstep, voffB); PG8_STAGE(PG8_SA(0, 1), cA + hstep, voffA);
        if (wr == 1) PG8_BAR;
        PG8_WAIT_V(4); PG8_BAR;
        PG8_STAGE(PG8_SB(1, 0), cB + kstep, voffB); PG8_STAGE(PG8_SA(1, 0), cA + kstep, voffA); PG8_STAGE(PG8_SB(1, 1), cB + hstep + kstep, voffB);
        PG8_WAIT_V(6); PG8_BAR;
    }
    for (;;) {
        const bool has_next = S.next(ui + 1, nxt);
        const char* nA = has_next ? (const char*)g.A + (size_t)nxt.pm * tstep : cA; const char* nB = has_next ? (const char*)g.Bt + (size_t)nxt.pn * tstep : cB;
        for (int t = 0; t < nt; t += 2) {
            const bool last = (t == nt - 2);
            const char* a1 = cA + (size_t)(t + 1) * kstep;
            const char* a2 = last ? nA : cA + (size_t)(t + 2) * kstep; const char* b2 = last ? nB : cB + (size_t)(t + 2) * kstep;
            const char* a3 = a2 + kstep; const char* b3 = b2 + kstep;
            if (last && has_next) S.a_ready(nxt);
            if constexpr (SP2) {
            PG8_LDB(B0, 0, 0); PG8_LDB(B1, 0, 1); PG8_SCHED; PG8_LDA(At, 0, 0); PG8_STAGE(PG8_SA(1, 1), a1 + hstep, voffA);
            PG8_WAIT_V(8); PG8_WAIT_L(0); PG8_BAR; PG8_MMA(0, 0, At, B0); PG8_MMA(0, 1, At, B1); PG8_BAR; PG8_SCHED;
            PG8_LDA(At, 0, 1); PG8_STAGE(PG8_SB(0, 0), b2, voffB); PG8_STAGE(PG8_SB(0, 1), b2 + hstep, voffB); PG8_STAGE(PG8_SA(0, 0), a2, voffA);
            PG8_WAIT_V(8); PG8_WAIT_L(0); PG8_BAR; PG8_MMA(1, 0, At, B0); PG8_MMA(1, 1, At, B1); PG8_BAR; PG8_SCHED;
            PG8_LDB(B0, 1, 0); PG8_LDB(B1, 1, 1); PG8_SCHED; PG8_LDA(At, 1, 0); PG8_STAGE(PG8_SA(0, 1), a2 + hstep, voffA);
            PG8_WAIT_V(8); PG8_WAIT_L(0); PG8_BAR; PG8_MMA(0, 0, At, B0); PG8_MMA(0, 1, At, B1); PG8_BAR; PG8_SCHED;
            PG8_LDA(At, 1, 1); PG8_STAGE(PG8_SB(1, 0), b3, voffB); PG8_STAGE(PG8_SB(1, 1), b3 + hstep, voffB); PG8_STAGE(PG8_SA(1, 0), a3, voffA);
            PG8_WAIT_V(8); PG8_WAIT_L(0); PG8_BAR; PG8_MMA(1, 0, At, B0); PG8_MMA(1, 1, At, B1); PG8_BAR; PG8_SCHED;
            } else {
            PG8_LDB(B0, 0, 0); PG8_SCHED; PG8_LDA(At, 0, 0); PG8_STAGE(PG8_SA(1, 1), a1 + hstep, voffA);
            PG8_WAIT_L(8); PG8_BAR; PG8_WAIT_L(0); PG8_MMA(0, 0, At, B0); PG8_BAR; PG8_SCHED;
            PG8_LDB(B1, 0, 1); PG8_STAGE(PG8_SB(0, 0), b2, voffB);
            PG8_BAR; PG8_WAIT_L(0); PG8_MMA(0, 1, At, B1); PG8_BAR;
            PG8_LDA(At, 0, 1); PG8_STAGE(PG8_SA(0, 0), a2, voffA);
            PG8_BAR; PG8_WAIT_L(0); PG8_MMA(1, 0, At, B0); PG8_BAR; PG8_SCHED;
            PG8_STAGE(PG8_SB(0, 1), b2 + hstep, voffB);
            PG8_WAIT_V(6); PG8_BAR; PG8_MMA(1, 1, At, B1); PG8_BAR;
            PG8_LDB(B0, 1, 0); PG8_SCHED; PG8_LDA(At, 1, 0); PG8_STAGE(PG8_SA(0, 1), a2 + hstep, voffA);
            PG8_WAIT_L(8); PG8_BAR; PG8_WAIT_L(0); PG8_MMA(0, 0, At, B0); PG8_BAR; PG8_SCHED;
            PG8_LDB(B1, 1, 1); PG8_STAGE(PG8_SB(1, 0), b3, voffB);
            PG8_BAR; PG8_WAIT_L(0); PG8_MMA(0, 1, At, B1); PG8_BAR;
            PG8_LDA(At, 1, 1); PG8_STAGE(PG8_SA(1, 0), a3, voffA);
            PG8_BAR; PG8_WAIT_L(0); PG8_MMA(1, 0, At, B0); PG8_BAR; PG8_SCHED;
            PG8_STAGE(PG8_SB(1, 1), b3 + hstep, voffB);
            PG8_WAIT_V(6); PG8_BAR; PG8_MMA(1, 1, At, B1); PG8_BAR;
            }
        }
        if constexpr (ALIGN_EPI) { if (wr == 0) PG8_BAR; }
        if constexpr (!Epi::AFTER_DRAIN) { E(acc, cur, wr, wc, fr, fq); S.done(cur); }
        if (!has_next) break;
#pragma unroll
        for (int a = 0; a < 2; ++a)
#pragma unroll
            for (int b = 0; b < 2; ++b)
#pragma unroll
                for (int m = 0; m < 4; ++m)
#pragma unroll
                    for (int n = 0; n < 2; ++n) acc[a][b][m][n] = (f32x4){0.f, 0.f, 0.f, 0.f};
        cur = nxt; cA = nA; cB = nB; ++ui;
        if constexpr (ALIGN_EPI) { if (wr == 1) PG8_BAR; }
    }
    PG8_WAIT_V(0);
    if constexpr (!ALIGN_EPI) { if (wr == 0) PG8_BAR; }
    PG8_BAR;
    if constexpr (Epi::AFTER_DRAIN) { E.fused(acc, cur, wr, wc, fr, fq, lds, wid, lane); S.done(cur); }
#undef PG8_SA
#undef PG8_SB
#undef PG8_STAGE
#undef PG8_LDA
#undef PG8_LDB
#undef PG8_MMA
#undef PG8_WAIT_V
#undef PG8_WAIT_L
#undef PG8_BAR
#undef PG8_SCHED
}
}

#define LAS __attribute__((address_space(3)))
typedef unsigned short bf16;
typedef short bf16x8 __attribute__((ext_vector_type(8)));
typedef short s16x4 __attribute__((ext_vector_type(4)));
typedef float f32x4 __attribute__((ext_vector_type(4)));
typedef unsigned u32x4 __attribute__((ext_vector_type(4)));
typedef unsigned u32x2 __attribute__((ext_vector_type(2)));
#define MFMA16(a, b, c) __builtin_amdgcn_mfma_f32_16x16x32_bf16((a), (b), (c), 0, 0, 0)

constexpr int T = 32768, D = 1024, SEQ = 8192, NTHR = 512;
constexpr int LDS_BYTES = 163840, XCH_OFF = 131072;
constexpr size_t MiB = 1u << 20;
constexpr size_t WS_W = 0;
constexpr size_t W_IN = 0, W_SOUT = W_IN + (size_t)6400 * 1024, W_FIN0 = W_SOUT + (size_t)1024 * 2048, W_FIN1 = W_FIN0 + (size_t)5632 * 1024,
                 W_FOUT0 = W_FIN1 + (size_t)5632 * 1024, W_FOUT1 = W_FOUT0 + (size_t)1024 * 2816, W_K = W_FOUT1 + (size_t)1024 * 2816, W_V = W_K + 1048576, W_Q = W_V + 1048576,
                 W_O = W_Q + 1048576, W_END = W_O + 1048576;
static_assert(W_END * 2 <= 58 * MiB, "weights fit");
constexpr size_t WS_MODS = 58 * MiB;
constexpr size_t WS_SUMSQ = 59 * MiB;
constexpr size_t WS_FLAGS = 60 * MiB;
constexpr size_t WS_BAR = 61 * MiB;
constexpr size_t WS_X = 64 * MiB;
constexpr size_t WS_BIG = 192 * MiB;
constexpr size_t WS_END = 448 * MiB;
constexpr int MOD_L = 6144, MOD_KV = 12288, MOD_FIN = 14336, MOD_N = 16384;

#ifdef PROBE
#define STAMP(k) do { if (blockIdx.x == 0 && threadIdx.x == 0) { __threadfence(); TS[k] = __builtin_amdgcn_s_memrealtime(); __threadfence(); } } while (0)
#else
#define STAMP(k) do {} while (0)
#endif
struct Params { const float* in[28]; float* out; unsigned char* ws; };

__device__ __forceinline__ float bf2f(unsigned u) { return __uint_as_float(u << 16); }
typedef float f32x2_t __attribute__((ext_vector_type(2))); typedef __bf16 bf16x2_t __attribute__((ext_vector_type(2)));
__device__ __forceinline__ unsigned pk2(float lo, float hi) { f32x2_t v = {lo, hi}; bf16x2_t b = __builtin_convertvector(v, bf16x2_t); return __builtin_bit_cast(unsigned, b); }
__device__ __forceinline__ unsigned f2bf(float f) { return pk2(f, 0.f) & 0xffffu; }
__device__ __forceinline__ float wave_sum(float v) {
#pragma unroll
    for (int o = 1; o < 64; o <<= 1) v += __shfl_xor(v, o);
    return v;
}
using pg8::silu_f; using pg8::softplus_f;

__device__ __forceinline__ void p0_item(const float* W, int K, int Nsrc, bf16* WT, int dst_n0, int src_n0, int k0, LAS float* scr, int lane) {
    const int c = lane & 7;
    if (src_n0 < 0) {
#pragma unroll
        for (int j = 0; j < 4; ++j) { const int n = (lane >> 3) + 8 * j; *(u32x4*)(WT + (size_t)(dst_n0 + n) * K + k0 + 8 * c) = (u32x4){0u, 0u, 0u, 0u}; }
        return;
    }
#pragma unroll 8
    for (int i = 0; i < 32; ++i) { const int kk = 2 * i + (lane >> 5); scr[kk * 33 + (lane & 31)] = __builtin_nontemporal_load(W + (size_t)(k0 + kk) * Nsrc + src_n0 + (lane & 31)); }
    asm volatile("s_waitcnt lgkmcnt(0)" ::: "memory");
#pragma unroll
    for (int j = 0; j < 4; ++j) { const int n = (lane >> 3) + 8 * j; const LAS float* s = scr + (8 * c) * 33 + n;
        u32x4 o; o.x = pk2(s[0 * 33], s[1 * 33]); o.y = pk2(s[2 * 33], s[3 * 33]); o.z = pk2(s[4 * 33], s[5 * 33]); o.w = pk2(s[6 * 33], s[7 * 33]);
        *(u32x4*)(WT + (size_t)(dst_n0 + n) * K + k0 + 8 * c) = o; }
    asm volatile("s_waitcnt lgkmcnt(0)" ::: "memory");
}
__device__ __forceinline__ void p0_phase(const Params& p, LAS unsigned char* L) {
    const int tid = threadIdx.x, lane = tid & 63, wave = __builtin_amdgcn_readfirstlane(tid >> 6);
    bf16* WB = (bf16*)(p.ws + WS_W);
    float* MODS = (float*)(p.ws + WS_MODS); float* SUMSQ = (float*)(p.ws + WS_SUMSQ);
    if (blockIdx.x == 0 && tid < 64) ((unsigned*)(p.ws + WS_FLAGS))[tid] = 0u;
    LAS float* cs = (LAS float*)L; LAS float* part = (LAS float*)(L + 16384);
    for (int i = tid; i < 4096; i += NTHR) cs[i] = silu_f(p.in[1][i]);
    __syncthreads();
    for (int jb = blockIdx.x; jb < MOD_N / 64; jb += gridDim.x) {
        const int j = jb * 64 + lane; const float* Wsrc; const float* bsrc; int stride, jj;
        if (j < MOD_KV) { const int l = j / MOD_L; jj = j - l * MOD_L; Wsrc = p.in[2] + (size_t)l * D * MOD_L; bsrc = p.in[3] + l * MOD_L; stride = MOD_L; }
        else if (j < MOD_FIN) { jj = j - MOD_KV; Wsrc = p.in[14]; bsrc = p.in[15]; stride = 2048; }
        else { jj = j - MOD_FIN; Wsrc = p.in[25]; bsrc = p.in[26]; stride = 2048; }
        float a0 = 0.f, a1 = 0.f, a2 = 0.f, a3 = 0.f;
#pragma unroll 8
        for (int k = wave * 128; k < wave * 128 + 128; ++k) { const float wv = __builtin_nontemporal_load(Wsrc + (size_t)k * stride + jj); a0 += cs[k] * wv; a1 += cs[1024 + k] * wv; a2 += cs[2048 + k] * wv; a3 += cs[3072 + k] * wv; }
        part[(wave * 4 + 0) * 64 + lane] = a0; part[(wave * 4 + 1) * 64 + lane] = a1; part[(wave * 4 + 2) * 64 + lane] = a2; part[(wave * 4 + 3) * 64 + lane] = a3;
        __syncthreads();
        if (tid < 256) { const int b = tid >> 6; float s = 0.f;
#pragma unroll
            for (int w = 0; w < 8; ++w) s += part[(w * 4 + b) * 64 + lane];
            MODS[(size_t)b * MOD_N + j] = s + bsrc[jj]; }
        __syncthreads();
    }
    LAS float* scr = (LAS float*)(L + wave * 16384);
    const int gw = blockIdx.x * 8 + wave, NGW = gridDim.x * 8;
    constexpr int NI0 = 16 * 200, NI1 = 32 * 32, NI2 = 16 * 176, NI3 = 44 * 32, NI4 = 16 * 32;
    constexpr int NITEMS = NI0 + NI1 + 2 * NI2 + 2 * NI3 + 4 * NI4;
    for (int it = gw; it < NITEMS; it += NGW) {
        int r = it;
        if (r < NI0) { const int kb = r / 200, nb = r % 200; const int dn = nb * 32; const int sn = dn < 2048 ? dn : dn < 2080 ? 6144 + (dn - 2048) : dn < 2304 ? -1 : 2048 + (dn - 2304); p0_item(p.in[6], 1024, 6176, WB + W_IN, dn, sn, kb * 64, scr, lane); continue; } r -= NI0;
        if (r < NI1) { const int kb = r / 32, nb = r % 32; p0_item(p.in[13], 2048, 1024, WB + W_SOUT, nb * 32, nb * 32, kb * 64, scr, lane); continue; } r -= NI1;
        if (r < 2 * NI2) { const int l = r / NI2; r -= l * NI2; const int kb = r / 176, nb = r % 176; const int dn = nb * 32; const int sn = (dn >> 8) * 128 + (dn & 127) + ((dn & 255) >= 128 ? 2816 : 0);
            p0_item(p.in[21] + (size_t)l * 1024 * 5632, 1024, 5632, WB + (l ? W_FIN1 : W_FIN0), dn, sn, kb * 64, scr, lane); continue; } r -= 2 * NI2;
        if (r < 2 * NI3) { const int l = r / NI3; r -= l * NI3; const int kb = r / 32, nb = r % 32;
            p0_item(p.in[24] + (size_t)l * 2816 * 1024, 2816, 1024, WB + (l ? W_FOUT1 : W_FOUT0), nb * 32, nb * 32, kb * 64, scr, lane); continue; } r -= 2 * NI3;
        { const int q = r / NI4; r -= q * NI4; const int kb = r / 32, nb = r % 32; const float* src = q == 0 ? p.in[17] : q == 1 ? p.in[18] : q == 2 ? p.in[19] : p.in[20];
            bf16* dst = WB + (q == 0 ? W_K : q == 1 ? W_V : q == 2 ? W_Q : W_O);
            p0_item(src, 1024, 1024, dst, nb * 32, nb * 32, kb * 64, scr, lane); }
    }
}

template <int NOUT, bool F32OUT>
__device__ __forceinline__ void norm_phase(const float* X, const float* g0, const float* mod0, void* out0, const float* g1, const float* mod1, void* out1) {
    int tid_ = threadIdx.x; asm volatile("" : "+v"(tid_));
    const int tid = tid_, lane = tid & 63, wave = tid >> 6;
    const int gw = blockIdx.x * 8 + wave, NGW = gridDim.x * 8;
    for (int row = gw; row < T; row += NGW) {
        const int b = row >> 13;
        const f32x4* xr = (const f32x4*)(X + (size_t)row * D) + lane;
        f32x4 v[4]; float s = 0.f;
#pragma unroll
        for (int j = 0; j < 4; ++j) { v[j] = __builtin_nontemporal_load(xr + 64 * j); s += (v[j].x * v[j].x + v[j].y * v[j].y) + (v[j].z * v[j].z + v[j].w * v[j].w); }
        const float rstd = rsqrtf(wave_sum(s) * (1.f / D) + 1e-6f);
#pragma unroll
        for (int o = 0; o < NOUT; ++o) {
            const float* g = o ? g1 : g0; const float* md = (o ? mod1 : mod0) + (size_t)b * MOD_N; void* out = o ? out1 : out0;
#pragma unroll
            for (int j = 0; j < 4; ++j) { const int col = 4 * lane + 256 * j;
                const f32x4 gv = *(const f32x4*)(g + col), sh = *(const f32x4*)(md + col), sc = *(const f32x4*)(md + 1024 + col);
                const f32x4 y = v[j] * rstd * gv * (sc + 1.0f) + sh;
                if (F32OUT) *(f32x4*)((float*)out + (size_t)row * D + col) = y;
                else { u32x2 w; w.x = pk2(y.x, y.y); w.y = pk2(y.z, y.w); *(u32x2*)((bf16*)out + (size_t)row * D + col) = w; } }
        }
    }
}

template <int NOUT, bool F32OUT>
__device__ __forceinline__ void norm_phase_b(const bf16* X, const float* g0, const float* mod0, void* out0, const float* g1, const float* mod1, void* out1) {
    int tid_ = threadIdx.x; asm volatile("" : "+v"(tid_));
    const int tid = tid_, lane = tid & 63, wave = tid >> 6;
    const int gw = blockIdx.x * 8 + wave, NGW = gridDim.x * 8;
    for (int row = gw; row < T; row += NGW) {
        const int b = row >> 13;
        float v[2][8]; float s = 0.f;
#pragma unroll
        for (int j = 0; j < 2; ++j) { const u32x4 xb = *(const u32x4*)(X + (size_t)row * D + 8 * lane + 512 * j);
#pragma unroll
            for (int e = 0; e < 4; ++e) { v[j][2 * e] = __uint_as_float(xb[e] << 16); v[j][2 * e + 1] = __uint_as_float(xb[e] & 0xffff0000u); }
#pragma unroll
            for (int e = 0; e < 8; ++e) s += v[j][e] * v[j][e]; }
        const float rstd = rsqrtf(wave_sum(s) * (1.f / D) + 1e-6f);
#pragma unroll
        for (int o = 0; o < NOUT; ++o) {
            const float* g = o ? g1 : g0; const float* md = (o ? mod1 : mod0) + (size_t)b * MOD_N; void* out = o ? out1 : out0;
#pragma unroll
            for (int j = 0; j < 2; ++j) { const int col = 8 * lane + 512 * j; float y[8];
#pragma unroll
                for (int q = 0; q < 2; ++q) { const f32x4 gv = *(const f32x4*)(g + col + 4 * q), sh = *(const f32x4*)(md + col + 4 * q), sc = *(const f32x4*)(md + 1024 + col + 4 * q);
#pragma unroll
                    for (int e = 0; e < 4; ++e) y[4 * q + e] = v[j][4 * q + e] * rstd * gv[e] * (sc[e] + 1.0f) + sh[e]; }
                if (F32OUT) { *(f32x4*)((float*)out + (size_t)row * D + col) = (f32x4){y[0], y[1], y[2], y[3]}; *(f32x4*)((float*)out + (size_t)row * D + col + 4) = (f32x4){y[4], y[5], y[6], y[7]}; }
                else { u32x4 w; w.x = pk2(y[0], y[1]); w.y = pk2(y[2], y[3]); w.z = pk2(y[4], y[5]); w.w = pk2(y[6], y[7]); *(u32x4*)((bf16*)out + (size_t)row * D + col) = w; } }
        }
    }
}

__device__ __forceinline__ void fixup_mamba(const float* P, const float* UH, const float* cw, const float* cb, bf16* XBC) {
    const int total = 128 * 3 * 4096;
    for (int i = blockIdx.x * NTHR + threadIdx.x; i < total; i += gridDim.x * NTHR) {
        const int ch = i & 4095, r = (i >> 12) % 3, pm = i / (3 * 4096); const int c = ch;
        float v = P[((size_t)pm * 3 + r) * 4096 + c];
        if (pm & 31) { for (int k = r + 1; k <= 3; ++k) v += cw[(3 - k) * 4096 + ch] * UH[((size_t)(pm - 1) * 3 + (3 + r - k)) * 4096 + c]; }
        XBC[(size_t)(pm * 256 + r) * 4096 + ch] = (bf16)f2bf(silu_f(v));
    }
}
__device__ __forceinline__ void fixup_ffn(const float* P, const float* UH, const float* cw, const float* cb, bf16* G) {
    const int total = 128 * 2 * 2816;
    for (int i = blockIdx.x * NTHR + threadIdx.x; i < total; i += gridDim.x * NTHR) {
        const int j = i % 2816, r = (i / 2816) & 1, pm = i / (2 * 2816); const int cg_ = (j >> 7) * 256 + (j & 127), cv_ = cg_ + 128;
        float g = P[((size_t)pm * 2 + r) * 5632 + cg_], v = P[((size_t)pm * 2 + r) * 5632 + cv_];
        if (pm & 31) { for (int k = r + 1; k <= 2; ++k) { const size_t ro = ((size_t)(pm - 1) * 2 + (2 + r - k)) * 5632;
            g += cw[(2 - k) * 5632 + j] * UH[ro + cg_]; v += cw[(2 - k) * 5632 + 2816 + j] * UH[ro + cv_]; } }
        G[(size_t)(pm * 256 + r) * 2816 + j] = (bf16)f2bf(silu_f(g) * v);
    }
}

constexpr int SSD_CS = 0, SSD_BS = 34816, SSD_XT = 69632, SSD_XDT = 78336, SSD_HS0 = 87040, SSD_HS1 = 95744, SSD_ACS = 104448, SSD_WSCR = 104960;
__device__ __forceinline__ void acs_phase(const float* DT, const float* a_log, float* ACS) {
    const int lane = threadIdx.x & 63, wave = threadIdx.x >> 6;
    const int h = lane & 31, sub = lane >> 5; const float A = -__expf(a_log[h]);
    for (int task = blockIdx.x * 8 + wave; task < 256; task += gridDim.x * 8) {
        const size_t tok0 = (size_t)task * 128 + sub * 64;
        float s = 0.f;
#pragma unroll 8
        for (int i = 0; i < 64; ++i) s += DT[(tok0 + i) * 32 + h] * A;
        const float s0 = __shfl(s, h);
        float run = sub ? s0 : 0.f;
#pragma unroll 8
        for (int i = 0; i < 64; ++i) { run += DT[(tok0 + i) * 32 + h] * A; ACS[(tok0 + i) * 32 + h] = run; }
    }
}
template <int LT> __device__ __forceinline__ void ssd_diag(const LAS bf16* Bs, const LAS bf16* XTs, const LAS float* acs_s, const bf16x8 (&cf)[4], float acs_l, int r16, int quad, f32x4 (&Yd)[2]) {
#pragma unroll
    for (int t = 0; t <= (LT >> 1); ++t) {
        f32x4 mm[2];
#pragma unroll
        for (int hf = 0; hf < 2; ++hf) { const int st = 2 * t + hf; mm[hf] = (f32x4){0.f, 0.f, 0.f, 0.f};
            if (st <= LT) { f32x4 acc = (f32x4){0.f, 0.f, 0.f, 0.f};
#pragma unroll
                for (int ks = 0; ks < 4; ++ks) { const bf16x8 af = *(const LAS bf16x8*)(Bs + (16 * st + r16) * 136 + ks * 32 + quad * 8); acc = MFMA16(af, cf[ks], acc); }
                const f32x4 as4 = *(const LAS f32x4*)(acs_s + 16 * st + 4 * quad);
#pragma unroll
                for (int j = 0; j < 4; ++j) { const float v = acc[j] * __expf(acs_l - as4[j]); mm[hf][j] = (st == LT && (4 * quad + j > r16)) ? 0.f : v; } } }
        u32x4 mp; mp.x = pk2(mm[0][0], mm[0][1]); mp.y = pk2(mm[0][2], mm[0][3]); mp.z = pk2(mm[1][0], mm[1][1]); mp.w = pk2(mm[1][2], mm[1][3]);
        const bf16x8 mf = __builtin_bit_cast(bf16x8, mp);
#pragma unroll
        for (int pt = 0; pt < 2; ++pt) { const LAS bf16* xp = XTs + (16 * pt + r16) * 136 + 32 * t + 4 * quad;
            const u32x2 lo = *(const LAS u32x2*)xp, hi = *(const LAS u32x2*)(xp + 16);
            const bf16x8 xf = __builtin_bit_cast(bf16x8, ((u32x4){lo.x, lo.y, hi.x, hi.y}));
            Yd[pt] = MFMA16(mf, xf, Yd[pt]); }
    }
}
__device__ __forceinline__ void ssreduce_phase(const float* PS, float* RS) {
    for (int t = blockIdx.x * NTHR + threadIdx.x; t < T; t += gridDim.x * NTHR) { float s = 0.f;
#pragma unroll 16
        for (int q = 0; q < 64; ++q) s += PS[(size_t)q * T + t];
        RS[t] = rsqrtf(s * (1.0f / 2048.0f) + 1e-6f); }
}
template <bool REAL, int MODE = 15> __device__ __forceinline__ void ssd_phase(const bf16* XBC, bf16* Zb, const float* DT, const float* ACS, const float* a_log, const float* d_skip, const float* normg, float* SUMSQ, LAS unsigned char* L) {
    int tid_ = threadIdx.x; asm volatile("" : "+v"(tid_));
    const int tid = tid_, lane = tid & 63, w = __builtin_amdgcn_readfirstlane(tid >> 6), r16 = lane & 15, quad = lane >> 4;
    LAS bf16* Cs = (LAS bf16*)(L + SSD_CS); LAS bf16* Bs = (LAS bf16*)(L + SSD_BS); LAS bf16* XTs = (LAS bf16*)(L + SSD_XT); LAS bf16* XDs = (LAS bf16*)(L + SSD_XDT);
    LAS float* acs_s = (LAS float*)(L + SSD_ACS);
    LAS bf16* Wx = (LAS bf16*)(L + SSD_WSCR + w * 3840); LAS bf16* Wz = Wx + 640; LAS bf16* Wy = Wx + 1280;
    const int lt = w < 4 ? w : 11 - w;
    const int vcu = (gridDim.x == 256) ? (int)((blockIdx.x & 7) * 32 + (blockIdx.x >> 3)) : (int)blockIdx.x;
    for (int unit = vcu; unit < 256; unit += gridDim.x) {
        const int b = unit >> 6, h = (unit >> 1) & 31, ph = unit & 1, g = h >> 2;
        const float Dh = d_skip[h];
        const int xcol = h * 64 + ph * 32;
        const float ng0 = normg[xcol + r16], ng1 = normg[xcol + 16 + r16];
        for (int i = tid; i < 8704 / 4; i += NTHR) ((LAS unsigned*)(L + SSD_HS0))[i] = 0u;
        f32x4 Hst[2][2]; Hst[0][0] = Hst[0][1] = Hst[1][0] = Hst[1][1] = (f32x4){0.f, 0.f, 0.f, 0.f};
        int hb = 0;
        const int srow = tid >> 4, sg = tid & 15, lr = lane >> 2, part = lane & 3, lx = 16 * lt + lr;
        u32x4 cv[4], bv[4], xv, zv; float dtl, acl, aclast, a01;
#define SSD_LOAD(c_) do { const size_t tk = (size_t)b * SEQ + (size_t)(c_) * 128; \
            _Pragma("unroll") for (int i = 0; i < 4; ++i) { const bf16* src = XBC + (tk + srow + 32 * i) * 4096 + g * 128 + sg * 8; cv[i] = *(const u32x4*)(src + 3072); bv[i] = *(const u32x4*)(src + 2048); } \
            xv = *(const u32x4*)(XBC + (tk + lx) * 4096 + xcol + part * 8); zv = *(const u32x4*)(Zb + (tk + lx) * 2048 + xcol + part * 8); \
            dtl = DT[(tk + lx) * 32 + h]; acl = ACS[(tk + lx) * 32 + h]; aclast = ACS[(tk + 127) * 32 + h]; a01 = ACS[(tk + 2 * w * 0 + (tid & 127)) * 32 + h]; } while (0)
        SSD_LOAD(0);
        for (int c = 0; c < 64; ++c) {
            const size_t tok0 = (size_t)b * SEQ + (size_t)c * 128;
#pragma unroll
            for (int i = 0; i < 4; ++i) { const int l = srow + 32 * i; *(LAS u32x4*)(Cs + l * 136 + sg * 8) = cv[i]; *(LAS u32x4*)(Bs + l * 136 + sg * 8) = bv[i]; }
            if (tid < 128) acs_s[tid] = a01;
            const float acs_last = aclast;
            { const float dec = __expf(acs_last - acl);
                *(LAS u32x4*)(Wx + lr * 40 + part * 8) = xv; *(LAS u32x4*)(Wz + lr * 40 + part * 8) = zv;
#pragma unroll
                for (int e = 0; e < 8; ++e) { const unsigned xb = (xv[e >> 1] >> (16 * (e & 1))) & 0xffffu; const float xd = bf2f(xb) * dtl;
                    XTs[(part * 8 + e) * 136 + lx] = (bf16)f2bf(xd); XDs[(part * 8 + e) * 136 + lx] = (bf16)f2bf(xd * dec); } }
            __syncthreads();
            if (c < 63) SSD_LOAD(c + 1);
            __builtin_amdgcn_sched_barrier(0);
            bf16x8 cf[4];
#pragma unroll
            for (int ks = 0; ks < 4; ++ks) cf[ks] = *(const LAS bf16x8*)(Cs + (16 * lt + r16) * 136 + ks * 32 + quad * 8);
            const float acs_l = acs_s[16 * lt + r16];
            f32x4 Yd[2], Yo[2]; Yd[0] = Yd[1] = Yo[0] = Yo[1] = (f32x4){0.f, 0.f, 0.f, 0.f};
            if constexpr ((MODE & 1) != 0)
            switch (lt) {
                case 0: ssd_diag<0>(Bs, XTs, acs_s, cf, acs_l, r16, quad, Yd); break; case 1: ssd_diag<1>(Bs, XTs, acs_s, cf, acs_l, r16, quad, Yd); break;
                case 2: ssd_diag<2>(Bs, XTs, acs_s, cf, acs_l, r16, quad, Yd); break; case 3: ssd_diag<3>(Bs, XTs, acs_s, cf, acs_l, r16, quad, Yd); break;
                case 4: ssd_diag<4>(Bs, XTs, acs_s, cf, acs_l, r16, quad, Yd); break; case 5: ssd_diag<5>(Bs, XTs, acs_s, cf, acs_l, r16, quad, Yd); break;
                case 6: ssd_diag<6>(Bs, XTs, acs_s, cf, acs_l, r16, quad, Yd); break; default: ssd_diag<7>(Bs, XTs, acs_s, cf, acs_l, r16, quad, Yd); break; }
            if constexpr ((MODE & 2) != 0)
            { const LAS bf16* Hc = (const LAS bf16*)(L + (hb ? SSD_HS1 : SSD_HS0));
#pragma unroll
                for (int pt = 0; pt < 2; ++pt)
#pragma unroll
                    for (int ks = 0; ks < 4; ++ks) { const bf16x8 hf = *(const LAS bf16x8*)(Hc + (16 * pt + r16) * 136 + ks * 32 + quad * 8); Yo[pt] = MFMA16(cf[ks], hf, Yo[pt]); } }
            if constexpr ((MODE & 4) != 0) {
            float ssq[4] = {0.f, 0.f, 0.f, 0.f};
            { const f32x4 al4 = *(const LAS f32x4*)(acs_s + 16 * lt + 4 * quad);
#pragma unroll
            for (int j = 0; j < 4; ++j) { const int lrow = 4 * quad + j; const float el = __expf(al4[j]);
#pragma unroll
                for (int pt = 0; pt < 2; ++pt) { const int pcol = 16 * pt + r16;
                    float y = Yd[pt][j] + el * Yo[pt][j];
                    y += Dh * bf2f(Wx[lrow * 40 + pcol]);
                    const float gz = y * silu_f(bf2f(Wz[lrow * 40 + pcol])); ssq[j] += gz * gz;
                    Wy[lrow * 40 + pcol] = (bf16)f2bf(gz * (pt ? ng1 : ng0)); } } }
#pragma unroll
            for (int j = 0; j < 4; ++j) { float v = ssq[j]; v += __shfl_xor(v, 1); v += __shfl_xor(v, 2); v += __shfl_xor(v, 4); v += __shfl_xor(v, 8); ssq[j] = v; }
            { const float sv = r16 == 0 ? ssq[0] : r16 == 1 ? ssq[1] : r16 == 2 ? ssq[2] : ssq[3];
                if (r16 < 4) SUMSQ[(size_t)(h * 2 + ph) * T + tok0 + 16 * lt + 4 * quad + r16] = sv; }
            asm volatile("s_waitcnt lgkmcnt(0)" ::: "memory");
            { const u32x4 yv = *(const LAS u32x4*)(Wy + lr * 40 + part * 8);
                if (REAL) *(u32x4*)(Zb + (tok0 + 16 * lt + lr) * 2048 + xcol + part * 8) = yv; }
            } else { if (Yd[0][0] + Yd[1][0] + Yo[0][0] + Yo[1][0] == 12345.f) Wy[0] = 1; }
            if (((MODE & 8) != 0) && w < 4) {
                f32x4 a4[2][2];
#pragma unroll
                for (int q = 0; q < 2; ++q) a4[q][0] = a4[q][1] = (f32x4){0.f, 0.f, 0.f, 0.f};
#pragma unroll
                for (int ks = 0; ks < 4; ++ks) { bf16x8 af[2];
#pragma unroll
                    for (int pt = 0; pt < 2; ++pt) af[pt] = *(const LAS bf16x8*)(XDs + (16 * pt + r16) * 136 + ks * 32 + quad * 8);
#pragma unroll
                    for (int q = 0; q < 2; ++q) { bf16x8 bfr;
#pragma unroll
                        for (int j = 0; j < 8; ++j) bfr[j] = (short)Bs[(ks * 32 + quad * 8 + j) * 136 + 16 * (2 * w + q) + r16];
#pragma unroll
                        for (int pt = 0; pt < 2; ++pt) a4[q][pt] = MFMA16(af[pt], bfr, a4[q][pt]); } }
                const float cd = __expf(acs_last);
                LAS bf16* Hn = (LAS bf16*)(L + (hb ? SSD_HS0 : SSD_HS1));
#pragma unroll
                for (int q = 0; q < 2; ++q)
#pragma unroll
                    for (int pt = 0; pt < 2; ++pt)
#pragma unroll
                        for (int j = 0; j < 4; ++j) { const float hv = Hst[q][pt][j] * cd + a4[q][pt][j]; Hst[q][pt][j] = hv; Hn[(16 * pt + 4 * quad + j) * 136 + 16 * (2 * w + q) + r16] = (bf16)f2bf(hv); }
            }
            hb ^= 1;
            __syncthreads();
        }
#undef SSD_LOAD
    }
}

constexpr int AT_KS = 0, AT_VS = 18432, AT_SMAX = 35840;
template <bool DIAG, int NKT> __device__ __forceinline__ float att_elem(f32x4 (&S)[8], float suffix, int q_rel, int quad) {
    f32x4 Lg[8];
#pragma unroll
    for (int kt = 0; kt < NKT; ++kt) { const f32x4 y = S[kt]; f32x4 sp;
#pragma unroll
        for (int j = 0; j < 4; ++j) sp[j] = __builtin_amdgcn_logf(1.0f + __builtin_amdgcn_exp2f(-__builtin_fabsf(y[j])));
        f32x4 lg = -(sp + __builtin_elementwise_max(y, (f32x4){0.f, 0.f, 0.f, 0.f}));
        if (DIAG) {
#pragma unroll
            for (int j = 0; j < 4; ++j) if (!(16 * kt + 4 * quad + j < q_rel)) lg[j] = 0.f; }
        lg[2] += lg[3]; lg[1] += lg[2]; lg[0] += lg[1]; Lg[kt] = lg; }
    float tail = 0.f;
#pragma unroll
    for (int kt = NKT - 1; kt >= 0; --kt) { const float a = Lg[kt][0]; const float bq = __shfl_xor(a, 16), cq = __shfl_xor(a, 32), dq = __shfl_xor(bq, 32);
        const float E = quad == 0 ? (bq + cq + dq) : quad == 1 ? (cq + dq) : quad == 2 ? bq : 0.f;
        Lg[kt] = Lg[kt] + (E + tail);
        tail += (a + bq) + (cq + dq); }
#pragma unroll
    for (int kt = 0; kt < NKT; ++kt) { const f32x4 lw = (S[kt] + Lg[kt]) + suffix;
#pragma unroll
        for (int j = 0; j < 4; ++j) { float wv = __builtin_amdgcn_exp2f(lw[j]); if (DIAG && !(16 * kt + 4 * quad + j < q_rel)) wv = 0.f; S[kt][j] = wv; } }
    return tail;
}
template <bool DIAG, int NKT> __device__ __forceinline__ float att_block(const LAS bf16* Ks, const LAS bf16* Vs, const bf16x8 (&qf)[2], f32x4 (&O)[4], float suffix, int q_rel, int r16, int quad) {
    f32x4 S[8];
#pragma unroll
    for (int kt = 0; kt < 8; ++kt) S[kt] = (f32x4){0.f, 0.f, 0.f, 0.f};
#pragma unroll
    for (int kt = 0; kt < NKT; ++kt)
#pragma unroll
        for (int ks = 0; ks < 2; ++ks) { const bf16x8 kf = *(const LAS bf16x8*)(Ks + (16 * kt + r16) * 72 + ks * 32 + quad * 8); S[kt] = MFMA16(kf, qf[ks], S[kt]); }
    const float tail = att_elem<DIAG, NKT>(S, suffix, q_rel, quad);
#pragma unroll
    for (int t = 0; t < (NKT + 1) / 2; ++t) { u32x4 wp; wp.x = pk2(S[2 * t][0], S[2 * t][1]); wp.y = pk2(S[2 * t][2], S[2 * t][3]); wp.z = pk2(S[2 * t + 1][0], S[2 * t + 1][1]); wp.w = pk2(S[2 * t + 1][2], S[2 * t + 1][3]);
        const bf16x8 wf = __builtin_bit_cast(bf16x8, wp);
#pragma unroll
        for (int dt = 0; dt < 4; ++dt) { const LAS bf16* vp = Vs + (16 * dt + r16) * 136 + 32 * t + 4 * quad;
            const u32x2 lo = *(const LAS u32x2*)vp, hi = *(const LAS u32x2*)(vp + 16);
            const bf16x8 vf = __builtin_bit_cast(bf16x8, ((u32x4){lo.x, lo.y, hi.x, hi.y}));
            O[dt] = MFMA16(wf, vf, O[dt]); } }
    return tail;
}
template <bool REAL> __device__ __forceinline__ void attn_phase(bf16* QO, const bf16* Kb, const bf16* VT, LAS unsigned char* L) {
    int tid_ = threadIdx.x; asm volatile("" : "+v"(tid_));
    const int tid = tid_, lane = tid & 63, w = __builtin_amdgcn_readfirstlane(tid >> 6), r16 = lane & 15, quad = lane >> 4;
    LAS bf16* Ks = (LAS bf16*)(L + AT_KS); LAS bf16* Vs = (LAS bf16*)(L + AT_VS); LAS float* smax_s = (LAS float*)(L + AT_SMAX);
    const int ks_s = tid >> 2, ks_p = tid & 3, vs_d = tid >> 3, vs_p = tid & 7;
    u32x4 pk0, pk1, pv0, pv1; bf16x8 qn[2];
#define ATT_LOAD(b_, h_, kb_) do { const bf16* src = Kb + ((size_t)(b_) * SEQ + (kb_) * 128 + ks_s) * 1024 + (h_) * 64 + ks_p * 16; pk0 = *(const u32x4*)src; pk1 = *(const u32x4*)(src + 8); \
        const bf16* vsrc = VT + (size_t)((h_) * 64 + vs_d) * T + (size_t)(b_) * SEQ + (kb_) * 128 + vs_p * 16; pv0 = *(const u32x4*)vsrc; pv1 = *(const u32x4*)(vsrc + 8); } while (0)
#define ATT_QLOAD(b_, h_, qb_) do { const size_t rq_ = (size_t)(b_) * SEQ + (qb_) * 128 + 16 * w; \
        _Pragma("unroll") for (int ks = 0; ks < 2; ++ks) qn[ks] = *(const bf16x8*)(QO + (rq_ + r16) * 1024 + (h_) * 64 + ks * 32 + quad * 8); } while (0)
    if ((int)blockIdx.x < 4096) { const int u0 = blockIdx.x, bh0 = u0 & 63, qb0 = 63 - (u0 >> 6); ATT_QLOAD(bh0 >> 4, bh0 & 15, qb0); ATT_LOAD(bh0 >> 4, bh0 & 15, qb0); }
    for (int unit = blockIdx.x; unit < 4096; unit += gridDim.x) {
        const int bh = unit & 63, qb = 63 - (unit >> 6), b = bh >> 4, h = bh & 15;
        const size_t rowq = (size_t)b * SEQ + qb * 128 + 16 * w;
        bf16x8 qf[2]; qf[0] = qn[0]; qf[1] = qn[1];
        f32x4 O[4]; O[0] = O[1] = O[2] = O[3] = (f32x4){0.f, 0.f, 0.f, 0.f};
        float suffix = 0.f, wsm = 0.f;
        const int q_rel = 16 * w + r16;
        for (int kb = qb; kb >= 0; --kb) {
            *(LAS u32x4*)(Ks + ks_s * 72 + ks_p * 16) = pk0; *(LAS u32x4*)(Ks + ks_s * 72 + ks_p * 16 + 8) = pk1;
            *(LAS u32x4*)(Vs + vs_d * 136 + vs_p * 16) = pv0; *(LAS u32x4*)(Vs + vs_d * 136 + vs_p * 16 + 8) = pv1;
            __syncthreads();
            if (kb > 0) ATT_LOAD(b, h, kb - 1);
            __builtin_amdgcn_sched_barrier(0);
            if (wsm > -160.f) {
                float tail;
                if (kb != qb) tail = att_block<false, 8>(Ks, Vs, qf, O, suffix, q_rel, r16, quad);
                else switch (w) {
                    case 0: tail = att_block<true, 1>(Ks, Vs, qf, O, suffix, q_rel, r16, quad); break; case 1: tail = att_block<true, 2>(Ks, Vs, qf, O, suffix, q_rel, r16, quad); break;
                    case 2: tail = att_block<true, 3>(Ks, Vs, qf, O, suffix, q_rel, r16, quad); break; case 3: tail = att_block<true, 4>(Ks, Vs, qf, O, suffix, q_rel, r16, quad); break;
                    case 4: tail = att_block<true, 5>(Ks, Vs, qf, O, suffix, q_rel, r16, quad); break; case 5: tail = att_block<true, 6>(Ks, Vs, qf, O, suffix, q_rel, r16, quad); break;
                    case 6: tail = att_block<true, 7>(Ks, Vs, qf, O, suffix, q_rel, r16, quad); break; default: tail = att_block<true, 8>(Ks, Vs, qf, O, suffix, q_rel, r16, quad); break; }
                suffix += tail;
                float sm = suffix; sm = fmaxf(sm, __shfl_xor(sm, 1)); sm = fmaxf(sm, __shfl_xor(sm, 2)); sm = fmaxf(sm, __shfl_xor(sm, 4)); sm = fmaxf(sm, __shfl_xor(sm, 8));
                wsm = sm;
            }
            if (lane == 0) smax_s[w] = wsm;
            __syncthreads();
            float mall = smax_s[0];
#pragma unroll
            for (int i = 1; i < 8; ++i) mall = fmaxf(mall, smax_s[i]);
            if (mall < -160.f) break;
        }
        { const int nu = unit + gridDim.x; if (nu < 4096) { const int nbh = nu & 63, nqb = 63 - (nu >> 6); ATT_QLOAD(nbh >> 4, nbh & 15, nqb); ATT_LOAD(nbh >> 4, nbh & 15, nqb); } }
        __builtin_amdgcn_sched_barrier(0);
#pragma unroll
        for (int dt = 0; dt < 4; ++dt)
#pragma unroll
            for (int j = 0; j < 4; ++j) if (REAL) QO[(rowq + 4 * quad + j) * 1024 + h * 64 + 16 * dt + r16] = (bf16)f2bf(O[dt][j]);
    }
}
#undef ATT_LOAD
#undef ATT_QLOAD

#define XB_TMO      128
#define XB_XCNT(j)  (256  + 64 * (j))
#define XB_XSUB(j)  (1280 + 64 * (j))
#define XB_XGEN(j)  (2304 + 64 * (j))
#define XB_TOP      3328
#define XB_TOPGEN   3392
#define XCD_BAR_WORDS 3456
#define XB_SPIN_CAP (1u << 20)

__device__ __forceinline__ unsigned xb_ld(unsigned* p)              { return __hip_atomic_load(p, __ATOMIC_RELAXED, __HIP_MEMORY_SCOPE_AGENT); }
__device__ __forceinline__ unsigned xb_add(unsigned* p, unsigned v) { return __hip_atomic_fetch_add(p, v, __ATOMIC_RELAXED, __HIP_MEMORY_SCOPE_AGENT); }
__device__ __forceinline__ unsigned xb_xcc_id() { return (unsigned)__builtin_amdgcn_s_getreg((3 << 11) | 20) & 0xFu; }
#define XB_SPIN(cond, bar) do { unsigned _sp = 0; while (cond) { __builtin_amdgcn_s_sleep(1); \
    if ((++_sp & 255u) == 0u) { if (xb_ld(&(bar)[XB_TMO])) break; if (_sp > XB_SPIN_CAP) { atomicAdd(&(bar)[XB_TMO], 1u); break; } } } } while (0)

struct XcdBarrier {
    unsigned* bar; unsigned x;
    volatile LAS unsigned* st;
};

__device__ __forceinline__ XcdBarrier xcd_barrier_post(unsigned* bar, volatile LAS unsigned* st) {
    XcdBarrier b; b.bar = bar; b.x = xb_xcc_id(); b.st = st;
    if (threadIdx.x == 0) (void)xb_add(&bar[XB_XCNT(b.x)], 1u);
    return b;
}
__device__ __forceinline__ void xcd_barrier_complete(unsigned* bar, unsigned x, unsigned& nloc, unsigned& nx) {
    const unsigned G = gridDim.x * gridDim.y * gridDim.z;
    unsigned sum, cnt, mine, sp = 0u;
    for (;;) {
        sum = 0u; cnt = 0u; mine = 0u;
#pragma unroll
        for (unsigned j = 0; j < 16; ++j) { const unsigned c = xb_ld(&bar[XB_XCNT(j)]); sum += c; cnt += (c > 0u) ? 1u : 0u; mine = (j == x) ? c : mine; }
        if (sum == G) break;
        __builtin_amdgcn_s_sleep(1);
        if ((++sp & 255u) == 0u) { if (xb_ld(&bar[XB_TMO])) break; if (sp > XB_SPIN_CAP) { atomicAdd(&bar[XB_TMO], 1u); break; } }
    }
    nloc = mine > 0u ? mine : 1u; nx = cnt > 0u ? cnt : 1u;
}

__device__ __forceinline__ void xcd_barrier(const XcdBarrier& b) {
    asm volatile("s_waitcnt vmcnt(0)" ::: "memory");
    __syncthreads();
    if (threadIdx.x == 0) {
        unsigned* bar = b.bar;
        __builtin_amdgcn_s_waitcnt(0);
        unsigned nloc = b.st[0], nx = b.st[1];
        if (nloc == 0u) { xcd_barrier_complete(bar, b.x, nloc, nx); b.st[0] = nloc; b.st[1] = nx; }
        const unsigned old = xb_add(&bar[XB_XSUB(b.x)], 1u);
        const unsigned gen = old / nloc;
        if (old + 1u == (gen + 1u) * nloc) {
            __builtin_amdgcn_fence(__ATOMIC_RELEASE, "agent");
            asm volatile("s_waitcnt vmcnt(0)" ::: "memory");
            const unsigned og = xb_add(&bar[XB_TOP], 1u);
            const unsigned tg = og / nx;
            if (og + 1u == (tg + 1u) * nx) xb_add(&bar[XB_TOPGEN], 1u);
            else XB_SPIN(xb_ld(&bar[XB_TOPGEN]) == tg, bar);
            __builtin_amdgcn_fence(__ATOMIC_ACQUIRE, "agent");
            xb_add(&bar[XB_XGEN(b.x)], 1u);
            asm volatile("s_waitcnt vmcnt(0)" ::: "memory");
        } else {
            XB_SPIN(xb_ld(&bar[XB_XGEN(b.x)]) == gen, bar);
            __builtin_amdgcn_fence(__ATOMIC_ACQUIRE, "agent");
            asm volatile("s_waitcnt vmcnt(0)" ::: "memory");
        }
    }
    __syncthreads();
}

#ifndef DUPMASK
#define DUPMASK 0
#endif
#ifndef SSD_DMODE
#define SSD_DMODE 15
#endif
#define DUP(k) constexpr ((DUPMASK >> (k)) & 1)
__global__ void __launch_bounds__(NTHR, 2) yoco_fwd(Params p) {
    extern __shared__ __attribute__((aligned(16))) unsigned char lds[];
    LAS unsigned char* L = (LAS unsigned char*)lds;
    cg::grid_group grid = cg::this_grid();
    if (threadIdx.x < 2) ((LAS unsigned*)(L + LDS_BYTES - 16))[threadIdx.x] = 0u;
    __syncthreads();
    const XcdBarrier xbar = xcd_barrier_post((unsigned*)(p.ws + WS_BAR), (volatile LAS unsigned*)(L + LDS_BYTES - 16));
    if (gridDim.x > 65536u) grid.sync();
#define GSYNC() xcd_barrier(xbar)
    unsigned char* ws = p.ws;
    bf16* WB = (bf16*)(ws + WS_W);
    float* MODS = (float*)(ws + WS_MODS); float* SUMSQ = (float*)(ws + WS_SUMSQ);
    bf16* X = (bf16*)(ws + WS_X);
    bf16* H0 = (bf16*)(ws + WS_X); float* DTb = (float*)(ws + WS_X + 64 * MiB); float* ACSb = (float*)(ws + WS_X + 92 * MiB); float* PSb = (float*)(ws + WS_X + 96 * MiB); float* P0b = (float*)(ws + WS_X + 68 * MiB); float* UH0 = (float*)(ws + WS_X + 80 * MiB);
    bf16* XBC = (bf16*)(ws + WS_BIG); bf16* Gb = (bf16*)(ws + WS_BIG); bf16* H = (bf16*)(ws + WS_BIG + 176 * MiB);
    float* P1b = (float*)(ws + WS_BIG + 240 * MiB); float* UH1 = (float*)(ws + WS_BIG + 248 * MiB);
    bf16* HK = (bf16*)(ws + WS_BIG); bf16* QO = (bf16*)(ws + WS_BIG + 64 * MiB);
    bf16* Zb = (bf16*)p.out; bf16* Kb = (bf16*)p.out; bf16* VT = (bf16*)((unsigned char*)p.out + 64 * MiB);
    LAS float* xch = (LAS float*)(L + XCH_OFF);
    const int G_ = gridDim.x, c_ = blockIdx.x;
    using pg8::Gemm; using pg8::StaticOrder;

#ifndef PHM
#define PHM 0xffff
#endif
#define EN(x) constexpr ((PHM >> (x)) & 1)
    unsigned long long* TS = (unsigned long long*)(ws + WS_FLAGS + 4096);
    STAMP(0);
if DUP(1) { if EN(0) p0_phase(p, L); GSYNC(); }
        if EN(0) p0_phase(p, L);
    GSYNC(); STAMP(1);
if DUP(2) { if EN(1) norm_phase<1, false>(p.in[0], p.in[4], MODS + 0, H0, nullptr, nullptr, nullptr); GSYNC(); }
        if EN(1) norm_phase<1, false>(p.in[0], p.in[4], MODS + 0, H0, nullptr, nullptr, nullptr);
    GSYNC(); STAMP(2);
    if DUP(3) { if EN(2) {
        Gemm g{H0, WB + W_IN, T, 2304, 1024}; StaticOrder S; S.init(T, 2304, G_, c_);
        pg8::EpiZdt E{Zb, DTb, p.in[9]};
        pg8::gemm_phase<pg8::EpiZdt, StaticOrder, true, true>(L, g, S, E);
    }
    if EN(2) {
        Gemm g{H0, WB + W_IN + (size_t)2304 * 1024, T, 4096, 1024}; StaticOrder S; S.init(T, 4096, G_, c_);
        pg8::EpiMamba E{XBC, P0b, UH0, p.in[7], p.in[8], xch};
        pg8::gemm_phase<pg8::EpiMamba, StaticOrder, true, true>(L, g, S, E);
    } GSYNC(); }
    if EN(2) {
        Gemm g{H0, WB + W_IN, T, 2304, 1024}; StaticOrder S; S.init(T, 2304, G_, c_);
        pg8::EpiZdt E{Zb, DTb, p.in[9]};
        pg8::gemm_phase<pg8::EpiZdt, StaticOrder, true, true>(L, g, S, E);
    }
    if EN(2) {
        Gemm g{H0, WB + W_IN + (size_t)2304 * 1024, T, 4096, 1024}; StaticOrder S; S.init(T, 4096, G_, c_);
        pg8::EpiMamba E{XBC, P0b, UH0, p.in[7], p.in[8], xch};
        pg8::gemm_phase<pg8::EpiMamba, StaticOrder, true, true>(L, g, S, E);
    }
    GSYNC(); STAMP(3);
#ifdef XSYNC
    for (int i = 0; i < XSYNC; ++i) GSYNC();
#endif
    if EN(3) { fixup_mamba(P0b, UH0, p.in[7], p.in[8], XBC); acs_phase(DTb, p.in[10], ACSb); }
    GSYNC(); STAMP(4);
    if DUP(5) { ssd_phase<false, SSD_DMODE>(XBC, Zb, DTb, ACSb, p.in[10], p.in[11], p.in[12], PSb, L); GSYNC(); }
    if EN(4) ssd_phase<true>(XBC, Zb, DTb, ACSb, p.in[10], p.in[11], p.in[12], PSb, L);
    GSYNC();
    ssreduce_phase(PSb, SUMSQ);
    GSYNC(); STAMP(5);
    if DUP(6) { if EN(5) {
        Gemm g{Zb, WB + W_SOUT, T, 1024, 2048}; StaticOrder S; S.init(T, 1024, G_, c_);
        pg8::EpiRes<true> E{p.in[0], X, MODS + 2048, SUMSQ};
        pg8::gemm_phase<pg8::EpiRes<true>, StaticOrder, true, true>(L, g, S, E);
    } GSYNC(); }
    if EN(5) {
        Gemm g{Zb, WB + W_SOUT, T, 1024, 2048}; StaticOrder S; S.init(T, 1024, G_, c_);
        pg8::EpiRes<true> E{p.in[0], X, MODS + 2048, SUMSQ};
        pg8::gemm_phase<pg8::EpiRes<true>, StaticOrder, true, true>(L, g, S, E);
    }
    GSYNC(); STAMP(6);
    {
        const float* md = MODS;
if DUP(7) { norm_phase_b<1, false>(X, p.in[5] + 0, md + 3072, H, nullptr, nullptr, nullptr); GSYNC(); }
            norm_phase_b<1, false>(X, p.in[5] + 0, md + 3072, H, nullptr, nullptr, nullptr);
        GSYNC(); STAMP(7);
        if DUP(8) { if EN(9) { Gemm g{H, WB + (W_FIN0), T, 5632, 1024}; StaticOrder S; S.init(T, 5632, G_, c_);
          pg8::EpiFFN E{Gb, P1b, UH1, p.in[22] + 0, p.in[23] + 0, xch};
          pg8::gemm_phase<pg8::EpiFFN, StaticOrder, true, true>(L, g, S, E); } GSYNC(); }
    if EN(9) { Gemm g{H, WB + (W_FIN0), T, 5632, 1024}; StaticOrder S; S.init(T, 5632, G_, c_);
          pg8::EpiFFN E{Gb, P1b, UH1, p.in[22] + 0, p.in[23] + 0, xch};
          pg8::gemm_phase<pg8::EpiFFN, StaticOrder, true, true>(L, g, S, E); }
        GSYNC(); STAMP(8);
        if EN(10) fixup_ffn(P1b, UH1, p.in[22] + 0, p.in[23] + 0, Gb);
        GSYNC(); STAMP(9);
        if DUP(10) { if EN(11) { Gemm g{Gb, WB + (W_FOUT0), T, 1024, 2816}; StaticOrder S; S.init(T, 1024, G_, c_); pg8::EpiRes<false> E{X, (bf16*)p.out, md + 5120, nullptr};
          pg8::gemm_phase<pg8::EpiRes<false>, StaticOrder, true, true>(L, g, S, E); } GSYNC(); }
    if EN(11) { Gemm g{Gb, WB + (W_FOUT0), T, 1024, 2816}; StaticOrder S; S.init(T, 1024, G_, c_); pg8::EpiRes<false> E{X, X, md + 5120, nullptr};
          pg8::gemm_phase<pg8::EpiRes<false>, StaticOrder, true, true>(L, g, S, E); }
        GSYNC(); STAMP(10);
    }
    {
        const float* md = MODS + MOD_L;
if DUP(11) { norm_phase_b<2, false>(X, p.in[16], MODS + MOD_KV, HK, p.in[4] + 1024, md + 0, H); GSYNC(); }
                norm_phase_b<2, false>(X, p.in[16], MODS + MOD_KV, HK, p.in[4] + 1024, md + 0, H);
            GSYNC(); STAMP(11);
            if DUP(12) { if EN(6) { Gemm g{HK, WB + W_K, T, 1024, 1024}; StaticOrder S; S.init(T, 1024, G_, c_); pg8::EpiStore E{Kb, 1024, 1.0f};
              pg8::gemm_phase<pg8::EpiStore, StaticOrder, true, true>(L, g, S, E); }
            if EN(6) { Gemm g{WB + W_V, HK, 1024, T, 1024}; StaticOrder S; S.init(1024, T, G_, c_); pg8::EpiStore E{VT, T, 1.0f};
              pg8::gemm_phase<pg8::EpiStore, StaticOrder, true, true>(L, g, S, E); }
            if EN(6) { Gemm g{H, WB + W_Q, T, 1024, 1024}; StaticOrder S; S.init(T, 1024, G_, c_); pg8::EpiStore E{QO, 1024, 0.125f * 1.4426950408889634f};
              pg8::gemm_phase<pg8::EpiStore, StaticOrder, true, true>(L, g, S, E); } GSYNC(); }
    if EN(6) { Gemm g{HK, WB + W_K, T, 1024, 1024}; StaticOrder S; S.init(T, 1024, G_, c_); pg8::EpiStore E{Kb, 1024, 1.0f};
              pg8::gemm_phase<pg8::EpiStore, StaticOrder, true, true>(L, g, S, E); }
            if EN(6) { Gemm g{WB + W_V, HK, 1024, T, 1024}; StaticOrder S; S.init(1024, T, G_, c_); pg8::EpiStore E{VT, T, 1.0f};
              pg8::gemm_phase<pg8::EpiStore, StaticOrder, true, true>(L, g, S, E); }
            if EN(6) { Gemm g{H, WB + W_Q, T, 1024, 1024}; StaticOrder S; S.init(T, 1024, G_, c_); pg8::EpiStore E{QO, 1024, 0.125f * 1.4426950408889634f};
              pg8::gemm_phase<pg8::EpiStore, StaticOrder, true, true>(L, g, S, E); }
            GSYNC(); STAMP(12);
            if DUP(13) { attn_phase<false>(QO, Kb, VT, L); GSYNC(); }
            if EN(7) attn_phase<true>(QO, Kb, VT, L);
            GSYNC(); STAMP(13);
            if DUP(14) { if EN(8) { Gemm g{QO, WB + W_O, T, 1024, 1024}; StaticOrder S; S.init(T, 1024, G_, c_); pg8::EpiRes<false> E{X, (bf16*)p.out, md + 2048, nullptr};
              pg8::gemm_phase<pg8::EpiRes<false>, StaticOrder, true, true>(L, g, S, E); } GSYNC(); }
    if EN(8) { Gemm g{QO, WB + W_O, T, 1024, 1024}; StaticOrder S; S.init(T, 1024, G_, c_); pg8::EpiRes<false> E{X, X, md + 2048, nullptr};
              pg8::gemm_phase<pg8::EpiRes<false>, StaticOrder, true, true>(L, g, S, E); }
            GSYNC(); STAMP(14);
if DUP(15) { norm_phase_b<1, false>(X, p.in[5] + 1024, md + 3072, H, nullptr, nullptr, nullptr); GSYNC(); }
            norm_phase_b<1, false>(X, p.in[5] + 1024, md + 3072, H, nullptr, nullptr, nullptr);
        GSYNC(); STAMP(15);
        if DUP(16) { if EN(9) { Gemm g{H, WB + (W_FIN1), T, 5632, 1024}; StaticOrder S; S.init(T, 5632, G_, c_);
          pg8::EpiFFN E{Gb, P1b, UH1, p.in[22] + 16896, p.in[23] + 5632, xch};
          pg8::gemm_phase<pg8::EpiFFN, StaticOrder, true, true>(L, g, S, E); } GSYNC(); }
    if EN(9) { Gemm g{H, WB + (W_FIN1), T, 5632, 1024}; StaticOrder S; S.init(T, 5632, G_, c_);
          pg8::EpiFFN E{Gb, P1b, UH1, p.in[22] + 16896, p.in[23] + 5632, xch};
          pg8::gemm_phase<pg8::EpiFFN, StaticOrder, true, true>(L, g, S, E); }
        GSYNC(); STAMP(16);
        if EN(10) fixup_ffn(P1b, UH1, p.in[22] + 16896, p.in[23] + 5632, Gb);
        GSYNC(); STAMP(17);
        if DUP(18) { if EN(11) { Gemm g{Gb, WB + (W_FOUT1), T, 1024, 2816}; StaticOrder S; S.init(T, 1024, G_, c_); pg8::EpiRes<false> E{X, (bf16*)p.out, md + 5120, nullptr};
          pg8::gemm_phase<pg8::EpiRes<false>, StaticOrder, true, true>(L, g, S, E); } GSYNC(); }
    if EN(11) { Gemm g{Gb, WB + (W_FOUT1), T, 1024, 2816}; StaticOrder S; S.init(T, 1024, G_, c_); pg8::EpiRes<false> E{X, X, md + 5120, nullptr};
          pg8::gemm_phase<pg8::EpiRes<false>, StaticOrder, true, true>(L, g, S, E); }
        GSYNC(); STAMP(18);
    }
if DUP(19) { norm_phase_b<1, true>(X, p.in[27], MODS + MOD_FIN, p.out, nullptr, nullptr, nullptr); GSYNC(); }
        norm_phase_b<1, true>(X, p.in[27], MODS + MOD_FIN, p.out, nullptr, nullptr, nullptr);
#ifdef PROBE
    GSYNC(); STAMP(19);
    __threadfence();
    {   volatile unsigned long long* tsv = TS; float ta = 0.f, tb = 0.f;
        for (int k = 1; k <= 19; ++k) { const float d = (float)(tsv[k] - tsv[k - 1]) * 0.01f; if ((PROBE_A >> k) & 1) ta += d; if ((PROBE_B >> k) & 1) tb += d; }
        for (int i = blockIdx.x * NTHR + threadIdx.x; i < (1 << 22); i += gridDim.x * NTHR) p.out[(1 << 24) + i] = tb;
        if (blockIdx.x == 0 && threadIdx.x == 0) p.out[0] = ta * 10.0f; }
#endif
}

extern "C" void kernel_launch(void* const* d_in, const int* in_sizes, int n_in, void* d_out, int out_size, void* d_ws, size_t ws_size, hipStream_t stream) {
    static int grid = 0;
    if (grid == 0) {
        if (n_in != 28 || out_size != T * D || ws_size < WS_END) { fprintf(stderr, "kernel_launch: unexpected shapes (n_in %d out %d ws %zu)\n", n_in, out_size, ws_size); grid = -1; return; }
        int dev = 0, cus = 0, per_cu = 0;
        hipGetDevice(&dev); hipDeviceGetAttribute(&cus, hipDeviceAttributeMultiprocessorCount, dev);
        hipFuncSetAttribute((const void*)yoco_fwd, hipFuncAttributeMaxDynamicSharedMemorySize, LDS_BYTES);
        hipOccupancyMaxActiveBlocksPerMultiprocessor(&per_cu, (const void*)yoco_fwd, NTHR, LDS_BYTES);
        if (per_cu < 1) per_cu = 1;
        grid = cus * per_cu; if (grid > 256) grid = 256;
        (void)hipGetLastError();
    }
    if (grid < 0) return;
    Params p{};
    for (int i = 0; i < 28; ++i) p.in[i] = (const float*)d_in[i];
    p.out = (float*)d_out; p.ws = (unsigned char*)d_ws;
    (void)hipMemsetAsync((unsigned char*)d_ws + WS_BAR, 0, 16384, stream);
    void* args[] = {&p};
    hipError_t e = hipLaunchCooperativeKernel((const void*)yoco_fwd, dim3(grid), dim3(NTHR), args, LDS_BYTES, stream);
    if (e != hipSuccess) fprintf(stderr, "cooperative launch failed: %s (grid %d)\n", hipGetErrorString(e), grid);
}
```

```cpp
#include <hip/hip_runtime.h>
#include <hip/hip_cooperative_groups.h>
#include <cstdio>
#include <cstdint>
namespace cg = cooperative_groups;
#ifndef DBG
#define DBG 0
#endif
namespace pg8 {
#define PG8_LAS __attribute__((address_space(3)))
typedef unsigned short bf16_t;
typedef short bf16x8 __attribute__((ext_vector_type(8)));
typedef float f32x4 __attribute__((ext_vector_type(4)));
typedef unsigned u32x4 __attribute__((ext_vector_type(4)));
constexpr int BM = 256, BK = 64, HALF = 128, HTB = HALF * BK * 2  , STAGE_BYTES = 8 * HTB, NXCD = 8, WGM = 8;

__host__ __device__ __forceinline__ int lds_byte(int r, int c) { const int st = (r >> 4) * 2 + (c >> 5), rr = r & 15, cc = c & 31, ob = rr * 64 + cc * 2; return st * 1024 + (ob ^ (((ob >> 9) & 1) << 5)); }
__host__ __device__ __forceinline__ void stage_rc(int b, int& R, int& C) { const int st = b / 1024, sb = b % 1024, swz = sb ^ (((sb >> 9) & 1) << 5); R = (st >> 1) * 16 + swz / 64; C = (st & 1) * 32 + (swz % 64) / 2; }
__host__ __device__ __forceinline__ int perm32(int rho) { const int n = rho >> 4, i = rho & 15; return 8 * (i >> 2) + 4 * n + (i & 3); }

struct Unit { int pm, pn; };
struct Gemm { const bf16_t* A; const bf16_t* Bt; int M, N, K; };

struct StaticOrder {
    int nM, nN, nwg, G, c;
    __host__ __device__ void init(int M, int N, int G_, int c_) { nM = M / BM; nN = N / BM; nwg = nM * nN; G = G_; c = c_; }
    __host__ __device__ bool next(int i, Unit& u) const {
        const long L = (long)i * G + c; if (L >= nwg) return false;
        int wgid = (int)L; { const int q = nwg / NXCD, r = nwg % NXCD, xcd = wgid % NXCD, off = wgid / NXCD; wgid = (xcd < r ? xcd * (q + 1) : r * (q + 1) + (xcd - r) * q) + off; }
        const int nig = WGM * nN, gid = wgid / nig, fm = gid * WGM, gsz = (nM - fm) < WGM ? (nM - fm) : WGM;
        u.pm = fm + ((wgid % nig) % gsz); u.pn = (wgid % nig) / gsz; return true;
    }
    __device__ __forceinline__ void a_ready(const Unit&) const {}
    __device__ __forceinline__ void done(const Unit&) const {}
};

__device__ __forceinline__ unsigned cvt_pk_bf16(float lo, float hi) { unsigned r; asm volatile("v_cvt_pk_bf16_f32 %0, %1, %2" : "=v"(r) : "v"(lo), "v"(hi)); return r; }

typedef unsigned u32x2 __attribute__((ext_vector_type(2)));
typedef float f32x2 __attribute__((ext_vector_type(2)));
__device__ __forceinline__ float silu_f(float x) { return x * __builtin_amdgcn_rcpf(1.f + __expf(-x)); }
__device__ __forceinline__ f32x2 silu2(f32x2 x) { const f32x2 t = x * (-1.4426950408889634f); f32x2 d; d.x = __builtin_amdgcn_exp2f(t.x); d.y = __builtin_amdgcn_exp2f(t.y); d = d + 1.0f;
    f32x2 r; r.x = __builtin_amdgcn_rcpf(d.x); r.y = __builtin_amdgcn_rcpf(d.y); return x * r; }
__device__ __forceinline__ float softplus_f(float x) { return fmaxf(x, 0.f) + __logf(1.f + __expf(-fabsf(x))); }
template <int K> __device__ __forceinline__ float dpp_ror(float v) { return __int_as_float(__builtin_amdgcn_update_dpp(0, __float_as_int(v), 0x120 + K, 0xf, 0xf, false)); }
template <int K> __device__ __forceinline__ float dpp_shr_keep(float cur, float old) { return __int_as_float(__builtin_amdgcn_update_dpp(__float_as_int(old), __float_as_int(cur), 0x110 + K, 0xf, 0xf, false)); }
template <int K> __device__ __forceinline__ float shift1(float cur, float prev, float halo, bool first) { const float old = first ? halo : dpp_ror<K>(prev); return dpp_shr_keep<K>(cur, old); }
template <int K> __device__ __forceinline__ f32x4 shift_rows(const f32x4 cur, const f32x4 prev, const f32x4 halo, bool first) {
    f32x4 r;
#pragma unroll
    for (int e = 0; e < 4; ++e) { const float old = first ? halo[e] : dpp_ror<K>(prev[e]); r[e] = dpp_shr_keep<K>(cur[e], old); }
    return r;
}

struct EpiStore {
    static constexpr bool PERM = true, AFTER_DRAIN = false, ROWPERM = false;
    bf16_t* O; int ldc; float sc;
    __device__ __forceinline__ void operator()(const f32x4 (&acc)[2][2][4][2], const Unit& u, int wr, int wc, int fr, int fq) const {
        asm volatile("" : "+v"(fr), "+v"(fq));
        const int row0 = u.pm * BM + wr * 64 + fr, col0 = u.pn * BM + wc * 32 + 8 * fq;
#pragma unroll
        for (int ai = 0; ai < 2; ++ai)
#pragma unroll
            for (int m = 0; m < 4; ++m) { bf16_t* rowp = O + (size_t)(row0 + ai * HALF + m * 16) * ldc + col0;
#pragma unroll
                for (int bj = 0; bj < 2; ++bj) { const f32x4 v0 = acc[ai][bj][m][0] * sc, v1 = acc[ai][bj][m][1] * sc;
                    u32x4 w; w.x = cvt_pk_bf16(v0[0], v0[1]); w.y = cvt_pk_bf16(v0[2], v0[3]); w.z = cvt_pk_bf16(v1[0], v1[1]); w.w = cvt_pk_bf16(v1[2], v1[3]);
                    *(u32x4*)(rowp + bj * HALF) = w; } }
    }
};

template <bool XIN_F32> struct EpiRes {
    static constexpr bool PERM = true, AFTER_DRAIN = false, ROWPERM = false;
    const void* xin; bf16_t* xout; const float* gate; const float* sumsq;
    __device__ __forceinline__ void operator()(const f32x4 (&acc)[2][2][4][2], const Unit& u, int wr, int wc, int fr, int fq) const {
        asm volatile("" : "+v"(fr), "+v"(fq));
        const int row0 = u.pm * BM + wr * 64 + fr, col0 = u.pn * BM + wc * 32 + 8 * fq;
        const float* gp = gate + (size_t)(u.pm >> 5) * 16384 + col0;
        f32x4 gv[2][2];
#pragma unroll
        for (int bj = 0; bj < 2; ++bj)
#pragma unroll
            for (int n = 0; n < 2; ++n) gv[bj][n] = *(const f32x4*)(gp + bj * HALF + n * 4);
#pragma unroll
        for (int ai = 0; ai < 2; ++ai)
#pragma unroll
            for (int m = 0; m < 4; ++m) { const int row = row0 + ai * HALF + m * 16;
                const float rs = sumsq ? sumsq[row] : 1.0f;
                const size_t off = (size_t)row * 1024 + col0;
#pragma unroll
                for (int bj = 0; bj < 2; ++bj) {
                    f32x4 x0, x1;
                    if (XIN_F32) { x0 = __builtin_nontemporal_load((const f32x4*)((const float*)xin + off + bj * HALF)); x1 = __builtin_nontemporal_load((const f32x4*)((const float*)xin + off + bj * HALF + 4)); }
                    else { const u32x4 xb = *(const u32x4*)((const bf16_t*)xin + off + bj * HALF);
                        x0 = (f32x4){__uint_as_float(xb.x << 16), __uint_as_float(xb.x & 0xffff0000u), __uint_as_float(xb.y << 16), __uint_as_float(xb.y & 0xffff0000u)};
                        x1 = (f32x4){__uint_as_float(xb.z << 16), __uint_as_float(xb.z & 0xffff0000u), __uint_as_float(xb.w << 16), __uint_as_float(xb.w & 0xffff0000u)}; }
                    const f32x4 v0 = x0 + gv[bj][0] * acc[ai][bj][m][0] * rs, v1 = x1 + gv[bj][1] * acc[ai][bj][m][1] * rs;
                    u32x4 w; w.x = cvt_pk_bf16(v0[0], v0[1]); w.y = cvt_pk_bf16(v0[2], v0[3]); w.z = cvt_pk_bf16(v1[0], v1[1]); w.w = cvt_pk_bf16(v1[2], v1[3]);
                    *(u32x4*)(xout + off + bj * HALF) = w; } }
    }
};

struct EpiZdt {
    static constexpr bool PERM = true, AFTER_DRAIN = false, ROWPERM = false;
    bf16_t* Z; float* DT; const float* dtb;
    __device__ __forceinline__ void operator()(const f32x4 (&acc)[2][2][4][2], const Unit& u, int wr, int wc, int fr, int fq) const {
        asm volatile("" : "+v"(fr), "+v"(fq));
        const int row0 = u.pm * BM + wr * 64 + fr;
        if (u.pn < 8) {
            const int col0 = u.pn * BM + wc * 32 + 8 * fq;
#pragma unroll
            for (int ai = 0; ai < 2; ++ai)
#pragma unroll
                for (int m = 0; m < 4; ++m) { bf16_t* rowp = Z + (size_t)(row0 + ai * HALF + m * 16) * 2048 + col0;
#pragma unroll
                    for (int bj = 0; bj < 2; ++bj) { const f32x4 v0 = acc[ai][bj][m][0], v1 = acc[ai][bj][m][1];
                        u32x4 w; w.x = cvt_pk_bf16(v0[0], v0[1]); w.y = cvt_pk_bf16(v0[2], v0[3]); w.z = cvt_pk_bf16(v1[0], v1[1]); w.w = cvt_pk_bf16(v1[2], v1[3]);
                        *(u32x4*)(rowp + bj * HALF) = w; } }
            return;
        }
        {
            if (wc == 0) {
#pragma unroll
                for (int n = 0; n < 2; ++n) { const f32x4 bv = *(const f32x4*)(dtb + 8 * fq + 4 * n);
#pragma unroll
                    for (int ai = 0; ai < 2; ++ai)
#pragma unroll
                        for (int m = 0; m < 4; ++m) { f32x4 v = acc[ai][0][m][n] + bv;
#pragma unroll
                            for (int e = 0; e < 4; ++e) v[e] = softplus_f(v[e]);
                            *(f32x4*)(DT + (size_t)(row0 + ai * HALF + m * 16) * 32 + 8 * fq + 4 * n) = v; } }
            }
            return;
        }
    }
};

struct EpiMamba {
    static constexpr bool PERM = true, AFTER_DRAIN = false, ROWPERM = true;
    static constexpr int NC = 4096;
    bf16_t* XBC; float* P; float* UH; const float* cw; const float* cb; PG8_LAS float* xch;
    __device__ __forceinline__ void operator()(const f32x4 (&acc)[2][2][4][2], const Unit& u, int wr, int wc, int fr, int fq) const {
        asm volatile("" : "+v"(fr), "+v"(fq));
        const int row0 = u.pm * BM + wr * 64 + 4 * fr;
        const int cpos0 = 32 * wc + 8 * fq;
        PG8_LAS float* wt = xch + 3072;
        { const int tid = (wr * 4 + wc) * 64 + fq * 16 + fr;
#pragma unroll
            for (int j = 0; j < 3; ++j) { const int i = tid + 512 * j; if (i < 5 * 256) { const int t = i >> 8, cp = i & 255; wt[i] = t < 4 ? cw[t * 4096 + u.pn * BM + cp] : cb[u.pn * BM + cp]; } } }
        if (fr == 15) {
#pragma unroll
            for (int ai = 0; ai < 2; ++ai)
#pragma unroll
                for (int bj = 0; bj < 2; ++bj)
#pragma unroll
                    for (int n = 0; n < 2; ++n)
#pragma unroll
                        for (int m = 1; m < 4; ++m) {
                            *(PG8_LAS f32x4*)(xch + ((2 * ai + wr) * 3 + (m - 1)) * 256 + 128 * bj + cpos0 + 4 * n) = acc[ai][bj][m][n];
                            if (ai == 1 && wr == 1) *(f32x4*)(UH + ((size_t)u.pm * 3 + (m - 1)) * NC + u.pn * BM + 128 * bj + cpos0 + 4 * n) = acc[1][bj][m][n]; }
        }
        asm volatile("s_waitcnt lgkmcnt(0)" ::: "memory"); __builtin_amdgcn_s_barrier(); asm volatile("" ::: "memory");
#pragma unroll
        for (int ai = 0; ai < 2; ++ai) {
            const int seg = 2 * ai + wr; const bool has_prev = seg > 0; const int sp = has_prev ? seg - 1 : 0;
#pragma unroll
            for (int bj = 0; bj < 2; ++bj) {
                const int ch0 = u.pn * BM + 128 * bj + cpos0;
                unsigned pkn[2][4][2];
#pragma unroll
                for (int n = 0; n < 2; ++n) {
                    unsigned (&pk)[4][2] = pkn[n];
#pragma unroll
                    for (int eh = 0; eh < 2; ++eh) {
                        const int cpos = 128 * bj + cpos0 + 4 * n + 2 * eh; const int ch = ch0 + 4 * n + 2 * eh;
                        f32x2 h1 = *(const PG8_LAS f32x2*)(xch + (sp * 3 + 2) * 256 + cpos), h2 = *(const PG8_LAS f32x2*)(xch + (sp * 3 + 1) * 256 + cpos), h3 = *(const PG8_LAS f32x2*)(xch + (sp * 3 + 0) * 256 + cpos);
                        if (!has_prev) { h1 = (f32x2){0.f, 0.f}; h2 = h1; h3 = h1; }
                        const f32x2 w0 = *(const PG8_LAS f32x2*)(wt + 0 * 256 + cpos), w1 = *(const PG8_LAS f32x2*)(wt + 1 * 256 + cpos), w2 = *(const PG8_LAS f32x2*)(wt + 2 * 256 + cpos),
                                    w3 = *(const PG8_LAS f32x2*)(wt + 3 * 256 + cpos), bb = *(const PG8_LAS f32x2*)(wt + 4 * 256 + cpos);
                        f32x2 o[4], v[4];
#pragma unroll
                        for (int m = 0; m < 4; ++m) v[m] = (f32x2){acc[ai][bj][m][n][2 * eh], acc[ai][bj][m][n][2 * eh + 1]};
                        const f32x2 s1 = (f32x2){dpp_shr_keep<1>(v[3].x, h1.x), dpp_shr_keep<1>(v[3].y, h1.y)}, s2 = (f32x2){dpp_shr_keep<1>(v[2].x, h2.x), dpp_shr_keep<1>(v[2].y, h2.y)},
                                    s3 = (f32x2){dpp_shr_keep<1>(v[1].x, h3.x), dpp_shr_keep<1>(v[1].y, h3.y)};
                        o[0] = bb + w3 * v[0] + w2 * s1 + w1 * s2 + w0 * s3;
                        o[1] = bb + w3 * v[1] + w2 * v[0] + w1 * s1 + w0 * s2;
                        o[2] = bb + w3 * v[2] + w2 * v[1] + w1 * v[0] + w0 * s1;
                        o[3] = bb + w3 * v[3] + w2 * v[2] + w1 * v[1] + w0 * v[0];
                        if (seg == 0 && fr == 0) {
#pragma unroll
                            for (int m = 0; m < 3; ++m) *(f32x2*)(P + ((size_t)u.pm * 3 + m) * NC + u.pn * BM + cpos) = o[m]; }
#pragma unroll
                        for (int m = 0; m < 4; ++m) { const f32x2 r = silu2(o[m]); pk[m][eh] = cvt_pk_bf16(r.x, r.y); }
                    }
                }
#pragma unroll
                for (int m = 0; m < 4; ++m) { u32x4 w; w.x = pkn[0][m][0]; w.y = pkn[0][m][1]; w.z = pkn[1][m][0]; w.w = pkn[1][m][1]; *(u32x4*)(XBC + (size_t)(row0 + ai * HALF + m) * 4096 + ch0) = w; }
            }
        }
    }
};

struct EpiFFN {
    static constexpr bool PERM = true, AFTER_DRAIN = false, ROWPERM = true;
    static constexpr int NC = 5632, F = 2816;
    bf16_t* G; float* P; float* UH; const float* cw; const float* cb; PG8_LAS float* xch;
    __device__ __forceinline__ void operator()(const f32x4 (&acc)[2][2][4][2], const Unit& u, int wr, int wc, int fr, int fq) const {
        asm volatile("" : "+v"(fr), "+v"(fq));
        const int row0 = u.pm * BM + wr * 64 + 4 * fr;
        const int cpos0 = 32 * wc + 8 * fq;
        PG8_LAS float* wt = xch + 3072;
        { const int tid = (wr * 4 + wc) * 64 + fq * 16 + fr;
#pragma unroll
            for (int j = 0; j < 2; ++j) { const int i = tid + 512 * j; const int t = i >> 8, cp = i & 255; const int chs = (cp >> 7) * F + u.pn * 128 + (cp & 127); wt[i] = t < 3 ? cw[t * NC + chs] : cb[chs]; } }
        if (fr == 15) {
#pragma unroll
            for (int ai = 0; ai < 2; ++ai)
#pragma unroll
                for (int bj = 0; bj < 2; ++bj)
#pragma unroll
                    for (int n = 0; n < 2; ++n)
#pragma unroll
                        for (int m = 2; m < 4; ++m) {
                            *(PG8_LAS f32x4*)(xch + ((2 * ai + wr) * 2 + (m - 2)) * 256 + 128 * bj + cpos0 + 4 * n) = acc[ai][bj][m][n];
                            if (ai == 1 && wr == 1) *(f32x4*)(UH + ((size_t)u.pm * 2 + (m - 2)) * NC + u.pn * BM + 128 * bj + cpos0 + 4 * n) = acc[1][bj][m][n]; }
        }
        asm volatile("s_waitcnt lgkmcnt(0)" ::: "memory"); __builtin_amdgcn_s_barrier(); asm volatile("" ::: "memory");
        const int j0 = u.pn * 128 + cpos0;
#pragma unroll
        for (int ai = 0; ai < 2; ++ai) {
            const int seg = 2 * ai + wr; const bool has_prev = seg > 0; const int sp = has_prev ? seg - 1 : 0;
            unsigned pkn[2][4][2];
#pragma unroll
            for (int n = 0; n < 2; ++n) {
                unsigned (&pk)[4][2] = pkn[n];
#pragma unroll
                for (int eh = 0; eh < 2; ++eh) {
                    f32x2 og[2][4];
#pragma unroll
                    for (int bj = 0; bj < 2; ++bj) {
                        const int cpos = 128 * bj + cpos0 + 4 * n + 2 * eh;
                        f32x2 h1 = *(const PG8_LAS f32x2*)(xch + (sp * 2 + 1) * 256 + cpos), h2 = *(const PG8_LAS f32x2*)(xch + (sp * 2 + 0) * 256 + cpos);
                        if (!has_prev) { h1 = (f32x2){0.f, 0.f}; h2 = h1; }
                        const f32x2 w0 = *(const PG8_LAS f32x2*)(wt + 0 * 256 + cpos), w1 = *(const PG8_LAS f32x2*)(wt + 1 * 256 + cpos), w2 = *(const PG8_LAS f32x2*)(wt + 2 * 256 + cpos), bb = *(const PG8_LAS f32x2*)(wt + 3 * 256 + cpos);
                        f32x2 v[4];
#pragma unroll
                        for (int m = 0; m < 4; ++m) v[m] = (f32x2){acc[ai][bj][m][n][2 * eh], acc[ai][bj][m][n][2 * eh + 1]};
                        const f32x2 s1 = (f32x2){dpp_shr_keep<1>(v[3].x, h1.x), dpp_shr_keep<1>(v[3].y, h1.y)}, s2 = (f32x2){dpp_shr_keep<1>(v[2].x, h2.x), dpp_shr_keep<1>(v[2].y, h2.y)};
                        og[bj][0] = bb + w2 * v[0] + w1 * s1 + w0 * s2;
                        og[bj][1] = bb + w2 * v[1] + w1 * v[0] + w0 * s1;
                        og[bj][2] = bb + w2 * v[2] + w1 * v[1] + w0 * v[0];
                        og[bj][3] = bb + w2 * v[3] + w1 * v[2] + w0 * v[1];
                        if (seg == 0 && fr == 0) {
#pragma unroll
                            for (int m = 0; m < 2; ++m) *(f32x2*)(P + ((size_t)u.pm * 2 + m) * NC + u.pn * BM + cpos) = og[bj][m]; }
                    }
#pragma unroll
                    for (int m = 0; m < 4; ++m) { const f32x2 r = silu2(og[0][m]) * og[1][m]; pk[m][eh] = cvt_pk_bf16(r.x, r.y); }
                }
            }
#pragma unroll
            for (int m = 0; m < 4; ++m) { u32x4 w; w.x = pkn[0][m][0]; w.y = pkn[0][m][1]; w.z = pkn[1][m][0]; w.w = pkn[1][m][1]; *(u32x4*)(G + (size_t)(row0 + ai * HALF + m) * F + j0) = w; }
        }
    }
};
template <class Epi, class Sched, bool ALIGN_EPI = false, bool SP2 = false>
__device__ __forceinline__ void gemm_phase(PG8_LAS unsigned char* lds, const Gemm g, const Sched& S, const Epi& E) {
    int tid_ = threadIdx.x; asm volatile("" : "+v"(tid_));
    const int tid = tid_, wid = __builtin_amdgcn_readfirstlane(tid >> 6), lane = tid & 63, wr = wid >> 2, wc = wid & 3, fr = lane & 15, fq = lane >> 4;
    const int K = g.K, nt = K / BK;
    unsigned voffA[2], voffB[2];
#pragma unroll
    for (int i = 0; i < 2; ++i) { int R, C; stage_rc(tid * 16 + i * 8192, R, C); const int Rb = Epi::PERM ? ((R & ~31) + perm32(R & 31)) : R;
        const int Ra = Epi::ROWPERM ? ((R & ~63) + 4 * (R & 15) + ((R >> 4) & 3)) : R;
        voffA[i] = (unsigned)(Ra * K + C) * 2u; voffB[i] = (unsigned)(Rb * K + C) * 2u; }
    const size_t kstep = (size_t)(BK * 2);
    const size_t hstep = (size_t)HALF * K * 2;
    const size_t tstep = 2 * hstep;
    const unsigned ldsw = (unsigned)wid * 1024u;
    const int aoff = lds_byte(wr * 64 + fr, fq * 8), boff = lds_byte(wc * 32 + fr, fq * 8);
#define PG8_SA(b, h) (((b) * 2 + (h)) * HTB)
#define PG8_SB(b, h) ((4 + (b) * 2 + (h)) * HTB)
#define PG8_STAGE(bufoff, gbase, voff) do { _Pragma("unroll") for (int _i = 0; _i < 2; ++_i) \
        __builtin_amdgcn_global_load_lds((const unsigned*)((const char*)(gbase) + (voff)[_i]), (PG8_LAS unsigned*)(lds + (bufoff) + ldsw + _i * 8192), 16, 0, 0); } while (0)
#define PG8_LDA(dst, b, h) do { _Pragma("unroll") for (int m = 0; m < 4; ++m) _Pragma("unroll") for (int k = 0; k < 2; ++k) dst[m][k] = *(const PG8_LAS bf16x8*)(lds + PG8_SA(b, h) + aoff + m * 2048 + k * 1024); } while (0)
#define PG8_LDB(dst, b, h) do { _Pragma("unroll") for (int n = 0; n < 2; ++n) _Pragma("unroll") for (int k = 0; k < 2; ++k) dst[n][k] = *(const PG8_LAS bf16x8*)(lds + PG8_SB(b, h) + boff + n * 2048 + k * 1024); } while (0)
#define PG8_MMA(ai, bj, At, Bt) do { __builtin_amdgcn_s_setprio(1); _Pragma("unroll") for (int m = 0; m < 4; ++m) _Pragma("unroll") for (int n = 0; n < 2; ++n) _Pragma("unroll") for (int k = 0; k < 2; ++k) \
        acc[ai][bj][m][n] = __builtin_amdgcn_mfma_f32_16x16x32_bf16(Bt[n][k], At[m][k], acc[ai][bj][m][n], 0, 0, 0); __builtin_amdgcn_s_setprio(0); } while (0)
#define PG8_WAIT_V(n) asm volatile("s_waitcnt vmcnt(" #n ")" ::: "memory")
#define PG8_WAIT_L(n) asm volatile("s_waitcnt lgkmcnt(" #n ")" ::: "memory")
#define PG8_BAR __builtin_amdgcn_s_barrier()
#define PG8_SCHED __builtin_amdgcn_sched_barrier(0)
    Unit cur, nxt; int ui = 0;
    if (!S.next(0, cur)) return;
    f32x4 acc[2][2][4][2];
#pragma unroll
    for (int a = 0; a < 2; ++a)
#pragma unroll
        for (int b = 0; b < 2; ++b)
#pragma unroll
            for (int m = 0; m < 4; ++m)
#pragma unroll
                for (int n = 0; n < 2; ++n) acc[a][b][m][n] = (f32x4){0.f, 0.f, 0.f, 0.f};
    bf16x8 At[4][2], B0[2][2], B1[2][2];
    const char* cA = (const char*)g.A + (size_t)cur.pm * tstep; const char* cB = (const char*)g.Bt + (size_t)cur.pn * tstep;
    S.a_ready(cur);
    if constexpr (SP2) {
        PG8_STAGE(PG8_SB(0, 0), cB, voffB); PG8_STAGE(PG8_SB(0, 1), cB + hstep, voffB); PG8_STAGE(PG8_SA(0, 0), cA, voffA); PG8_STAGE(PG8_SA(0, 1), cA + hstep, voffA);
        if (wr == 1) PG8_BAR;
        PG8_WAIT_V(2); PG8_BAR;
        PG8_STAGE(PG8_SB(1, 0), cB + kstep, voffB); PG8_STAGE(PG8_SA(1, 0), cA + kstep, voffA); PG8_STAGE(PG8_SB(1, 1), cB + hstep + kstep, voffB);
        PG8_WAIT_V(6); PG8_BAR;
    } else {
        PG8_STAGE(PG8_SB(0, 0), cB, voffB); PG8_STAGE(PG8_SA(0, 0), cA, voffA); PG8_STAGE(PG8_SB(0, 1), cB + hstep, voffB); PG8_STAGE(PG8_SA(0, 1), cA + hstep, voffA);
        if (wr == 1) PG8_BAR;
        PG8_WAIT_V(4); PG8_BAR;
        PG8_STAGE(PG8_SB(1, 0), cB + kstep, voffB); PG8_STAGE(PG8_SA(1, 0), cA + kstep, voffA); PG8_STAGE(PG8_SB(1, 1), cB + hstep + kstep, voffB);
        PG8_WAIT_V(6); PG8_BAR;
    }
    for (;;) {
        const bool has_next = S.next(ui + 1, nxt);
        const char* nA = has_next ? (const char*)g.A + (size_t)nxt.pm * tstep : cA; const char* nB = has_next ? (const char*)g.Bt + (size_t)nxt.pn * tstep : cB;
        for (int t = 0; t < nt; t += 2) {
            const bool last = (t == nt - 2);
            const char* a1 = cA + (size_t)(t + 1) * kstep;
            const char* a2 = last ? nA : cA + (size_t)(t + 2) * kstep; const char* b2 = last ? nB : cB + (size_t)(t + 2) * kstep;
            const char* a3 = a2 + kstep; const char* b3 = b2 + kstep;
            if (last && has_next) S.a_ready(nxt);
            if constexpr (SP2) {
            PG8_LDB(B0, 0, 0); PG8_LDB(B1, 0, 1); PG8_SCHED; PG8_LDA(At, 0, 0); PG8_STAGE(PG8_SA(1, 1), a1 + hstep, voffA);
            PG8_WAIT_V(8); PG8_WAIT_L(0); PG8_BAR; PG8_MMA(0, 0, At, B0); PG8_MMA(0, 1, At, B1); PG8_BAR; PG8_SCHED;
            PG8_LDA(At, 0, 1); PG8_STAGE(PG8_SB(0, 0), b2, voffB); PG8_STAGE(PG8_SB(0, 1), b2 + hstep, voffB); PG8_STAGE(PG8_SA(0, 0), a2, voffA);
            PG8_WAIT_V(8); PG8_WAIT_L(0); PG8_BAR; PG8_MMA(1, 0, At, B0); PG8_MMA(1, 1, At, B1); PG8_BAR; PG8_SCHED;
            PG8_LDB(B0, 1, 0); PG8_LDB(B1, 1, 1); PG8_SCHED; PG8_LDA(At, 1, 0); PG8_STAGE(PG8_SA(0, 1), a2 + hstep, voffA);
            PG8_WAIT_V(8); PG8_WAIT_L(0); PG8_BAR; PG8_MMA(0, 0, At, B0); PG8_MMA(0, 1, At, B1); PG8_BAR; PG8_SCHED;
            PG8_LDA(At, 1, 1); PG8_STAGE(PG8_SB(1, 0), b3, voffB); PG8_STAGE(PG8_SB(1, 1), b3 + hstep, voffB); PG8_STAGE(PG8_SA(1, 0), a3, voffA);
            PG8_WAIT_V(8); PG8_WAIT_L(0); PG8_BAR; PG8_MMA(1, 0, At, B0); PG8_MMA(1, 1, At, B1); PG8_BAR; PG8_SCHED;
            } else {
            PG8_LDB(B0, 0, 0); PG8_SCHED; PG8_LDA(At, 0, 0); PG8_STAGE(PG8_SA(1, 1), a1 + hstep, voffA);
            PG8_WAIT_L(8); PG8_BAR; PG8_WAIT_L(0); PG8_MMA(0, 0, At, B0); PG8_BAR; PG8_SCHED;
            PG8_LDB(B1, 0, 1); PG8_STAGE(PG8_SB(0, 0), b2, voffB);
            PG8_BAR; PG8_WAIT_L(0); PG8_MMA(0, 1, At, B1); PG8_BAR;
            PG8_LDA(At, 0, 1); PG8_STAGE(PG8_SA(0, 0), a2, voffA);
            PG8_BAR; PG8_WAIT_L(0); PG8_MMA(1, 0, At, B0); PG8_BAR; PG8_SCHED;
            PG8_STAGE(PG8_SB(0, 1), b2 + hstep, voffB);
            PG8_WAIT_V(6); PG8_BAR; PG8_MMA(1, 1, At, B1); PG8_BAR;
            PG8_LDB(B0, 1, 0); PG8_SCHED; PG8_LDA(At, 1, 0); PG8_STAGE(PG8_SA(0, 1), a2 + hstep, voffA);
            PG8_WAIT_L(8); PG8_BAR; PG8_WAIT_L(0); PG8_MMA(0, 0, At, B0); PG8_BAR; PG8_SCHED;
            PG8_LDB(B1, 1, 1); PG8_STAGE(PG8_SB(1, 0), b3, voffB);
            PG8_BAR; PG8_WAIT_L(0); PG8_MMA(0, 1, At, B1); PG8_BAR;
            PG8_LDA(At, 1, 1); PG8_STAGE(PG8_SA(1, 0), a3, voffA);
            PG8_BAR; PG8_WAIT_L(0); PG8_MMA(1, 0, At, B0); PG8_BAR; PG8_SCHED;
            PG8_STAGE(PG8_SB(1, 1), b3 + hstep, voffB);
            PG8_WAIT_V(6); PG8_BAR; PG8_MMA(1, 1, At, B1); PG8_BAR;
            }
        }
        if constexpr (ALIGN_EPI) { if (wr == 0) PG8_BAR; }
        if constexpr (!Epi::AFTER_DRAIN) { E(acc, cur, wr, wc, fr, fq); S.done(cur); }
        if (!has_next) break;
#pragma unroll
        for (int a = 0; a < 2; ++a)
#pragma unroll
            for (int b = 0; b < 2; ++b)
#pragma unroll
                for (int m = 0; m < 4; ++m)
#pragma unroll
                    for (int n = 0; n < 2; ++n) acc[a][b][m][n] = (f32x4){0.f, 0.f, 0.f, 0.f};
        cur = nxt; cA = nA; cB = nB; ++ui;
        if constexpr (ALIGN_EPI) { if (wr == 1) PG8_BAR; }
    }
    PG8_WAIT_V(0);
    if constexpr (!ALIGN_EPI) { if (wr == 0) PG8_BAR; }
    PG8_BAR;
    if constexpr (Epi::AFTER_DRAIN) { E.fused(acc, cur, wr, wc, fr, fq, lds, wid, lane); S.done(cur); }
#undef PG8_SA
#undef PG8_SB
#undef PG8_STAGE
#undef PG8_LDA
#undef PG8_LDB
#undef PG8_MMA
#undef PG8_WAIT_V
#undef PG8_WAIT_L
#undef PG8_BAR
#undef PG8_SCHED
}
}

#define LAS __attribute__((address_space(3)))
typedef unsigned short bf16;
typedef short bf16x8 __attribute__((ext_vector_type(8)));
typedef short s16x4 __attribute__((ext_vector_type(4)));
typedef float f32x4 __attribute__((ext_vector_type(4)));
typedef unsigned u32x4 __attribute__((ext_vector_type(4)));
typedef unsigned u32x2 __attribute__((ext_vector_type(2)));
#define MFMA16(a, b, c) __builtin_amdgcn_mfma_f32_16x16x32_bf16((a), (b), (c), 0, 0, 0)

constexpr int T = 32768, D = 1024, SEQ = 8192, NTHR = 512;
constexpr int LDS_BYTES = 163840, XCH_OFF = 131072;
constexpr size_t MiB = 1u << 20;
constexpr size_t WS_W = 0;
constexpr size_t W_IN = 0, W_SOUT = W_IN + (size_t)6400 * 1024, W_FIN0 = W_SOUT + (size_t)1024 * 2048, W_FIN1 = W_FIN0 + (size_t)5632 * 1024,
                 W_FOUT0 = W_FIN1 + (size_t)5632 * 1024, W_FOUT1 = W_FOUT0 + (size_t)1024 * 2816, W_K = W_FOUT1 + (size_t)1024 * 2816, W_V = W_K + 1048576, W_Q = W_V + 1048576,
                 W_O = W_Q + 1048576, W_END = W_O + 1048576;
static_assert(W_END * 2 <= 58 * MiB, "weights fit");
constexpr size_t WS_MODS = 58 * MiB;
constexpr size_t WS_SUMSQ = 59 * MiB;
constexpr size_t WS_FLAGS = 60 * MiB;
constexpr size_t WS_BAR = 61 * MiB;
constexpr size_t WS_X = 64 * MiB;
constexpr size_t WS_BIG = 192 * MiB;
constexpr size_t WS_END = 448 * MiB;
constexpr int MOD_L = 6144, MOD_KV = 12288, MOD_FIN = 14336, MOD_N = 16384;

#ifdef PROBE
#define STAMP(k) do { if (blockIdx.x == 0 && threadIdx.x == 0) { __threadfence(); TS[k] = __builtin_amdgcn_s_memrealtime(); __threadfence(); } } while (0)
#else
#define STAMP(k) do {} while (0)
#endif
struct Params { const float* in[28]; float* out; unsigned char* ws; };

__device__ __forceinline__ float bf2f(unsigned u) { return __uint_as_float(u << 16); }
typedef float f32x2_t __attribute__((ext_vector_type(2))); typedef __bf16 bf16x2_t __attribute__((ext_vector_type(2)));
__device__ __forceinline__ unsigned pk2(float lo, float hi) { f32x2_t v = {lo, hi}; bf16x2_t b = __builtin_convertvector(v, bf16x2_t); return __builtin_bit_cast(unsigned, b); }
__device__ __forceinline__ unsigned f2bf(float f) { return pk2(f, 0.f) & 0xffffu; }
__device__ __forceinline__ float wave_sum(float v) {
#pragma unroll
    for (int o = 1; o < 64; o <<= 1) v += __shfl_xor(v, o);
    return v;
}
using pg8::silu_f; using pg8::softplus_f;

__device__ __forceinline__ void p0_item(const float* W, int K, int Nsrc, bf16* WT, int dst_n0, int src_n0, int k0, LAS float* scr, int lane) {
    const int c = lane & 7;
    if (src_n0 < 0) {
#pragma unroll
        for (int j = 0; j < 4; ++j) { const int n = (lane >> 3) + 8 * j; *(u32x4*)(WT + (size_t)(dst_n0 + n) * K + k0 + 8 * c) = (u32x4){0u, 0u, 0u, 0u}; }
        return;
    }
#pragma unroll 8
    for (int i = 0; i < 32; ++i) { const int kk = 2 * i + (lane >> 5); scr[kk * 33 + (lane & 31)] = __builtin_nontemporal_load(W + (size_t)(k0 + kk) * Nsrc + src_n0 + (lane & 31)); }
    asm volatile("s_waitcnt lgkmcnt(0)" ::: "memory");
#pragma unroll
    for (int j = 0; j < 4; ++j) { const int n = (lane >> 3) + 8 * j; const LAS float* s = scr + (8 * c) * 33 + n;
        u32x4 o; o.x = pk2(s[0 * 33], s[1 * 33]); o.y = pk2(s[2 * 33], s[3 * 33]); o.z = pk2(s[4 * 33], s[5 * 33]); o.w = pk2(s[6 * 33], s[7 * 33]);
        *(u32x4*)(WT + (size_t)(dst_n0 + n) * K + k0 + 8 * c) = o; }
    asm volatile("s_waitcnt lgkmcnt(0)" ::: "memory");
}
__device__ __forceinline__ void p0_phase(const Params& p, LAS unsigned char* L) {
    const int tid = threadIdx.x, lane = tid & 63, wave = __builtin_amdgcn_readfirstlane(tid >> 6);
    bf16* WB = (bf16*)(p.ws + WS_W);
    float* MODS = (float*)(p.ws + WS_MODS); float* SUMSQ = (float*)(p.ws + WS_SUMSQ);
    if (blockIdx.x == 0 && tid < 64) ((unsigned*)(p.ws + WS_FLAGS))[tid] = 0u;
    LAS float* cs = (LAS float*)L; LAS float* part = (LAS float*)(L + 16384);
    for (int i = tid; i < 4096; i += NTHR) cs[i] = silu_f(p.in[1][i]);
    __syncthreads();
    for (int jb = blockIdx.x; jb < MOD_N / 64; jb += gridDim.x) {
        const int j = jb * 64 + lane; const float* Wsrc; const float* bsrc; int stride, jj;
        if (j < MOD_KV) { const int l = j / MOD_L; jj = j - l * MOD_L; Wsrc = p.in[2] + (size_t)l * D * MOD_L; bsrc = p.in[3] + l * MOD_L; stride = MOD_L; }
        else if (j < MOD_FIN) { jj = j - MOD_KV; Wsrc = p.in[14]; bsrc = p.in[15]; stride = 2048; }
        else { jj = j - MOD_FIN; Wsrc = p.in[25]; bsrc = p.in[26]; stride = 2048; }
        float a0 = 0.f, a1 = 0.f, a2 = 0.f, a3 = 0.f;
#pragma unroll 8
        for (int k = wave * 128; k < wave * 128 + 128; ++k) { const float wv = __builtin_nontemporal_load(Wsrc + (size_t)k * stride + jj); a0 += cs[k] * wv; a1 += cs[1024 + k] * wv; a2 += cs[2048 + k] * wv; a3 += cs[3072 + k] * wv; }
        part[(wave * 4 + 0) * 64 + lane] = a0; part[(wave * 4 + 1) * 64 + lane] = a1; part[(wave * 4 + 2) * 64 + lane] = a2; part[(wave * 4 + 3) * 64 + lane] = a3;
        __syncthreads();
        if (tid < 256) { const int b = tid >> 6; float s = 0.f;
#pragma unroll
            for (int w = 0; w < 8; ++w) s += part[(w * 4 + b) * 64 + lane];
            MODS[(size_t)b * MOD_N + j] = s + bsrc[jj]; }
        __syncthreads();
    }
    LAS float* scr = (LAS float*)(L + wave * 16384);
    const int gw = blockIdx.x * 8 + wave, NGW = gridDim.x * 8;
    constexpr int NI0 = 16 * 200, NI1 = 32 * 32, NI2 = 16 * 176, NI3 = 44 * 32, NI4 = 16 * 32;
    constexpr int NITEMS = NI0 + NI1 + 2 * NI2 + 2 * NI3 + 4 * NI4;
    for (int it = gw; it < NITEMS; it += NGW) {
        int r = it;
        if (r < NI0) { const int kb = r / 200, nb = r % 200; const int dn = nb * 32; const int sn = dn < 2048 ? dn : dn < 2080 ? 6144 + (dn - 2048) : dn < 2304 ? -1 : 2048 + (dn - 2304); p0_item(p.in[6], 1024, 6176, WB + W_IN, dn, sn, kb * 64, scr, lane); continue; } r -= NI0;
        if (r < NI1) { const int kb = r / 32, nb = r % 32; p0_item(p.in[13], 2048, 1024, WB + W_SOUT, nb * 32, nb * 32, kb * 64, scr, lane); continue; } r -= NI1;
        if (r < 2 * NI2) { const int l = r / NI2; r -= l * NI2; const int kb = r / 176, nb = r % 176; const int dn = nb * 32; const int sn = (dn >> 8) * 128 + (dn & 127) + ((dn & 255) >= 128 ? 2816 : 0);
            p0_item(p.in[21] + (size_t)l * 1024 * 5632, 1024, 5632, WB + (l ? W_FIN1 : W_FIN0), dn, sn, kb * 64, scr, lane); continue; } r -= 2 * NI2;
        if (r < 2 * NI3) { const int l = r / NI3; r -= l * NI3; const int kb = r / 32, nb = r % 32;
            p0_item(p.in[24] + (size_t)l * 2816 * 1024, 2816, 1024, WB + (l ? W_FOUT1 : W_FOUT0), nb * 32, nb * 32, kb * 64, scr, lane); continue; } r -= 2 * NI3;
        { const int q = r / NI4; r -= q * NI4; const int kb = r / 32, nb = r % 32; const float* src = q == 0 ? p.in[17] : q == 1 ? p.in[18] : q == 2 ? p.in[19] : p.in[20];
            bf16* dst = WB + (q == 0 ? W_K : q == 1 ? W_V : q == 2 ? W_Q : W_O);
            p0_item(src, 1024, 1024, dst, nb * 32, nb * 32, kb * 64, scr, lane); }
    }
}

template <int NOUT, bool F32OUT>
__device__ __forceinline__ void norm_phase(const float* X, const float* g0, const float* mod0, void* out0, const float* g1, const float* mod1, void* out1) {
    int tid_ = threadIdx.x; asm volatile("" : "+v"(tid_));
    const int tid = tid_, lane = tid & 63, wave = tid >> 6;
    const int gw = blockIdx.x * 8 + wave, NGW = gridDim.x * 8;
    for (int row = gw; row < T; row += NGW) {
        const int b = row >> 13;
        const f32x4* xr = (const f32x4*)(X + (size_t)row * D) + lane;
        f32x4 v[4]; float s = 0.f;
#pragma unroll
        for (int j = 0; j < 4; ++j) { v[j] = __builtin_nontemporal_load(xr + 64 * j); s += (v[j].x * v[j].x + v[j].y * v[j].y) + (v[j].z * v[j].z + v[j].w * v[j].w); }
        const float rstd = rsqrtf(wave_sum(s) * (1.f / D) + 1e-6f);
#pragma unroll
        for (int o = 0; o < NOUT; ++o) {
            const float* g = o ? g1 : g0; const float* md = (o ? mod1 : mod0) + (size_t)b * MOD_N; void* out = o ? out1 : out0;
#pragma unroll
            for (int j = 0; j < 4; ++j) { const int col = 4 * lane + 256 * j;
                const f32x4 gv = *(const f32x4*)(g + col), sh = *(const f32x4*)(md + col), sc = *(const f32x4*)(md + 1024 + col);
                const f32x4 y = v[j] * rstd * gv * (sc + 1.0f) + sh;
                if (F32OUT) *(f32x4*)((float*)out + (size_t)row * D + col) = y;
                else { u32x2 w; w.x = pk2(y.x, y.y); w.y = pk2(y.z, y.w); *(u32x2*)((bf16*)out + (size_t)row * D + col) = w; } }
        }
    }
}

template <int NOUT, bool F32OUT>
__device__ __forceinline__ void norm_phase_b(const bf16* X, const float* g0, const float* mod0, void* out0, const float* g1, const float* mod1, void* out1) {
    int tid_ = threadIdx.x; asm volatile("" : "+v"(tid_));
    const int tid = tid_, lane = tid & 63, wave = tid >> 6;
    const int gw = blockIdx.x * 8 + wave, NGW = gridDim.x * 8;
    for (int row = gw; row < T; row += NGW) {
        const int b = row >> 13;
        float v[2][8]; float s = 0.f;
#pragma unroll
        for (int j = 0; j < 2; ++j) { const u32x4 xb = *(const u32x4*)(X + (size_t)row * D + 8 * lane + 512 * j);
#pragma unroll
            for (int e = 0; e < 4; ++e) { v[j][2 * e] = __uint_as_float(xb[e] << 16); v[j][2 * e + 1] = __uint_as_float(xb[e] & 0xffff0000u); }
#pragma unroll
            for (int e = 0; e < 8; ++e) s += v[j][e] * v[j][e]; }
        const float rstd = rsqrtf(wave_sum(s) * (1.f / D) + 1e-6f);
#pragma unroll
        for (int o = 0; o < NOUT; ++o) {
            const float* g = o ? g1 : g0; const float* md = (o ? mod1 : mod0) + (size_t)b * MOD_N; void* out = o ? out1 : out0;
#pragma unroll
            for (int j = 0; j < 2; ++j) { const int col = 8 * lane + 512 * j; float y[8];
#pragma unroll
                for (int q = 0; q < 2; ++q) { const f32x4 gv = *(const f32x4*)(g + col + 4 * q), sh = *(const f32x4*)(md + col + 4 * q), sc = *(const f32x4*)(md + 1024 + col + 4 * q);
#pragma unroll
                    for (int e = 0; e < 4; ++e) y[4 * q + e] = v[j][4 * q + e] * rstd * gv[e] * (sc[e] + 1.0f) + sh[e]; }
                if (F32OUT) { *(f32x4*)((float*)out + (size_t)row * D + col) = (f32x4){y[0], y[1], y[2], y[3]}; *(f32x4*)((float*)out + (size_t)row * D + col + 4) = (f32x4){y[4], y[5], y[6], y[7]}; }
                else { u32x4 w; w.x = pk2(y[0], y[1]); w.y = pk2(y[2], y[3]); w.z = pk2(y[4], y[5]); w.w = pk2(y[6], y[7]); *(u32x4*)((bf16*)out + (size_t)row * D + col) = w; } }
        }
    }
}

__device__ __forceinline__ void fixup_mamba(const float* P, const float* UH, const float* cw, const float* cb, bf16* XBC) {
    const int total = 128 * 3 * 4096;
    for (int i = blockIdx.x * NTHR + threadIdx.x; i < total; i += gridDim.x * NTHR) {
        const int ch = i & 4095, r = (i >> 12) % 3, pm = i / (3 * 4096); const int c = ch;
        float v = P[((size_t)pm * 3 + r) * 4096 + c];
        if (pm & 31) { for (int k = r + 1; k <= 3; ++k) v += cw[(3 - k) * 4096 + ch] * UH[((size_t)(pm - 1) * 3 + (3 + r - k)) * 4096 + c]; }
        XBC[(size_t)(pm * 256 + r) * 4096 + ch] = (bf16)f2bf(silu_f(v));
    }
}
__device__ __forceinline__ void fixup_ffn(const float* P, const float* UH, const float* cw, const float* cb, bf16* G) {
    const int total = 128 * 2 * 2816;
    for (int i = blockIdx.x * NTHR + threadIdx.x; i < total; i += gridDim.x * NTHR) {
        const int j = i % 2816, r = (i / 2816) & 1, pm = i / (2 * 2816); const int cg_ = (j >> 7) * 256 + (j & 127), cv_ = cg_ + 128;
        float g = P[((size_t)pm * 2 + r) * 5632 + cg_], v = P[((size_t)pm * 2 + r) * 5632 + cv_];
        if (pm & 31) { for (int k = r + 1; k <= 2; ++k) { const size_t ro = ((size_t)(pm - 1) * 2 + (2 + r - k)) * 5632;
            g += cw[(2 - k) * 5632 + j] * UH[ro + cg_]; v += cw[(2 - k) * 5632 + 2816 + j] * UH[ro + cv_]; } }
        G[(size_t)(pm * 256 + r) * 2816 + j] = (bf16)f2bf(silu_f(g) * v);
    }
}

constexpr int SSD_CS = 0, SSD_BS = 34816, SSD_XT = 69632, SSD_XDT = 78336, SSD_HS0 = 87040, SSD_HS1 = 95744, SSD_ACS = 104448, SSD_WSCR = 104960;
__device__ __forceinline__ void acs_phase(const float* DT, const float* a_log, float* ACS) {
    const int lane = threadIdx.x & 63, wave = threadIdx.x >> 6;
    const int h = lane & 31, sub = lane >> 5; const float A = -__expf(a_log[h]);
    for (int task = blockIdx.x * 8 + wave; task < 256; task += gridDim.x * 8) {
        const size_t tok0 = (size_t)task * 128 + sub * 64;
        float s = 0.f;
#pragma unroll 8
        for (int i = 0; i < 64; ++i) s += DT[(tok0 + i) * 32 + h] * A;
        const float s0 = __shfl(s, h);
        float run = sub ? s0 : 0.f;
#pragma unroll 8
        for (int i = 0; i < 64; ++i) { run += DT[(tok0 + i) * 32 + h] * A; ACS[(tok0 + i) * 32 + h] = run; }
    }
}
template <int LT> __device__ __forceinline__ void ssd_diag(const LAS bf16* Bs, const LAS bf16* XTs, const LAS float* acs_s, const bf16x8 (&cf)[4], float acs_l, int r16, int quad, f32x4 (&Yd)[2]) {
#pragma unroll
    for (int t = 0; t <= (LT >> 1); ++t) {
        f32x4 mm[2];
#pragma unroll
        for (int hf = 0; hf < 2; ++hf) { const int st = 2 * t + hf; mm[hf] = (f32x4){0.f, 0.f, 0.f, 0.f};
            if (st <= LT) { f32x4 acc = (f32x4){0.f, 0.f, 0.f, 0.f};
#pragma unroll
                for (int ks = 0; ks < 4; ++ks) { const bf16x8 af = *(const LAS bf16x8*)(Bs + (16 * st + r16) * 136 + ks * 32 + quad * 8); acc = MFMA16(af, cf[ks], acc); }
                const f32x4 as4 = *(const LAS f32x4*)(acs_s + 16 * st + 4 * quad);
#pragma unroll
                for (int j = 0; j < 4; ++j) { const float v = acc[j] * __expf(acs_l - as4[j]); mm[hf][j] = (st == LT && (4 * quad + j > r16)) ? 0.f : v; } } }
        u32x4 mp; mp.x = pk2(mm[0][0], mm[0][1]); mp.y = pk2(mm[0][2], mm[0][3]); mp.z = pk2(mm[1][0], mm[1][1]); mp.w = pk2(mm[1][2], mm[1][3]);
        const bf16x8 mf = __builtin_bit_cast(bf16x8, mp);
#pragma unroll
        for (int pt = 0; pt < 2; ++pt) { const LAS bf16* xp = XTs + (16 * pt + r16) * 136 + 32 * t + 4 * quad;
            const u32x2 lo = *(const LAS u32x2*)xp, hi = *(const LAS u32x2*)(xp + 16);
            const bf16x8 xf = __builtin_bit_cast(bf16x8, ((u32x4){lo.x, lo.y, hi.x, hi.y}));
            Yd[pt] = MFMA16(mf, xf, Yd[pt]); }
    }
}
__device__ __forceinline__ void ssreduce_phase(const float* PS, float* RS) {
    for (int t = blockIdx.x * NTHR + threadIdx.x; t < T; t += gridDim.x * NTHR) { float s = 0.f;
#pragma unroll 16
        for (int q = 0; q < 64; ++q) s += PS[(size_t)q * T + t];
        RS[t] = rsqrtf(s * (1.0f / 2048.0f) + 1e-6f); }
}
template <bool REAL, int MODE = 15> __device__ __forceinline__ void ssd_phase(const bf16* XBC, bf16* Zb, const float* DT, const float* ACS, const float* a_log, const float* d_skip, const float* normg, float* SUMSQ, LAS unsigned char* L) {
    int tid_ = threadIdx.x; asm volatile("" : "+v"(tid_));
    const int tid = tid_, lane = tid & 63, w = __builtin_amdgcn_readfirstlane(tid >> 6), r16 = lane & 15, quad = lane >> 4;
    LAS bf16* Cs = (LAS bf16*)(L + SSD_CS); LAS bf16* Bs = (LAS bf16*)(L + SSD_BS); LAS bf16* XTs = (LAS bf16*)(L + SSD_XT); LAS bf16* XDs = (LAS bf16*)(L + SSD_XDT);
    LAS float* acs_s = (LAS float*)(L + SSD_ACS);
    LAS bf16* Wx = (LAS bf16*)(L + SSD_WSCR + w * 3840); LAS bf16* Wz = Wx + 640; LAS bf16* Wy = Wx + 1280;
    const int lt = w < 4 ? w : 11 - w;
    const int vcu = (gridDim.x == 256) ? (int)((blockIdx.x & 7) * 32 + (blockIdx.x >> 3)) : (int)blockIdx.x;
    for (int unit = vcu; unit < 256; unit += gridDim.x) {
        const int b = unit >> 6, h = (unit >> 1) & 31, ph = unit & 1, g = h >> 2;
        const float Dh = d_skip[h];
        const int xcol = h * 64 + ph * 32;
        const float ng0 = normg[xcol + r16], ng1 = normg[xcol + 16 + r16];
        for (int i = tid; i < 8704 / 4; i += NTHR) ((LAS unsigned*)(L + SSD_HS0))[i] = 0u;
        f32x4 Hst[2][2]; Hst[0][0] = Hst[0][1] = Hst[1][0] = Hst[1][1] = (f32x4){0.f, 0.f, 0.f, 0.f};
        int hb = 0;
        const int srow = tid >> 4, sg = tid & 15, lr = lane >> 2, part = lane & 3, lx = 16 * lt + lr;
        u32x4 cv[4], bv[4], xv, zv; float dtl, acl, aclast, a01;
#define SSD_LOAD(c_) do { const size_t tk = (size_t)b * SEQ + (size_t)(c_) * 128; \
            _Pragma("unroll") for (int i = 0; i < 4; ++i) { const bf16* src = XBC + (tk + srow + 32 * i) * 4096 + g * 128 + sg * 8; cv[i] = *(const u32x4*)(src + 3072); bv[i] = *(const u32x4*)(src + 2048); } \
            xv = *(const u32x4*)(XBC + (tk + lx) * 4096 + xcol + part * 8); zv = *(const u32x4*)(Zb + (tk + lx) * 2048 + xcol + part * 8); \
            dtl = DT[(tk + lx) * 32 + h]; acl = ACS[(tk + lx) * 32 + h]; aclast = ACS[(tk + 127) * 32 + h]; a01 = ACS[(tk + 2 * w * 0 + (tid & 127)) * 32 + h]; } while (0)
        SSD_LOAD(0);
        for (int c = 0; c < 64; ++c) {
            const size_t tok0 = (size_t)b * SEQ + (size_t)c * 128;
#pragma unroll
            for (int i = 0; i < 4; ++i) { const int l = srow + 32 * i; *(LAS u32x4*)(Cs + l * 136 + sg * 8) = cv[i]; *(LAS u32x4*)(Bs + l * 136 + sg * 8) = bv[i]; }
            if (tid < 128) acs_s[tid] = a01;
            const float acs_last = aclast;
            { const float dec = __expf(acs_last - acl);
                *(LAS u32x4*)(Wx + lr * 40 + part * 8) = xv; *(LAS u32x4*)(Wz + lr * 40 + part * 8) = zv;
#pragma unroll
                for (int e = 0; e < 8; ++e) { const unsigned xb = (xv[e >> 1] >> (16 * (e & 1))) & 0xffffu; const float xd = bf2f(xb) * dtl;
                    XTs[(part * 8 + e) * 136 + lx] = (bf16)f2bf(xd); XDs[(part * 8 + e) * 136 + lx] = (bf16)f2bf(xd * dec); } }
            __syncthreads();
            if (c < 63) SSD_LOAD(c + 1);
            __builtin_amdgcn_sched_barrier(0);
            bf16x8 cf[4];
#pragma unroll
            for (int ks = 0; ks < 4; ++ks) cf[ks] = *(const LAS bf16x8*)(Cs + (16 * lt + r16) * 136 + ks * 32 + quad * 8);
            const float acs_l = acs_s[16 * lt + r16];
            f32x4 Yd[2], Yo[2]; Yd[0] = Yd[1] = Yo[0] = Yo[1] = (f32x4){0.f, 0.f, 0.f, 0.f};
            if constexpr ((MODE & 1) != 0)
            switch (lt) {
                case 0: ssd_diag<0>(Bs, XTs, acs_s, cf, acs_l, r16, quad, Yd); break; case 1: ssd_diag<1>(Bs, XTs, acs_s, cf, acs_l, r16, quad, Yd); break;
                case 2: ssd_diag<2>(Bs, XTs, acs_s, cf, acs_l, r16, quad, Yd); break; case 3: ssd_diag<3>(Bs, XTs, acs_s, cf, acs_l, r16, quad, Yd); break;
                case 4: ssd_diag<4>(Bs, XTs, acs_s, cf, acs_l, r16, quad, Yd); break; case 5: ssd_diag<5>(Bs, XTs, acs_s, cf, acs_l, r16, quad, Yd); break;
                case 6: ssd_diag<6>(Bs, XTs, acs_s, cf, acs_l, r16, quad, Yd); break; default: ssd_diag<7>(Bs, XTs, acs_s, cf, acs_l, r16, quad, Yd); break; }
            if constexpr ((MODE & 2) != 0)
            { const LAS bf16* Hc = (const LAS bf16*)(L + (hb ? SSD_HS1 : SSD_HS0));
#pragma unroll
                for (int pt = 0; pt < 2; ++pt)
#pragma unroll
                    for (int ks = 0; ks < 4; ++ks) { const bf16x8 hf = *(const LAS bf16x8*)(Hc + (16 * pt + r16) * 136 + ks * 32 + quad * 8); Yo[pt] = MFMA16(cf[ks], hf, Yo[pt]); } }
            if constexpr ((MODE & 4) != 0) {
            float ssq[4] = {0.f, 0.f, 0.f, 0.f};
            { const f32x4 al4 = *(const LAS f32x4*)(acs_s + 16 * lt + 4 * quad);
#pragma unroll
            for (int j = 0; j < 4; ++j) { const int lrow = 4 * quad + j; const float el = __expf(al4[j]);
#pragma unroll
                for (int pt = 0; pt < 2; ++pt) { const int pcol = 16 * pt + r16;
                    float y = Yd[pt][j] + el * Yo[pt][j];
                    y += Dh * bf2f(Wx[lrow * 40 + pcol]);
                    const float gz = y * silu_f(bf2f(Wz[lrow * 40 + pcol])); ssq[j] += gz * gz;
                    Wy[lrow * 40 + pcol] = (bf16)f2bf(gz * (pt ? ng1 : ng0)); } } }
#pragma unroll
            for (int j = 0; j < 4; ++j) { float v = ssq[j]; v += __shfl_xor(v, 1); v += __shfl_xor(v, 2); v += __shfl_xor(v, 4); v += __shfl_xor(v, 8); ssq[j] = v; }
            { const float sv = r16 == 0 ? ssq[0] : r16 == 1 ? ssq[1] : r16 == 2 ? ssq[2] : ssq[3];
                if (r16 < 4) SUMSQ[(size_t)(h * 2 + ph) * T + tok0 + 16 * lt + 4 * quad + r16] = sv; }
            asm volatile("s_waitcnt lgkmcnt(0)" ::: "memory");
            { const u32x4 yv = *(const LAS u32x4*)(Wy + lr * 40 + part * 8);
                if (REAL) *(u32x4*)(Zb + (tok0 + 16 * lt + lr) * 2048 + xcol + part * 8) = yv; }
            } else { if (Yd[0][0] + Yd[1][0] + Yo[0][0] + Yo[1][0] == 12345.f) Wy[0] = 1; }
            if (((MODE & 8) != 0) && w < 4) {
                f32x4 a4[2][2];
#pragma unroll
                for (int q = 0; q < 2; ++q) a4[q][0] = a4[q][1] = (f32x4){0.f, 0.f, 0.f, 0.f};
#pragma unroll
                for (int ks = 0; ks < 4; ++ks) { bf16x8 af[2];
#pragma unroll
                    for (int pt = 0; pt < 2; ++pt) af[pt] = *(const LAS bf16x8*)(XDs + (16 * pt + r16) * 136 + ks * 32 + quad * 8);
#pragma unroll
                    for (int q = 0; q < 2; ++q) { bf16x8 bfr;
#pragma unroll
                        for (int j = 0; j < 8; ++j) bfr[j] = (short)Bs[(ks * 32 + quad * 8 + j) * 136 + 16 * (2 * w + q) + r16];
#pragma unroll
                        for (int pt = 0; pt < 2; ++pt) a4[q][pt] = MFMA16(af[pt], bfr, a4[q][pt]); } }
                const float cd = __expf(acs_last);
                LAS bf16* Hn = (LAS bf16*)(L + (hb ? SSD_HS0 : SSD_HS1));
#pragma unroll
                for (int q = 0; q < 2; ++q)
#pragma unroll
                    for (int pt = 0; pt < 2; ++pt)
#pragma unroll
                        for (int j = 0; j < 4; ++j) { const float hv = Hst[q][pt][j] * cd + a4[q][pt][j]; Hst[q][pt][j] = hv; Hn[(16 * pt + 4 * quad + j) * 136 + 16 * (2 * w + q) + r16] = (bf16)f2bf(hv); }
            }
            hb ^= 1;
            __syncthreads();
        }
#undef SSD_LOAD
    }
}

constexpr int AT_KS = 0, AT_VS = 18432, AT_SMAX = 35840;
template <bool DIAG, int NKT> __device__ __forceinline__ float att_elem(f32x4 (&S)[8], float suffix, int q_rel, int quad) {
    f32x4 Lg[8];
#pragma unroll
    for (int kt = 0; kt < NKT; ++kt) { const f32x4 y = S[kt]; f32x4 sp;
#pragma unroll
        for (int j = 0; j < 4; ++j) sp[j] = __builtin_amdgcn_logf(1.0f + __builtin_amdgcn_exp2f(-__builtin_fabsf(y[j])));
        f32x4 lg = -(sp + __builtin_elementwise_max(y, (f32x4){0.f, 0.f, 0.f, 0.f}));
        if (DIAG) {
#pragma unroll
            for (int j = 0; j < 4; ++j) if (!(16 * kt + 4 * quad + j < q_rel)) lg[j] = 0.f; }
        lg[2] += lg[3]; lg[1] += lg[2]; lg[0] += lg[1]; Lg[kt] = lg; }
    float tail = 0.f;
#pragma unroll
    for (int kt = NKT - 1; kt >= 0; --kt) { const float a = Lg[kt][0]; const float bq = __shfl_xor(a, 16), cq = __shfl_xor(a, 32), dq = __shfl_xor(bq, 32);
        const float E = quad == 0 ? (bq + cq + dq) : quad == 1 ? (cq + dq) : quad == 2 ? bq : 0.f;
        Lg[kt] = Lg[kt] + (E + tail);
        tail += (a + bq) + (cq + dq); }
#pragma unroll
    for (int kt = 0; kt < NKT; ++kt) { const f32x4 lw = (S[kt] + Lg[kt]) + suffix;
#pragma unroll
        for (int j = 0; j < 4; ++j) { float wv = __builtin_amdgcn_exp2f(lw[j]); if (DIAG && !(16 * kt + 4 * quad + j < q_rel)) wv = 0.f; S[kt][j] = wv; } }
    return tail;
}
template <bool DIAG, int NKT> __device__ __forceinline__ float att_block(const LAS bf16* Ks, const LAS bf16* Vs, const bf16x8 (&qf)[2], f32x4 (&O)[4], float suffix, int q_rel, int r16, int quad) {
    f32x4 S[8];
#pragma unroll
    for (int kt = 0; kt < 8; ++kt) S[kt] = (f32x4){0.f, 0.f, 0.f, 0.f};
#pragma unroll
    for (int kt = 0; kt < NKT; ++kt)
#pragma unroll
        for (int ks = 0; ks < 2; ++ks) { const bf16x8 kf = *(const LAS bf16x8*)(Ks + (16 * kt + r16) * 72 + ks * 32 + quad * 8); S[kt] = MFMA16(kf, qf[ks], S[kt]); }
    const float tail = att_elem<DIAG, NKT>(S, suffix, q_rel, quad);
#pragma unroll
    for (int t = 0; t < (NKT + 1) / 2; ++t) { u32x4 wp; wp.x = pk2(S[2 * t][0], S[2 * t][1]); wp.y = pk2(S[2 * t][2], S[2 * t][3]); wp.z = pk2(S[2 * t + 1][0], S[2 * t + 1][1]); wp.w = pk2(S[2 * t + 1][2], S[2 * t + 1][3]);
        const bf16x8 wf = __builtin_bit_cast(bf16x8, wp);
#pragma unroll
        for (int dt = 0; dt < 4; ++dt) { const LAS bf16* vp = Vs + (16 * dt + r16) * 136 + 32 * t + 4 * quad;
            const u32x2 lo = *(const LAS u32x2*)vp, hi = *(const LAS u32x2*)(vp + 16);
            const bf16x8 vf = __builtin_bit_cast(bf16x8, ((u32x4){lo.x, lo.y, hi.x, hi.y}));
            O[dt] = MFMA16(wf, vf, O[dt]); } }
    return tail;
}
template <bool REAL> __device__ __forceinline__ void attn_phase(bf16* QO, const bf16* Kb, const bf16* VT, LAS unsigned char* L) {
    int tid_ = threadIdx.x; asm volatile("" : "+v"(tid_));
    const int tid = tid_, lane = tid & 63, w = __builtin_amdgcn_readfirstlane(tid >> 6), r16 = lane & 15, quad = lane >> 4;
    LAS bf16* Ks = (LAS bf16*)(L + AT_KS); LAS bf16* Vs = (LAS bf16*)(L + AT_VS); LAS float* smax_s = (LAS float*)(L + AT_SMAX);
    const int ks_s = tid >> 2, ks_p = tid & 3, vs_d = tid >> 3, vs_p = tid & 7;
    u32x4 pk0, pk1, pv0, pv1; bf16x8 qn[2];
#define ATT_LOAD(b_, h_, kb_) do { const bf16* src = Kb + ((size_t)(b_) * SEQ + (kb_) * 128 + ks_s) * 1024 + (h_) * 64 + ks_p * 16; pk0 = *(const u32x4*)src; pk1 = *(const u32x4*)(src + 8); \
        const bf16* vsrc = VT + (size_t)((h_) * 64 + vs_d) * T + (size_t)(b_) * SEQ + (kb_) * 128 + vs_p * 16; pv0 = *(const u32x4*)vsrc; pv1 = *(const u32x4*)(vsrc + 8); } while (0)
#define ATT_QLOAD(b_, h_, qb_) do { const size_t rq_ = (size_t)(b_) * SEQ + (qb_) * 128 + 16 * w; \
        _Pragma("unroll") for (int ks = 0; ks < 2; ++ks) qn[ks] = *(const bf16x8*)(QO + (rq_ + r16) * 1024 + (h_) * 64 + ks * 32 + quad * 8); } while (0)
    if ((int)blockIdx.x < 4096) { const int u0 = blockIdx.x, bh0 = u0 & 63, qb0 = 63 - (u0 >> 6); ATT_QLOAD(bh0 >> 4, bh0 & 15, qb0); ATT_LOAD(bh0 >> 4, bh0 & 15, qb0); }
    for (int unit = blockIdx.x; unit < 4096; unit += gridDim.x) {
        const int bh = unit & 63, qb = 63 - (unit >> 6), b = bh >> 4, h = bh & 15;
        const size_t rowq = (size_t)b * SEQ + qb * 128 + 16 * w;
        bf16x8 qf[2]; qf[0] = qn[0]; qf[1] = qn[1];
        f32x4 O[4]; O[0] = O[1] = O[2] = O[3] = (f32x4){0.f, 0.f, 0.f, 0.f};
        float suffix = 0.f, wsm = 0.f;
        const int q_rel = 16 * w + r16;
        for (int kb = qb; kb >= 0; --kb) {
            *(LAS u32x4*)(Ks + ks_s * 72 + ks_p * 16) = pk0; *(LAS u32x4*)(Ks + ks_s * 72 + ks_p * 16 + 8) = pk1;
            *(LAS u32x4*)(Vs + vs_d * 136 + vs_p * 16) = pv0; *(LAS u32x4*)(Vs + vs_d * 136 + vs_p * 16 + 8) = pv1;
            __syncthreads();
            if (kb > 0) ATT_LOAD(b, h, kb - 1);
            __builtin_amdgcn_sched_barrier(0);
            if (wsm > -160.f) {
                float tail;
                if (kb != qb) tail = att_block<false, 8>(Ks, Vs, qf, O, suffix, q_rel, r16, quad);
                else switch (w) {
                    case 0: tail = att_block<true, 1>(Ks, Vs, qf, O, suffix, q_rel, r16, quad); break; case 1: tail = att_block<true, 2>(Ks, Vs, qf, O, suffix, q_rel, r16, quad); break;
                    case 2: tail = att_block<true, 3>(Ks, Vs, qf, O, suffix, q_rel, r16, quad); break; case 3: tail = att_block<true, 4>(Ks, Vs, qf, O, suffix, q_rel, r16, quad); break;
                    case 4: tail = att_block<true, 5>(Ks, Vs, qf, O, suffix, q_rel, r16, quad); break; case 5: tail = att_block<true, 6>(Ks, Vs, qf, O, suffix, q_rel, r16, quad); break;
                    case 6: tail = att_block<true, 7>(Ks, Vs, qf, O, suffix, q_rel, r16, quad); break; default: tail = att_block<true, 8>(Ks, Vs, qf, O, suffix, q_rel, r16, quad); break; }
                suffix += tail;
                float sm = suffix; sm = fmaxf(sm, __shfl_xor(sm, 1)); sm = fmaxf(sm, __shfl_xor(sm, 2)); sm = fmaxf(sm, __shfl_xor(sm, 4)); sm = fmaxf(sm, __shfl_xor(sm, 8));
                wsm = sm;
            }
            if (lane == 0) smax_s[w] = wsm;
            __syncthreads();
            float mall = smax_s[0];
#pragma unroll
            for (int i = 1; i < 8; ++i) mall = fmaxf(mall, smax_s[i]);
            if (mall < -160.f) break;
        }
        { const int nu = unit + gridDim.x; if (nu < 4096) { const int nbh = nu & 63, nqb = 63 - (nu >> 6); ATT_QLOAD(nbh >> 4, nbh & 15, nqb); ATT_LOAD(nbh >> 4, nbh & 15, nqb); } }
        __builtin_amdgcn_sched_barrier(0);
#pragma unroll
        for (int dt = 0; dt < 4; ++dt)
#pragma unroll
            for (int j = 0; j < 4; ++j) if (REAL) QO[(rowq + 4 * quad + j) * 1024 + h * 64 + 16 * dt + r16] = (bf16)f2bf(O[dt][j]);
    }
}
#undef ATT_LOAD
#undef ATT_QLOAD

#define XB_TMO      128
#define XB_XCNT(j)  (256  + 64 * (j))
#define XB_XSUB(j)  (1280 + 64 * (j))
#define XB_XGEN(j)  (2304 + 64 * (j))
#define XB_TOP      3328
#define XB_TOPGEN   3392
#define XCD_BAR_WORDS 3456
#define XB_SPIN_CAP (1u << 20)

__device__ __forceinline__ unsigned xb_ld(unsigned* p)              { return __hip_atomic_load(p, __ATOMIC_RELAXED, __HIP_MEMORY_SCOPE_AGENT); }
__device__ __forceinline__ unsigned xb_add(unsigned* p, unsigned v) { return __hip_atomic_fetch_add(p, v, __ATOMIC_RELAXED, __HIP_MEMORY_SCOPE_AGENT); }
__device__ __forceinline__ unsigned xb_xcc_id() { return (unsigned)__builtin_amdgcn_s_getreg((3 << 11) | 20) & 0xFu; }
#define XB_SPIN(cond, bar) do { unsigned _sp = 0; while (cond) { __builtin_amdgcn_s_sleep(1); \
    if ((++_sp & 255u) == 0u) { if (xb_ld(&(bar)[XB_TMO])) break; if (_sp > XB_SPIN_CAP) { atomicAdd(&(bar)[XB_TMO], 1u); break; } } } } while (0)

struct XcdBarrier {
    unsigned* bar; unsigned x;
    volatile LAS unsigned* st;
};

__device__ __forceinline__ XcdBarrier xcd_barrier_post(unsigned* bar, volatile LAS unsigned* st) {
    XcdBarrier b; b.bar = bar; b.x = xb_xcc_id(); b.st = st;
    if (threadIdx.x == 0) (void)xb_add(&bar[XB_XCNT(b.x)], 1u);
    return b;
}
__device__ __forceinline__ void xcd_barrier_complete(unsigned* bar, unsigned x, unsigned& nloc, unsigned& nx) {
    const unsigned G = gridDim.x * gridDim.y * gridDim.z;
    unsigned sum, cnt, mine, sp = 0u;
    for (;;) {
        sum = 0u; cnt = 0u; mine = 0u;
#pragma unroll
        for (unsigned j = 0; j < 16; ++j) { const unsigned c = xb_ld(&bar[XB_XCNT(j)]); sum += c; cnt += (c > 0u) ? 1u : 0u; mine = (j == x) ? c : mine; }
        if (sum == G) break;
        __builtin_amdgcn_s_sleep(1);
        if ((++sp & 255u) == 0u) { if (xb_ld(&bar[XB_TMO])) break; if (sp > XB_SPIN_CAP) { atomicAdd(&bar[XB_TMO], 1u); break; } }
    }
    nloc = mine > 0u ? mine : 1u; nx = cnt > 0u ? cnt : 1u;
}

__device__ __forceinline__ void xcd_barrier(const XcdBarrier& b) {
    asm volatile("s_waitcnt vmcnt(0)" ::: "memory");
    __syncthreads();
    if (threadIdx.x == 0) {
        unsigned* bar = b.bar;
        __builtin_amdgcn_s_waitcnt(0);
        unsigned nloc = b.st[0], nx = b.st[1];
        if (nloc == 0u) { xcd_barrier_complete(bar, b.x, nloc, nx); b.st[0] = nloc; b.st[1] = nx; }
        const unsigned old = xb_add(&bar[XB_XSUB(b.x)], 1u);
        const unsigned gen = old / nloc;
        if (old + 1u == (gen + 1u) * nloc) {
            __builtin_amdgcn_fence(__ATOMIC_RELEASE, "agent");
            asm volatile("s_waitcnt vmcnt(0)" ::: "memory");
            const unsigned og = xb_add(&bar[XB_TOP], 1u);
            const unsigned tg = og / nx;
            if (og + 1u == (tg + 1u) * nx) xb_add(&bar[XB_TOPGEN], 1u);
            else XB_SPIN(xb_ld(&bar[XB_TOPGEN]) == tg, bar);
            __builtin_amdgcn_fence(__ATOMIC_ACQUIRE, "agent");
            xb_add(&bar[XB_XGEN(b.x)], 1u);
            asm volatile("s_waitcnt vmcnt(0)" ::: "memory");
        } else {
            XB_SPIN(xb_ld(&bar[XB_XGEN(b.x)]) == gen, bar);
            __builtin_amdgcn_fence(__ATOMIC_ACQUIRE, "agent");
            asm volatile("s_waitcnt vmcnt(0)" ::: "memory");
        }
    }
    __syncthreads();
}

#ifndef DUPMASK
#define DUPMASK 0
#endif
#ifndef SSD_DMODE
#define SSD_DMODE 15
#endif
#define DUP(k) constexpr ((DUPMASK >> (k)) & 1)
__global__ void __launch_bounds__(NTHR, 2) yoco_fwd(Params p) {
    extern __shared__ __attribute__((aligned(16))) unsigned char lds[];
    LAS unsigned char* L = (LAS unsigned char*)lds;
    cg::grid_group grid = cg::this_grid();
    if (threadIdx.x < 2) ((LAS unsigned*)(L + LDS_BYTES - 16))[threadIdx.x] = 0u;
    __syncthreads();
    const XcdBarrier xbar = xcd_barrier_post((unsigned*)(p.ws + WS_BAR), (volatile LAS unsigned*)(L + LDS_BYTES - 16));
    if (gridDim.x > 65536u) grid.sync();
#define GSYNC() xcd_barrier(xbar)
    unsigned char* ws = p.ws;
    bf16* WB = (bf16*)(ws + WS_W);
    float* MODS = (float*)(ws + WS_MODS); float* SUMSQ = (float*)(ws + WS_SUMSQ);
    bf16* X = (bf16*)(ws + WS_X);
    bf16* H0 = (bf16*)(ws + WS_X); float* DTb = (float*)(ws + WS_X + 64 * MiB); float* ACSb = (float*)(ws + WS_X + 92 * MiB); float* PSb = (float*)(ws + WS_X + 96 * MiB); float* P0b = (float*)(ws + WS_X + 68 * MiB); float* UH0 = (float*)(ws + WS_X + 80 * MiB);
    bf16* XBC = (bf16*)(ws + WS_BIG); bf16* Gb = (bf16*)(ws + WS_BIG); bf16* H = (bf16*)(ws + WS_BIG + 176 * MiB);
    float* P1b = (float*)(ws + WS_BIG + 240 * MiB); float* UH1 = (float*)(ws + WS_BIG + 248 * MiB);
    bf16* HK = (bf16*)(ws + WS_BIG); bf16* QO = (bf16*)(ws + WS_BIG + 64 * MiB);
    bf16* Zb = (bf16*)p.out; bf16* Kb = (bf16*)p.out; bf16* VT = (bf16*)((unsigned char*)p.out + 64 * MiB);
    LAS float* xch = (LAS float*)(L + XCH_OFF);
    const int G_ = gridDim.x, c_ = blockIdx.x;
    using pg8::Gemm; using pg8::StaticOrder;

#ifndef PHM
#define PHM 0xffff
#endif
#define EN(x) constexpr ((PHM >> (x)) & 1)
    unsigned long long* TS = (unsigned long long*)(ws + WS_FLAGS + 4096);
    STAMP(0);
if DUP(1) { if EN(0) p0_phase(p, L); GSYNC(); }
        if EN(0) p0_phase(p, L);
    GSYNC(); STAMP(1);
if DUP(2) { if EN(1) norm_phase<1, false>(p.in[0], p.in[4], MODS + 0, H0, nullptr, nullptr, nullptr); GSYNC(); }
        if EN(1) norm_phase<1, false>(p.in[0], p.in[4], MODS + 0, H0, nullptr, nullptr, nullptr);
    GSYNC(); STAMP(2);
    if DUP(3) { if EN(2) {
        Gemm g{H0, WB + W_IN, T, 2304, 1024}; StaticOrder S; S.init(T, 2304, G_, c_);
        pg8::EpiZdt E{Zb, DTb, p.in[9]};
        pg8::gemm_phase<pg8::EpiZdt, StaticOrder, true, true>(L, g, S, E);
    }
    if EN(2) {
        Gemm g{H0, WB + W_IN + (size_t)2304 * 1024, T, 4096, 1024}; StaticOrder S; S.init(T, 4096, G_, c_);
        pg8::EpiMamba E{XBC, P0b, UH0, p.in[7], p.in[8], xch};
        pg8::gemm_phase<pg8::EpiMamba, StaticOrder, true, true>(L, g, S, E);
    } GSYNC(); }
    if EN(2) {
        Gemm g{H0, WB + W_IN, T, 2304, 1024}; StaticOrder S; S.init(T, 2304, G_, c_);
        pg8::EpiZdt E{Zb, DTb, p.in[9]};
        pg8::gemm_phase<pg8::EpiZdt, StaticOrder, true, true>(L, g, S, E);
    }
    if EN(2) {
        Gemm g{H0, WB + W_IN + (size_t)2304 * 1024, T, 4096, 1024}; StaticOrder S; S.init(T, 4096, G_, c_);
        pg8::EpiMamba E{XBC, P0b, UH0, p.in[7], p.in[8], xch};
        pg8::gemm_phase<pg8::EpiMamba, StaticOrder, true, true>(L, g, S, E);
    }
    GSYNC(); STAMP(3);
#ifdef XSYNC
    for (int i = 0; i < XSYNC; ++i) GSYNC();
#endif
    if EN(3) { fixup_mamba(P0b, UH0, p.in[7], p.in[8], XBC); acs_phase(DTb, p.in[10], ACSb); }
    GSYNC(); STAMP(4);
    if DUP(5) { ssd_phase<false, SSD_DMODE>(XBC, Zb, DTb, ACSb, p.in[10], p.in[11], p.in[12], PSb, L); GSYNC(); }
    if EN(4) ssd_phase<true>(XBC, Zb, DTb, ACSb, p.in[10], p.in[11], p.in[12], PSb, L);
    GSYNC();
    ssreduce_phase(PSb, SUMSQ);
    GSYNC(); STAMP(5);
    if DUP(6) { if EN(5) {
        Gemm g{Zb, WB + W_SOUT, T, 1024, 2048}; StaticOrder S; S.init(T, 1024, G_, c_);
        pg8::EpiRes<true> E{p.in[0], X, MODS + 2048, SUMSQ};
        pg8::gemm_phase<pg8::EpiRes<true>, StaticOrder, true, true>(L, g, S, E);
    } GSYNC(); }
    if EN(5) {
        Gemm g{Zb, WB + W_SOUT, T, 1024, 2048}; StaticOrder S; S.init(T, 1024, G_, c_);
        pg8::EpiRes<true> E{p.in[0], X, MODS + 2048, SUMSQ};
        pg8::gemm_phase<pg8::EpiRes<true>, StaticOrder, true, true>(L, g, S, E);
    }
    GSYNC(); STAMP(6);
    {
        const float* md = MODS;
if DUP(7) { norm_phase_b<1, false>(X, p.in[5] + 0, md + 3072, H, nullptr, nullptr, nullptr); GSYNC(); }
            norm_phase_b<1, false>(X, p.in[5] + 0, md + 3072, H, nullptr, nullptr, nullptr);
        GSYNC(); STAMP(7);
        if DUP(8) { if EN(9) { Gemm g{H, WB + (W_FIN0), T, 5632, 1024}; StaticOrder S; S.init(T, 5632, G_, c_);
          pg8::EpiFFN E{Gb, P1b, UH1, p.in[22] + 0, p.in[23] + 0, xch};
          pg8::gemm_phase<pg8::EpiFFN, StaticOrder, true, true>(L, g, S, E); } GSYNC(); }
    if EN(9) { Gemm g{H, WB + (W_FIN0), T, 5632, 1024}; StaticOrder S; S.init(T, 5632, G_, c_);
          pg8::EpiFFN E{Gb, P1b, UH1, p.in[22] + 0, p.in[23] + 0, xch};
          pg8::gemm_phase<pg8::EpiFFN, StaticOrder, true, true>(L, g, S, E); }
        GSYNC(); STAMP(8);
        if EN(10) fixup_ffn(P1b, UH1, p.in[22] + 0, p.in[23] + 0, Gb);
        GSYNC(); STAMP(9);
        if DUP(10) { if EN(11) { Gemm g{Gb, WB + (W_FOUT0), T, 1024, 2816}; StaticOrder S; S.init(T, 1024, G_, c_); pg8::EpiRes<false> E{X, (bf16*)p.out, md + 5120, nullptr};
          pg8::gemm_phase<pg8::EpiRes<false>, StaticOrder, true, true>(L, g, S, E); } GSYNC(); }
    if EN(11) { Gemm g{Gb, WB + (W_FOUT0), T, 1024, 2816}; StaticOrder S; S.init(T, 1024, G_, c_); pg8::EpiRes<false> E{X, X, md + 5120, nullptr};
          pg8::gemm_phase<pg8::EpiRes<false>, StaticOrder, true, true>(L, g, S, E); }
        GSYNC(); STAMP(10);
    }
    {
        const float* md = MODS + MOD_L;
if DUP(11) { norm_phase_b<2, false>(X, p.in[16], MODS + MOD_KV, HK, p.in[4] + 1024, md + 0, H); GSYNC(); }
                norm_phase_b<2, false>(X, p.in[16], MODS + MOD_KV, HK, p.in[4] + 1024, md + 0, H);
            GSYNC(); STAMP(11);
            if DUP(12) { if EN(6) { Gemm g{HK, WB + W_K, T, 1024, 1024}; StaticOrder S; S.init(T, 1024, G_, c_); pg8::EpiStore E{Kb, 1024, 1.0f};
              pg8::gemm_phase<pg8::EpiStore, StaticOrder, true, true>(L, g, S, E); }
            if EN(6) { Gemm g{WB + W_V, HK, 1024, T, 1024}; StaticOrder S; S.init(1024, T, G_, c_); pg8::EpiStore E{VT, T, 1.0f};
              pg8::gemm_phase<pg8::EpiStore, StaticOrder, true, true>(L, g, S, E); }
            if EN(6) { Gemm g{H, WB + W_Q, T, 1024, 1024}; StaticOrder S; S.init(T, 1024, G_, c_); pg8::EpiStore E{QO, 1024, 0.125f * 1.4426950408889634f};
              pg8::gemm_phase<pg8::EpiStore, StaticOrder, true, true>(L, g, S, E); } GSYNC(); }
    if EN(6) { Gemm g{HK, WB + W_K, T, 1024, 1024}; StaticOrder S; S.init(T, 1024, G_, c_); pg8::EpiStore E{Kb, 1024, 1.0f};
              pg8::gemm_phase<pg8::EpiStore, StaticOrder, true, true>(L, g, S, E); }
            if EN(6) { Gemm g{WB + W_V, HK, 1024, T, 1024}; StaticOrder S; S.init(1024, T, G_, c_); pg8::EpiStore E{VT, T, 1.0f};
              pg8::gemm_phase<pg8::EpiStore, StaticOrder, true, true>(L, g, S, E); }
            if EN(6) { Gemm g{H, WB + W_Q, T, 1024, 1024}; StaticOrder S; S.init(T, 1024, G_, c_); pg8::EpiStore E{QO, 1024, 0.125f * 1.4426950408889634f};
              pg8::gemm_phase<pg8::EpiStore, StaticOrder, true, true>(L, g, S, E); }
            GSYNC(); STAMP(12);
            if DUP(13) { attn_phase<false>(QO, Kb, VT, L); GSYNC(); }
            if EN(7) attn_phase<true>(QO, Kb, VT, L);
            GSYNC(); STAMP(13);
            if DUP(14) { if EN(8) { Gemm g{QO, WB + W_O, T, 1024, 1024}; StaticOrder S; S.init(T, 1024, G_, c_); pg8::EpiRes<false> E{X, (bf16*)p.out, md + 2048, nullptr};
              pg8::gemm_phase<pg8::EpiRes<false>, StaticOrder, true, true>(L, g, S, E); } GSYNC(); }
    if EN(8) { Gemm g{QO, WB + W_O, T, 1024, 1024}; StaticOrder S; S.init(T, 1024, G_, c_); pg8::EpiRes<false> E{X, X, md + 2048, nullptr};
              pg8::gemm_phase<pg8::EpiRes<false>, StaticOrder, true, true>(L, g, S, E); }
            GSYNC(); STAMP(14);
if DUP(15) { norm_phase_b<1, false>(X, p.in[5] + 1024, md + 3072, H, nullptr, nullptr, nullptr); GSYNC(); }
            norm_phase_b<1, false>(X, p.in[5] + 1024, md + 3072, H, nullptr, nullptr, nullptr);
        GSYNC(); STAMP(15);
        if DUP(16) { if EN(9) { Gemm g{H, WB + (W_FIN1), T, 5632, 1024}; StaticOrder S; S.init(T, 5632, G_, c_);
          pg8::EpiFFN E{Gb, P1b, UH1, p.in[22] + 16896, p.in[23] + 5632, xch};
          pg8::gemm_phase<pg8::EpiFFN, StaticOrder, true, true>(L, g, S, E); } GSYNC(); }
    if EN(9) { Gemm g{H, WB + (W_FIN1), T, 5632, 1024}; StaticOrder S; S.init(T, 5632, G_, c_);
          pg8::EpiFFN E{Gb, P1b, UH1, p.in[22] + 16896, p.in[23] + 5632, xch};
          pg8::gemm_phase<pg8::EpiFFN, StaticOrder, true, true>(L, g, S, E); }
        GSYNC(); STAMP(16);
        if EN(10) fixup_ffn(P1b, UH1, p.in[22] + 16896, p.in[23] + 5632, Gb);
        GSYNC(); STAMP(17);
        if DUP(18) { if EN(11) { Gemm g{Gb, WB + (W_FOUT1), T, 1024, 2816}; StaticOrder S; S.init(T, 1024, G_, c_); pg8::EpiRes<false> E{X, (bf16*)p.out, md + 5120, nullptr};
          pg8::gemm_phase<pg8::EpiRes<false>, StaticOrder, true, true>(L, g, S, E); } GSYNC(); }
    if EN(11) { Gemm g{Gb, WB + (W_FOUT1), T, 1024, 2816}; StaticOrder S; S.init(T, 1024, G_, c_); pg8::EpiRes<false> E{X, X, md + 5120, nullptr};
          pg8::gemm_phase<pg8::EpiRes<false>, StaticOrder, true, true>(L, g, S, E); }
        GSYNC(); STAMP(18);
    }
if DUP(19) { norm_phase_b<1, true>(X, p.in[27], MODS + MOD_FIN, p.out, nullptr, nullptr, nullptr); GSYNC(); }
        norm_phase_b<1, true>(X, p.in[27], MODS + MOD_FIN, p.out, nullptr, nullptr, nullptr);
#ifdef PROBE
    GSYNC(); STAMP(19);
    __threadfence();
    {   volatile unsigned long long* tsv = TS; float ta = 0.f, tb = 0.f;
        for (int k = 1; k <= 19; ++k) { const float d = (float)(tsv[k] - tsv[k - 1]) * 0.01f; if ((PROBE_A >> k) & 1) ta += d; if ((PROBE_B >> k) & 1) tb += d; }
        for (int i = blockIdx.x * NTHR + threadIdx.x; i < (1 << 22); i += gridDim.x * NTHR) p.out[(1 << 24) + i] = tb;
        if (blockIdx.x == 0 && threadIdx.x == 0) p.out[0] = ta * 10.0f; }
#endif
}

extern "C" void kernel_launch(void* const* d_in, const int* in_sizes, int n_in, void* d_out, int out_size, void* d_ws, size_t ws_size, hipStream_t stream) {
    static int grid = 0;
    if (grid == 0) {
        if (n_in != 28 || out_size != T * D || ws_size < WS_END) { fprintf(stderr, "kernel_launch: unexpected shapes (n_in %d out %d ws %zu)\n", n_in, out_size, ws_size); grid = -1; return; }
        int dev = 0, cus = 0, per_cu = 0;
        hipGetDevice(&dev); hipDeviceGetAttribute(&cus, hipDeviceAttributeMultiprocessorCount, dev);
        hipFuncSetAttribute((const void*)yoco_fwd, hipFuncAttributeMaxDynamicSharedMemorySize, LDS_BYTES);
        hipOccupancyMaxActiveBlocksPerMultiprocessor(&per_cu, (const void*)yoco_fwd, NTHR, LDS_BYTES);
        if (per_cu < 1) per_cu = 1;
        grid = cus * per_cu; if (grid > 256) grid = 256;
        (void)hipGetLastError();
    }
    if (grid < 0) return;
    Params p{};
    for (int i = 0; i < 28; ++i) p.in[i] = (const float*)d_in[i];
    p.out = (float*)d_out; p.ws = (unsigned char*)d_ws;
    (void)hipMemsetAsync((unsigned char*)d_ws + WS_BAR, 0, 16384, stream);
    void* args[] = {&p};
    hipError_t e = hipLaunchCooperativeKernel((const void*)yoco_fwd, dim3(grid), dim3(NTHR), args, LDS_BYTES, stream);
    if (e != hipSuccess) fprintf(stderr, "cooperative launch failed: %s (grid %d)\n", hipGetErrorString(e), grid);
}
```

```cpp
#include <hip/hip_runtime.h>
#include <hip/hip_cooperative_groups.h>
#include <cstdio>
#include <cstdint>
namespace cg = cooperative_groups;
#ifndef DBG
#define DBG 0
#endif
namespace pg8 {
#define PG8_LAS __attribute__((address_space(3)))
typedef unsigned short bf16_t;
typedef short bf16x8 __attribute__((ext_vector_type(8)));
typedef float f32x4 __attribute__((ext_vector_type(4)));
typedef unsigned u32x4 __attribute__((ext_vector_type(4)));
constexpr int BM = 256, BK = 64, HALF = 128, HTB = HALF * BK * 2  , STAGE_BYTES = 8 * HTB, NXCD = 8, WGM = 8;

__host__ __device__ __forceinline__ int lds_byte(int r, int c) { const int st = (r >> 4) * 2 + (c >> 5), rr = r & 15, cc = c & 31, ob = rr * 64 + cc * 2; return st * 1024 + (ob ^ (((ob >> 9) & 1) << 5)); }
__host__ __device__ __forceinline__ void stage_rc(int b, int& R, int& C) { const int st = b / 1024, sb = b % 1024, swz = sb ^ (((sb >> 9) & 1) << 5); R = (st >> 1) * 16 + swz / 64; C = (st & 1) * 32 + (swz % 64) / 2; }
__host__ __device__ __forceinline__ int perm32(int rho) { const int n = rho >> 4, i = rho & 15; return 8 * (i >> 2) + 4 * n + (i & 3); }

struct Unit { int pm, pn; };
struct Gemm { const bf16_t* A; const bf16_t* Bt; int M, N, K; };

struct StaticOrder {
    int nM, nN, nwg, G, c;
    __host__ __device__ void init(int M, int N, int G_, int c_) { nM = M / BM; nN = N / BM; nwg = nM * nN; G = G_; c = c_; }
    __host__ __device__ bool next(int i, Unit& u) const {
        const long L = (long)i * G + c; if (L >= nwg) return false;
        int wgid = (int)L; { const int q = nwg / NXCD, r = nwg % NXCD, xcd = wgid % NXCD, off = wgid / NXCD; wgid = (xcd < r ? xcd * (q + 1) : r * (q + 1) + (xcd - r) * q) + off; }
        const int nig = WGM * nN, gid = wgid / nig, fm = gid * WGM, gsz = (nM - fm) < WGM ? (nM - fm) : WGM;
        u.pm = fm + ((wgid % nig) % gsz); u.pn = (wgid % nig) / gsz; return true;
    }
    __device__ __forceinline__ void a_ready(const Unit&) const {}
    __device__ __forceinline__ void done(const Unit&) const {}
};

__device__ __forceinline__ unsigned cvt_pk_bf16(float lo, float hi) { unsigned r; asm volatile("v_cvt_pk_bf16_f32 %0, %1, %2" : "=v"(r) : "v"(lo), "v"(hi)); return r; }

typedef unsigned u32x2 __attribute__((ext_vector_type(2)));
typedef float f32x2 __attribute__((ext_vector_type(2)));
__device__ __forceinline__ float silu_f(float x) { return x * __builtin_amdgcn_rcpf(1.f + __expf(-x)); }
__device__ __forceinline__ f32x2 silu2(f32x2 x) { const f32x2 t = x * (-1.4426950408889634f); f32x2 d; d.x = __builtin_amdgcn_exp2f(t.x); d.y = __builtin_amdgcn_exp2f(t.y); d = d + 1.0f;
    f32x2 r; r.x = __builtin_amdgcn_rcpf(d.x); r.y = __builtin_amdgcn_rcpf(d.y); return x * r; }
__device__ __forceinline__ float softplus_f(float x) { return fmaxf(x, 0.f) + __logf(1.f + __expf(-fabsf(x))); }
template <int K> __device__ __forceinline__ float dpp_ror(float v) { return __int_as_float(__builtin_amdgcn_update_dpp(0, __float_as_int(v), 0x120 + K, 0xf, 0xf, false)); }
template <int K> __device__ __forceinline__ float dpp_shr_keep(float cur, float old) { return __int_as_float(__builtin_amdgcn_update_dpp(__float_as_int(old), __float_as_int(cur), 0x110 + K, 0xf, 0xf, false)); }
template <int K> __device__ __forceinline__ float shift1(float cur, float prev, float halo, bool first) { const float old = first ? halo : dpp_ror<K>(prev); return dpp_shr_keep<K>(cur, old); }
template <int K> __device__ __forceinline__ f32x4 shift_rows(const f32x4 cur, const f32x4 prev, const f32x4 halo, bool first) {
    f32x4 r;
#pragma unroll
    for (int e = 0; e < 4; ++e) { const float old = first ? halo[e] : dpp_ror<K>(prev[e]); r[e] = dpp_shr_keep<K>(cur[e], old); }
    return r;
}

struct EpiStore {
    static constexpr bool PERM = true, AFTER_DRAIN = false, ROWPERM = false;
    bf16_t* O; int ldc; float sc;
    __device__ __forceinline__ void operator()(const f32x4 (&acc)[2][2][4][2], const Unit& u, int wr, int wc, int fr, int fq) const {
        asm volatile("" : "+v"(fr), "+v"(fq));
        const int row0 = u.pm * BM + wr * 64 + fr, col0 = u.pn * BM + wc * 32 + 8 * fq;
#pragma unroll
        for (int ai = 0; ai < 2; ++ai)
#pragma unroll
            for (int m = 0; m < 4; ++m) { bf16_t* rowp = O + (size_t)(row0 + ai * HALF + m * 16) * ldc + col0;
#pragma unroll
                for (int bj = 0; bj < 2; ++bj) { const f32x4 v0 = acc[ai][bj][m][0] * sc, v1 = acc[ai][bj][m][1] * sc;
                    u32x4 w; w.x = cvt_pk_bf16(v0[0], v0[1]); w.y = cvt_pk_bf16(v0[2], v0[3]); w.z = cvt_pk_bf16(v1[0], v1[1]); w.w = cvt_pk_bf16(v1[2], v1[3]);
                    *(u32x4*)(rowp + bj * HALF) = w; } }
    }
};

template <bool XIN_F32> struct EpiRes {
    static constexpr bool PERM = true, AFTER_DRAIN = false, ROWPERM = false;
    const void* xin; bf16_t* xout; const float* gate; const float* sumsq;
    __device__ __forceinline__ void operator()(const f32x4 (&acc)[2][2][4][2], const Unit& u, int wr, int wc, int fr, int fq) const {
        asm volatile("" : "+v"(fr), "+v"(fq));
        const int row0 = u.pm * BM + wr * 64 + fr, col0 = u.pn * BM + wc * 32 + 8 * fq;
        const float* gp = gate + (size_t)(u.pm >> 5) * 16384 + col0;
        f32x4 gv[2][2];
#pragma unroll
        for (int bj = 0; bj < 2; ++bj)
#pragma unroll
            for (int n = 0; n < 2; ++n) gv[bj][n] = *(const f32x4*)(gp + bj * HALF + n * 4);
#pragma unroll
        for (int ai = 0; ai < 2; ++ai)
#pragma unroll
            for (int m = 0; m < 4; ++m) { const int row = row0 + ai * HALF + m * 16;
                const float rs = sumsq ? sumsq[row] : 1.0f;
                const size_t off = (size_t)row * 1024 + col0;
#pragma unroll
                for (int bj = 0; bj < 2; ++bj) {
                    f32x4 x0, x1;
                    if (XIN_F32) { x0 = __builtin_nontemporal_load((const f32x4*)((const float*)xin + off + bj * HALF)); x1 = __builtin_nontemporal_load((const f32x4*)((const float*)xin + off + bj * HALF + 4)); }
                    else { const u32x4 xb = *(const u32x4*)((const bf16_t*)xin + off + bj * HALF);
                        x0 = (f32x4){__uint_as_float(xb.x << 16), __uint_as_float(xb.x & 0xffff0000u), __uint_as_float(xb.y << 16), __uint_as_float(xb.y & 0xffff0000u)};
                        x1 = (f32x4){__uint_as_float(xb.z << 16), __uint_as_float(xb.z & 0xffff0000u), __uint_as_float(xb.w << 16), __uint_as_float(xb.w & 0xffff0000u)}; }
                    const f32x4 v0 = x0 + gv[bj][0] * acc[ai][bj][m][0] * rs, v1 = x1 + gv[bj][1] * acc[ai][bj][m][1] * rs;
                    u32x4 w; w.x = cvt_pk_bf16(v0[0], v0[1]); w.y = cvt_pk_bf16(v0[2], v0[3]); w.z = cvt_pk_bf16(v1[0], v1[1]); w.w = cvt_pk_bf16(v1[2], v1[3]);
                    *(u32x4*)(xout + off + bj * HALF) = w; } }
    }
};

struct EpiZdt {
    static constexpr bool PERM = true, AFTER_DRAIN = false, ROWPERM = false;
    bf16_t* Z; float* DT; const float* dtb;
    __device__ __forceinline__ void operator()(const f32x4 (&acc)[2][2][4][2], const Unit& u, int wr, int wc, int fr, int fq) const {
        asm volatile("" : "+v"(fr), "+v"(fq));
        const int row0 = u.pm * BM + wr * 64 + fr;
        if (u.pn < 8) {
            const int col0 = u.pn * BM + wc * 32 + 8 * fq;
#pragma unroll
            for (int ai = 0; ai < 2; ++ai)
#pragma unroll
                for (int m = 0; m < 4; ++m) { bf16_t* rowp = Z + (size_t)(row0 + ai * HALF + m * 16) * 2048 + col0;
#pragma unroll
                    for (int bj = 0; bj < 2; ++bj) { const f32x4 v0 = acc[ai][bj][m][0], v1 = acc[ai][bj][m][1];
                        u32x4 w; w.x = cvt_pk_bf16(v0[0], v0[1]); w.y = cvt_pk_bf16(v0[2], v0[3]); w.z = cvt_pk_bf16(v1[0], v1[1]); w.w = cvt_pk_bf16(v1[2], v1[3]);
                        *(u32x4*)(rowp + bj * HALF) = w; } }
            return;
        }
        {
            if (wc == 0) {
#pragma unroll
                for (int n = 0; n < 2; ++n) { const f32x4 bv = *(const f32x4*)(dtb + 8 * fq + 4 * n);
#pragma unroll
                    for (int ai = 0; ai < 2; ++ai)
#pragma unroll
                        for (int m = 0; m < 4; ++m) { f32x4 v = acc[ai][0][m][n] + bv;
#pragma unroll
                            for (int e = 0; e < 4; ++e) v[e] = softplus_f(v[e]);
                            *(f32x4*)(DT + (size_t)(row0 + ai * HALF + m * 16) * 32 + 8 * fq + 4 * n) = v; } }
            }
            return;
        }
    }
};

struct EpiMamba {
    static constexpr bool PERM = true, AFTER_DRAIN = false, ROWPERM = true;
    static constexpr int NC = 4096;
    bf16_t* XBC; float* P; float* UH; const float* cw; const float* cb; PG8_LAS float* xch;
    __device__ __forceinline__ void operator()(const f32x4 (&acc)[2][2][4][2], const Unit& u, int wr, int wc, int fr, int fq) const {
        asm volatile("" : "+v"(fr), "+v"(fq));
        const int row0 = u.pm * BM + wr * 64 + 4 * fr;
        const int cpos0 = 32 * wc + 8 * fq;
        PG8_LAS float* wt = xch + 3072;
        { const int tid = (wr * 4 + wc) * 64 + fq * 16 + fr;
#pragma unroll
            for (int j = 0; j < 3; ++j) { const int i = tid + 512 * j; if (i < 5 * 256) { const int t = i >> 8, cp = i & 255; wt[i] = t < 4 ? cw[t * 4096 + u.pn * BM + cp] : cb[u.pn * BM + cp]; } } }
        if (fr == 15) {
#pragma unroll
            for (int ai = 0; ai < 2; ++ai)
#pragma unroll
                for (int bj = 0; bj < 2; ++bj)
#pragma unroll
                    for (int n = 0; n < 2; ++n)
#pragma unroll
                        for (int m = 1; m < 4; ++m) {
                            *(PG8_LAS f32x4*)(xch + ((2 * ai + wr) * 3 + (m - 1)) * 256 + 128 * bj + cpos0 + 4 * n) = acc[ai][bj][m][n];
                            if (ai == 1 && wr == 1) *(f32x4*)(UH + ((size_t)u.pm * 3 + (m - 1)) * NC + u.pn * BM + 128 * bj + cpos0 + 4 * n) = acc[1][bj][m][n]; }
        }
        asm volatile("s_waitcnt lgkmcnt(0)" ::: "memory"); __builtin_amdgcn_s_barrier(); asm volatile("" ::: "memory");
#pragma unroll
        for (int ai = 0; ai < 2; ++ai) {
            const int seg = 2 * ai + wr; const bool has_prev = seg > 0; const int sp = has_prev ? seg - 1 : 0;
#pragma unroll
            for (int bj = 0; bj < 2; ++bj) {
                const int ch0 = u.pn * BM + 128 * bj + cpos0;
                unsigned pkn[2][4][2];
#pragma unroll
                for (int n = 0; n < 2; ++n) {
                    unsigned (&pk)[4][2] = pkn[n];
#pragma unroll
                    for (int eh = 0; eh < 2; ++eh) {
                        const int cpos = 128 * bj + cpos0 + 4 * n + 2 * eh; const int ch = ch0 + 4 * n + 2 * eh;
                        f32x2 h1 = *(const PG8_LAS f32x2*)(xch + (sp * 3 + 2) * 256 + cpos), h2 = *(const PG8_LAS f32x2*)(xch + (sp * 3 + 1) * 256 + cpos), h3 = *(const PG8_LAS f32x2*)(xch + (sp * 3 + 0) * 256 + cpos);
                        if (!has_prev) { h1 = (f32x2){0.f, 0.f}; h2 = h1; h3 = h1; }
                        const f32x2 w0 = *(const PG8_LAS f32x2*)(wt + 0 * 256 + cpos), w1 = *(const PG8_LAS f32x2*)(wt + 1 * 256 + cpos), w2 = *(const PG8_LAS f32x2*)(wt + 2 * 256 + cpos),
                                    w3 = *(const PG8_LAS f32x2*)(wt + 3 * 256 + cpos), bb = *(const PG8_LAS f32x2*)(wt + 4 * 256 + cpos);
                        f32x2 o[4], v[4];
#pragma unroll
                        for (int m = 0; m < 4; ++m) v[m] = (f32x2){acc[ai][bj][m][n][2 * eh], acc[ai][bj][m][n][2 * eh + 1]};
                        const f32x2 s1 = (f32x2){dpp_shr_keep<1>(v[3].x, h1.x), dpp_shr_keep<1>(v[3].y, h1.y)}, s2 = (f32x2){dpp_shr_keep<1>(v[2].x, h2.x), dpp_shr_keep<1>(v[2].y, h2.y)},
                                    s3 = (f32x2){dpp_shr_keep<1>(v[1].x, h3.x), dpp_shr_keep<1>(v[1].y, h3.y)};
                        o[0] = bb + w3 * v[0] + w2 * s1 + w1 * s2 + w0 * s3;
                        o[1] = bb + w3 * v[1] + w2 * v[0] + w1 * s1 + w0 * s2;
                        o[2] = bb + w3 * v[2] + w2 * v[1] + w1 * v[0] + w0 * s1;
                        o[3] = bb + w3 * v[3] + w2 * v[2] + w1 * v[1] + w0 * v[0];
                        if (seg == 0 && fr == 0) {
#pragma unroll
                            for (int m = 0; m < 3; ++m) *(f32x2*)(P + ((size_t)u.pm * 3 + m) * NC + u.pn * BM + cpos) = o[m]; }
#pragma unroll
                        for (int m = 0; m < 4; ++m) { const f32x2 r = silu2(o[m]); pk[m][eh] = cvt_pk_bf16(r.x, r.y); }
                    }
                }
#pragma unroll
                for (int m = 0; m < 4; ++m) { u32x4 w; w.x = pkn[0][m][0]; w.y = pkn[0][m][1]; w.z = pkn[1][m][0]; w.w = pkn[1][m][1]; *(u32x4*)(XBC + (size_t)(row0 + ai * HALF + m) * 4096 + ch0) = w; }
            }
        }
    }
};

struct EpiFFN {
    static constexpr bool PERM = true, AFTER_DRAIN = false, ROWPERM = true;
    static constexpr int NC = 5632, F = 2816;
    bf16_t* G; float* P; float* UH; const float* cw; const float* cb; PG8_LAS float* xch;
    __device__ __forceinline__ void operator()(const f32x4 (&acc)[2][2][4][2], const Unit& u, int wr, int wc, int fr, int fq) const {
        asm volatile("" : "+v"(fr), "+v"(fq));
        const int row0 = u.pm * BM + wr * 64 + 4 * fr;
        const int cpos0 = 32 * wc + 8 * fq;
        PG8_LAS float* wt = xch + 3072;
        { const int tid = (wr * 4 + wc) * 64 + fq * 16 + fr;
#pragma unroll
            for (int j = 0; j < 2; ++j) { const int i = tid + 512 * j; const int t = i >> 8, cp = i & 255; const int chs = (cp >> 7) * F + u.pn * 128 + (cp & 127); wt[i] = t < 3 ? cw[t * NC + chs] : cb[chs]; } }
        if (fr == 15) {
#pragma unroll
            for (int ai = 0; ai < 2; ++ai)
#pragma unroll
                for (int bj = 0; bj < 2; ++bj)
#pragma unroll
                    for (int n = 0; n < 2; ++n)
#pragma unroll
                        for (int m = 2; m < 4; ++m) {
                            *(PG8_LAS f32x4*)(xch + ((2 * ai + wr) * 2 + (m - 2)) * 256 + 128 * bj + cpos0 + 4 * n) = acc[ai][bj][m][n];
                            if (ai == 1 && wr == 1) *(f32x4*)(UH + ((size_t)u.pm * 2 + (m - 2)) * NC + u.pn * BM + 128 * bj + cpos0 + 4 * n) = acc[1][bj][m][n]; }
        }
        asm volatile("s_waitcnt lgkmcnt(0)" ::: "memory"); __builtin_amdgcn_s_barrier(); asm volatile("" ::: "memory");
        const int j0 = u.pn * 128 + cpos0;
#pragma unroll
        for (int ai = 0; ai < 2; ++ai) {
            const int seg = 2 * ai + wr; const bool has_prev = seg > 0; const int sp = has_prev ? seg - 1 : 0;
            unsigned pkn[2][4][2];
#pragma unroll
            for (int n = 0; n < 2; ++n) {
                unsigned (&pk)[4][2] = pkn[n];
#pragma unroll
                for (int eh = 0; eh < 2; ++eh) {
                    f32x2 og[2][4];
#pragma unroll
                    for (int bj = 0; bj < 2; ++bj) {
                        const int cpos = 128 * bj + cpos0 + 4 * n + 2 * eh;
                        f32x2 h1 = *(const PG8_LAS f32x2*)(xch + (sp * 2 + 1) * 256 + cpos), h2 = *(const PG8_LAS f32x2*)(xch + (sp * 2 + 0) * 256 + cpos);
                        if (!has_prev) { h1 = (f32x2){0.f, 0.f}; h2 = h1; }
                        const f32x2 w0 = *(const PG8_LAS f32x2*)(wt + 0 * 256 + cpos), w1 = *(const PG8_LAS f32x2*)(wt + 1 * 256 + cpos), w2 = *(const PG8_LAS f32x2*)(wt + 2 * 256 + cpos), bb = *(const PG8_LAS f32x2*)(wt + 3 * 256 + cpos);
                        f32x2 v[4];
#pragma unroll
                        for (int m = 0; m < 4; ++m) v[m] = (f32x2){acc[ai][bj][m][n][2 * eh], acc[ai][bj][m][n][2 * eh + 1]};
                        const f32x2 s1 = (f32x2){dpp_shr_keep<1>(v[3].x, h1.x), dpp_shr_keep<1>(v[3].y, h1.y)}, s2 = (f32x2){dpp_shr_keep<1>(v[2].x, h2.x), dpp_shr_keep<1>(v[2].y, h2.y)};
                        og[bj][0] = bb + w2 * v[0] + w1 * s1 + w0 * s2;
                        og[bj][1] = bb + w2 * v[1] + w1 * v[0] + w0 * s1;
                        og[bj][2] = bb + w2 * v[2] + w1 * v[1] + w0 * v[0];
                        og[bj][3] = bb + w2 * v[3] + w1 * v[2] + w0 * v[1];
                        if (seg == 0 && fr == 0) {
#pragma unroll
                            for (int m = 0; m < 2; ++m) *(f32x2*)(P + ((size_t)u.pm * 2 + m) * NC + u.pn * BM + cpos) = og[bj][m]; }
                    }
#pragma unroll
                    for (int m = 0; m < 4; ++m) { const f32x2 r = silu2(og[0][m]) * og[1][m]; pk[m][eh] = cvt_pk_bf16(r.x, r.y); }
                }
            }
#pragma unroll
            for (int m = 0; m < 4; ++m) { u32x4 w; w.x = pkn[0][m][0]; w.y = pkn[0][m][1]; w.z = pkn[1][m][0]; w.w = pkn[1][m][1]; *(u32x4*)(G + (size_t)(row0 + ai * HALF + m) * F + j0) = w; }
        }
    }
};
template <class Epi, class Sched, bool ALIGN_EPI = false, bool SP2 = false>
__device__ __forceinline__ void gemm_phase(PG8_LAS unsigned char* lds, const Gemm g, const Sched& S, const Epi& E) {
    int tid_ = threadIdx.x; asm volatile("" : "+v"(tid_));
    const int tid = tid_, wid = __builtin_amdgcn_readfirstlane(tid >> 6), lane = tid & 63, wr = wid >> 2, wc = wid & 3, fr = lane & 15, fq = lane >> 4;
    const int K = g.K, nt = K / BK;
    unsigned voffA[2], voffB[2];
#pragma unroll
    for (int i = 0; i < 2; ++i) { int R, C; stage_rc(tid * 16 + i * 8192, R, C); const int Rb = Epi::PERM ? ((R & ~31) + perm32(R & 31)) : R;
        const int Ra = Epi::ROWPERM ? ((R & ~63) + 4 * (R & 15) + ((R >> 4) & 3)) : R;
        voffA[i] = (unsigned)(Ra * K + C) * 2u; voffB[i] = (unsigned)(Rb * K + C) * 2u; }
    const size_t kstep = (size_t)(BK * 2);
    const size_t hstep = (size_t)HALF * K * 2;
    const size_t tstep = 2 * hstep;
    const unsigned ldsw = (unsigned)wid * 1024u;
    const int aoff = lds_byte(wr * 64 + fr, fq * 8), boff = lds_byte(wc * 32 + fr, fq * 8);
#define PG8_SA(b, h) (((b) * 2 + (h)) * HTB)
#define PG8_SB(b, h) ((4 + (b) * 2 + (h)) * HTB)
#define PG8_STAGE(bufoff, gbase, voff) do { _Pragma("unroll") for (int _i = 0; _i < 2; ++_i) \
        __builtin_amdgcn_global_load_lds((const unsigned*)((const char*)(gbase) + (voff)[_i]), (PG8_LAS unsigned*)(lds + (bufoff) + ldsw + _i * 8192), 16, 0, 0); } while (0)
#define PG8_LDA(dst, b, h) do { _Pragma("unroll") for (int m = 0; m < 4; ++m) _Pragma("unroll") for (int k = 0; k < 2; ++k) dst[m][k] = *(const PG8_LAS bf16x8*)(lds + PG8_SA(b, h) + aoff + m * 2048 + k * 1024); } while (0)
#define PG8_LDB(dst, b, h) do { _Pragma("unroll") for (int n = 0; n < 2; ++n) _Pragma("unroll") for (int k = 0; k < 2; ++k) dst[n][k] = *(const PG8_LAS bf16x8*)(lds + PG8_SB(b, h) + boff + n * 2048 + k * 1024); } while (0)
#define PG8_MMA(ai, bj, At, Bt) do { __builtin_amdgcn_s_setprio(1); _Pragma("unroll") for (int m = 0; m < 4; ++m) _Pragma("unroll") for (int n = 0; n < 2; ++n) _Pragma("unroll") for (int k = 0; k < 2; ++k) \
        acc[ai][bj][m][n] = __builtin_amdgcn_mfma_f32_16x16x32_bf16(Bt[n][k], At[m][k], acc[ai][bj][m][n], 0, 0, 0); __builtin_amdgcn_s_setprio(0); } while (0)
#define PG8_WAIT_V(n) asm volatile("s_waitcnt vmcnt(" #n ")" ::: "memory")
#define PG8_WAIT_L(n) asm volatile("s_waitcnt lgkmcnt(" #n ")" ::: "memory")
#define PG8_BAR __builtin_amdgcn_s_barrier()
#define PG8_SCHED __builtin_amdgcn_sched_barrier(0)
    Unit cur, nxt; int ui = 0;
    if (!S.next(0, cur)) return;
    f32x4 acc[2][2][4][2];
#pragma unroll
    for (int a = 0; a < 2; ++a)
#pragma unroll
        for (int b = 0; b < 2; ++b)
#pragma unroll
            for (int m = 0; m < 4; ++m)
#pragma unroll
                for (int n = 0; n < 2; ++n) acc[a][b][m][n] = (f32x4){0.f, 0.f, 0.f, 0.f};
    bf16x8 At[4][2], B0[2][2], B1[2][2];
    const char* cA = (const char*)g.A + (size_t)cur.pm * tstep; const char* cB = (const char*)g.Bt + (size_t)cur.pn * tstep;
    S.a_ready(cur);
    if constexpr (SP2) {
        PG8_STAGE(PG8_SB(0, 0), cB, voffB); PG8_STAGE(PG8_SB(0, 1), cB + hstep, voffB); PG8_STAGE(PG8_SA(0, 0), cA, voffA); PG8_STAGE(PG8_SA(0, 1), cA + hstep, voffA);
        if (wr == 1) PG8_BAR;
        PG8_WAIT_V(2); PG8_BAR;
        PG8_STAGE(PG8_SB(1, 0), cB + kstep, voffB); PG8_STAGE(PG8_SA(1, 0), cA + kstep, voffA); PG8_STAGE(PG8_SB(1, 1), cB + hstep + kstep, voffB);
        PG8_WAIT_V(6); PG8_BAR;
    } else {
        PG8_STAGE(PG8_SB(0, 0), cB, voffB); PG8_STAGE(PG8_SA(0, 0), cA, voffA); PG8_STAGE(PG8_SB(0, 1), cB + hstep, voffB); PG8_STAGE(PG8_SA(0, 1), cA + hstep, voffA);
        if (wr == 1) PG8_BAR;
        PG8_WAIT_V(4); PG8_BAR;
        PG8_STAGE(PG8_SB(1, 0), cB + kstep, voffB); PG8_STAGE(PG8_SA(1, 0), cA + kstep, voffA); PG8_STAGE(PG8_SB(1, 1), cB + hstep + kstep, voffB);
        PG8_WAIT_V(6); PG8_BAR;
    }
    for (;;) {
        const bool has_next = S.next(ui + 1, nxt);
        const char* nA = has_next ? (const char*)g.A + (size_t)nxt.pm * tstep : cA; const char* nB = has_next ? (const char*)g.Bt + (size_t)nxt.pn * tstep : cB;
        for (int t = 0; t < nt; t += 2) {
            const bool last = (t == nt - 2);
            const char* a1 = cA + (size_t)(t + 1) * kstep;
            const char* a2 = last ? nA : cA + (size_t)(t + 2) * kstep; const char* b2 = last ? nB : cB + (size_t)(t + 2) * kstep;
            const char* a3 = a2 + kstep; const char* b3 = b2 + kstep;
            if (last && has_next) S.a_ready(nxt);
            if constexpr (SP2) {
            PG8_LDB(B0, 0, 0); PG8_LDB(B1, 0, 1); PG8_SCHED; PG8_LDA(At, 0, 0); PG8_STAGE(PG8_SA(1, 1), a1 + hstep, voffA);
            PG8_WAIT_V(8); PG8_WAIT_L(0); PG8_BAR; PG8_MMA(0, 0, At, B0); PG8_MMA(0, 1, At, B1); PG8_BAR; PG8_SCHED;
            PG8_LDA(At, 0, 1); PG8_STAGE(PG8_SB(0, 0), b2, voffB); PG8_STAGE(PG8_SB(0, 1), b2 + hstep, voffB); PG8_STAGE(PG8_SA(0, 0), a2, voffA);
            PG8_WAIT_V(8); PG8_WAIT_L(0); PG8_BAR; PG8_MMA(1, 0, At, B0); PG8_MMA(1, 1, At, B1); PG8_BAR; PG8_SCHED;
            PG8_LDB(B0, 1, 0); PG8_LDB(B1, 1, 1); PG8_SCHED; PG8_LDA(At, 1, 0); PG8_STAGE(PG8_SA(0, 1), a2 + hstep, voffA);
            PG8_WAIT_V(8); PG8_WAIT_L(0); PG8_BAR; PG8_MMA(0, 0, At, B0); PG8_MMA(0, 1, At, B1); PG8_BAR; PG8_SCHED;
            PG8_LDA(At, 1, 1); PG8_STAGE(PG8_SB(1, 0), b3, voffB); PG8_STAGE(PG8_SB(1, 1), b3 + hstep, voffB); PG8_STAGE(PG8_SA(1, 0), a3, voffA);
            PG8_WAIT_V(8); PG8_WAIT_L(0); PG8_BAR; PG8_MMA(1, 0, At, B0); PG8_MMA(1, 1, At, B1); PG8_BAR; PG8_SCHED;
            } else {
            PG8_LDB(B0, 0, 0); PG8_SCHED; PG8_LDA(At, 0, 0); PG8_STAGE(PG8_SA(1, 1), a1 + hstep, voffA);
            PG8_WAIT_L(8); PG8_BAR; PG8_WAIT_L(0); PG8_MMA(0, 0, At, B0); PG8_BAR; PG8_SCHED;
            PG8_LDB(B1, 0, 1); PG8_STAGE(PG8_SB(0, 0), b2, voffB);
            PG8_BAR; PG8_WAIT_L(0); PG8_MMA(0, 1, At, B1); PG8_BAR;
            PG8_LDA(At, 0, 1); PG8_STAGE(PG8_SA(0, 0), a2, voffA);
            PG8_BAR; PG8_WAIT_L(0); PG8_MMA(1, 0, At, B0); PG8_BAR; PG8_SCHED;
            PG8_STAGE(PG8_SB(0, 1), b2 + hstep, voffB);
            PG8_WAIT_V(6); PG8_BAR; PG8_MMA(1, 1, At, B1); PG8_BAR;
            PG8_LDB(B0, 1, 0); PG8_SCHED; PG8_LDA(At, 1, 0); PG8_STAGE(PG8_SA(0, 1), a2 + hstep, voffA);
            PG8_WAIT_L(8); PG8_BAR; PG8_WAIT_L(0); PG8_MMA(0, 0, At, B0); PG8_BAR; PG8_SCHED;
            PG8_LDB(B1, 1, 1); PG8_STAGE(PG8_SB(1, 0), b3, voffB);
            PG8_BAR; PG8_WAIT_L(0); PG8_MMA(0, 1, At, B1); PG8_BAR;
            PG8_LDA(At, 1, 1); PG8_STAGE(PG8_SA(1, 0), a3, voffA);
            PG8_BAR; PG8_WAIT_L(0); PG8_MMA(1, 0, At, B0); PG8_BAR; PG8_SCHED;
            PG8_STAGE(PG8_SB(1, 1), b3 + hstep, voffB);
            PG8_WAIT_V(6); PG8_BAR; PG8_MMA(1, 1, At, B1); PG8_BAR;
            }
        }
        if constexpr (ALIGN_EPI) { if (wr == 0) PG8_BAR; }
        if constexpr (!Epi::AFTER_DRAIN) { E(acc, cur, wr, wc, fr, fq); S.done(cur); }
        if (!has_next) break;
#pragma unroll
        for (int a = 0; a < 2; ++a)
#pragma unroll
            for (int b = 0; b < 2; ++b)
#pragma unroll
                for (int m = 0; m < 4; ++m)
#pragma unroll
                    for (int n = 0; n < 2; ++n) acc[a][b][m][n] = (f32x4){0.f, 0.f, 0.f, 0.f};
        cur = nxt; cA = nA; cB = nB; ++ui;
        if constexpr (ALIGN_EPI) { if (wr == 1) PG8_BAR; }
    }
    PG8_WAIT_V(0);
    if constexpr (!ALIGN_EPI) { if (wr == 0) PG8_BAR; }
    PG8_BAR;
    if constexpr (Epi::AFTER_DRAIN) { E.fused(acc, cur, wr, wc, fr, fq, lds, wid, lane); S.done(cur); }
#undef PG8_SA
#undef PG8_SB
#undef PG8_STAGE
#undef PG8_LDA
#undef PG8_LDB
#undef PG8_MMA
#undef PG8_WAIT_V
#undef PG8_WAIT_L
#undef PG8_BAR
#undef PG8_SCHED
}
}

#define LAS __attribute__((address_space(3)))
typedef unsigned short bf16;
typedef short bf16x8 __attribute__((ext_vector_type(8)));
typedef short s16x4 __attribute__((ext_vector_type(4)));
typedef float f32x4 __attribute__((ext_vector_type(4)));
typedef unsigned u32x4 __attribute__((ext_vector_type(4)));
typedef unsigned u32x2 __attribute__((ext_vector_type(2)));
#define MFMA16(a, b, c) __builtin_amdgcn_mfma_f32_16x16x32_bf16((a), (b), (c), 0, 0, 0)

constexpr int T = 32768, D = 1024, SEQ = 8192, NTHR = 512;
constexpr int LDS_BYTES = 163840, XCH_OFF = 131072;
constexpr size_t MiB = 1u << 20;
constexpr size_t WS_W = 0;
constexpr size_t W_IN = 0, W_SOUT = W_IN + (size_t)6400 * 1024, W_FIN0 = W_SOUT + (size_t)1024 * 2048, W_FIN1 = W_FIN0 + (size_t)5632 * 1024,
                 W_FOUT0 = W_FIN1 + (size_t)5632 * 1024, W_FOUT1 = W_FOUT0 + (size_t)1024 * 2816, W_K = W_FOUT1 + (size_t)1024 * 2816, W_V = W_K + 1048576, W_Q = W_V + 1048576,
                 W_O = W_Q + 1048576, W_END = W_O + 1048576;
static_assert(W_END * 2 <= 58 * MiB, "weights fit");
constexpr size_t WS_MODS = 58 * MiB;
constexpr size_t WS_SUMSQ = 59 * MiB;
constexpr size_t WS_FLAGS = 60 * MiB;
constexpr size_t WS_BAR = 61 * MiB;
constexpr size_t WS_X = 64 * MiB;
constexpr size_t WS_BIG = 192 * MiB;
constexpr size_t WS_END = 448 * MiB;
constexpr int MOD_L = 6144, MOD_KV = 12288, MOD_FIN = 14336, MOD_N = 16384;

#ifdef PROBE
#define STAMP(k) do { if (blockIdx.x == 0 && threadIdx.x == 0) { __threadfence(); TS[k] = __builtin_amdgcn_s_memrealtime(); __threadfence(); } } while (0)
#else
#define STAMP(k) do {} while (0)
#endif
struct Params { const float* in[28]; float* out; unsigned char* ws; };

__device__ __forceinline__ float bf2f(unsigned u) { return __uint_as_float(u << 16); }
typedef float f32x2_t __attribute__((ext_vector_type(2))); typedef __bf16 bf16x2_t __attribute__((ext_vector_type(2)));
__device__ __forceinline__ unsigned pk2(float lo, float hi) { f32x2_t v = {lo, hi}; bf16x2_t b = __builtin_convertvector(v, bf16x2_t); return __builtin_bit_cast(unsigned, b); }
__device__ __forceinline__ unsigned f2bf(float f) { return pk2(f, 0.f) & 0xffffu; }
__device__ __forceinline__ float wave_sum(float v) {
#pragma unroll
    for (int o = 1; o < 64; o <<= 1) v += __shfl_xor(v, o);
    return v;
}
using pg8::silu_f; using pg8::softplus_f;

__device__ __forceinline__ void p0_item(const float* W, int K, int Nsrc, bf16* WT, int dst_n0, int src_n0, int k0, LAS float* scr, int lane) {
    const int c = lane & 7;
    if (src_n0 < 0) {
#pragma unroll
        for (int j = 0; j < 4; ++j) { const int n = (lane >> 3) + 8 * j; *(u32x4*)(WT + (size_t)(dst_n0 + n) * K + k0 + 8 * c) = (u32x4){0u, 0u, 0u, 0u}; }
        return;
    }
#pragma unroll 8
    for (int i = 0; i < 32; ++i) { const int kk = 2 * i + (lane >> 5); scr[kk * 33 + (lane & 31)] = __builtin_nontemporal_load(W + (size_t)(k0 + kk) * Nsrc + src_n0 + (lane & 31)); }
    asm volatile("s_waitcnt lgkmcnt(0)" ::: "memory");
#pragma unroll
    for (int j = 0; j < 4; ++j) { const int n = (lane >> 3) + 8 * j; const LAS float* s = scr + (8 * c) * 33 + n;
        u32x4 o; o.x = pk2(s[0 * 33], s[1 * 33]); o.y = pk2(s[2 * 33], s[3 * 33]); o.z = pk2(s[4 * 33], s[5 * 33]); o.w = pk2(s[6 * 33], s[7 * 33]);
        *(u32x4*)(WT + (size_t)(dst_n0 + n) * K + k0 + 8 * c) = o; }
    asm volatile("s_waitcnt lgkmcnt(0)" ::: "memory");
}
__device__ __forceinline__ void p0_phase(const Params& p, LAS unsigned char* L) {
    const int tid = threadIdx.x, lane = tid & 63, wave = __builtin_amdgcn_readfirstlane(tid >> 6);
    bf16* WB = (bf16*)(p.ws + WS_W);
    float* MODS = (float*)(p.ws + WS_MODS); float* SUMSQ = (float*)(p.ws + WS_SUMSQ);
    if (blockIdx.x == 0 && tid < 64) ((unsigned*)(p.ws + WS_FLAGS))[tid] = 0u;
    LAS float* cs = (LAS float*)L; LAS float* part = (LAS float*)(L + 16384);
    for (int i = tid; i < 4096; i += NTHR) cs[i] = silu_f(p.in[1][i]);
    __syncthreads();
    for (int jb = blockIdx.x; jb < MOD_N / 64; jb += gridDim.x) {
        const int j = jb * 64 + lane; const float* Wsrc; const float* bsrc; int stride, jj;
        if (j < MOD_KV) { const int l = j / MOD_L; jj = j - l * MOD_L; Wsrc = p.in[2] + (size_t)l * D * MOD_L; bsrc = p.in[3] + l * MOD_L; stride = MOD_L; }
        else if (j < MOD_FIN) { jj = j - MOD_KV; Wsrc = p.in[14]; bsrc = p.in[15]; stride = 2048; }
        else { jj = j - MOD_FIN; Wsrc = p.in[25]; bsrc = p.in[26]; stride = 2048; }
        float a0 = 0.f, a1 = 0.f, a2 = 0.f, a3 = 0.f;
#pragma unroll 8
        for (int k = wave * 128; k < wave * 128 + 128; ++k) { const float wv = __builtin_nontemporal_load(Wsrc + (size_t)k * stride + jj); a0 += cs[k] * wv; a1 += cs[1024 + k] * wv; a2 += cs[2048 + k] * wv; a3 += cs[3072 + k] * wv; }
        part[(wave * 4 + 0) * 64 + lane] = a0; part[(wave * 4 + 1) * 64 + lane] = a1; part[(wave * 4 + 2) * 64 + lane] = a2; part[(wave * 4 + 3) * 64 + lane] = a3;
        __syncthreads();
        if (tid < 256) { const int b = tid >> 6; float s = 0.f;
#pragma unroll
            for (int w = 0; w < 8; ++w) s += part[(w * 4 + b) * 64 + lane];
            MODS[(size_t)b * MOD_N + j] = s + bsrc[jj]; }
        __syncthreads();
    }
    LAS float* scr = (LAS float*)(L + wave * 16384);
    const int gw = blockIdx.x * 8 + wave, NGW = gridDim.x * 8;
    constexpr int NI0 = 16 * 200, NI1 = 32 * 32, NI2 = 16 * 176, NI3 = 44 * 32, NI4 = 16 * 32;
    constexpr int NITEMS = NI0 + NI1 + 2 * NI2 + 2 * NI3 + 4 * NI4;
    for (int it = gw; it < NITEMS; it += NGW) {
        int r = it;
        if (r < NI0) { const int kb = r / 200, nb = r % 200; const int dn = nb * 32; const int sn = dn < 2048 ? dn : dn < 2080 ? 6144 + (dn - 2048) : dn < 2304 ? -1 : 2048 + (dn - 2304); p0_item(p.in[6], 1024, 6176, WB + W_IN, dn, sn, kb * 64, scr, lane); continue; } r -= NI0;
        if (r < NI1) { const int kb = r / 32, nb = r % 32; p0_item(p.in[13], 2048, 1024, WB + W_SOUT, nb * 32, nb * 32, kb * 64, scr, lane); continue; } r -= NI1;
        if (r < 2 * NI2) { const int l = r / NI2; r -= l * NI2; const int kb = r / 176, nb = r % 176; const int dn = nb * 32; const int sn = (dn >> 8) * 128 + (dn & 127) + ((dn & 255) >= 128 ? 2816 : 0);
            p0_item(p.in[21] + (size_t)l * 1024 * 5632, 1024, 5632, WB + (l ? W_FIN1 : W_FIN0), dn, sn, kb * 64, scr, lane); continue; } r -= 2 * NI2;
        if (r < 2 * NI3) { const int l = r / NI3; r -= l * NI3; const int kb = r / 32, nb = r % 32;
            p0_item(p.in[24] + (size_t)l * 2816 * 1024, 2816, 1024, WB + (l ? W_FOUT1 : W_FOUT0), nb * 32, nb * 32, kb * 64, scr, lane); continue; } r -= 2 * NI3;
        { const int q = r / NI4; r -= q * NI4; const int kb = r / 32, nb = r % 32; const float* src = q == 0 ? p.in[17] : q == 1 ? p.in[18] : q == 2 ? p.in[19] : p.in[20];
            bf16* dst = WB + (q == 0 ? W_K : q == 1 ? W_V : q == 2 ? W_Q : W_O);
            p0_item(src, 1024, 1024, dst, nb * 32, nb * 32, kb * 64, scr, lane); }
    }
}

template <int NOUT, bool F32OUT>
__device__ __forceinline__ void norm_phase(const float* X, const float* g0, const float* mod0, void* out0, const float* g1, const float* mod1, void* out1) {
    int tid_ = threadIdx.x; asm volatile("" : "+v"(tid_));
    const int tid = tid_, lane = tid & 63, wave = tid >> 6;
    const int gw = blockIdx.x * 8 + wave, NGW = gridDim.x * 8;
    for (int row = gw; row < T; row += NGW) {
        const int b = row >> 13;
        const f32x4* xr = (const f32x4*)(X + (size_t)row * D) + lane;
        f32x4 v[4]; float s = 0.f;
#pragma unroll
        for (int j = 0; j < 4; ++j) { v[j] = __builtin_nontemporal_load(xr + 64 * j); s += (v[j].x * v[j].x + v[j].y * v[j].y) + (v[j].z * v[j].z + v[j].w * v[j].w); }
        const float rstd = rsqrtf(wave_sum(s) * (1.f / D) + 1e-6f);
#pragma unroll
        for (int o = 0; o < NOUT; ++o) {
            const float* g = o ? g1 : g0; const float* md = (o ? mod1 : mod0) + (size_t)b * MOD_N; void* out = o ? out1 : out0;
#pragma unroll
            for (int j = 0; j < 4; ++j) { const int col = 4 * lane + 256 * j;
                const f32x4 gv = *(const f32x4*)(g + col), sh = *(const f32x4*)(md + col), sc = *(const f32x4*)(md + 1024 + col);
                const f32x4 y = v[j] * rstd * gv * (sc + 1.0f) + sh;
                if (F32OUT) *(f32x4*)((float*)out + (size_t)row * D + col) = y;
                else { u32x2 w; w.x = pk2(y.x, y.y); w.y = pk2(y.z, y.w); *(u32x2*)((bf16*)out + (size_t)row * D + col) = w; } }
        }
    }
}

template <int NOUT, bool F32OUT>
__device__ __forceinline__ void norm_phase_b(const bf16* X, const float* g0, const float* mod0, void* out0, const float* g1, const float* mod1, void* out1) {
    int tid_ = threadIdx.x; asm volatile("" : "+v"(tid_));
    const int tid = tid_, lane = tid & 63, wave = tid >> 6;
    const int gw = blockIdx.x * 8 + wave, NGW = gridDim.x * 8;
    for (int row = gw; row < T; row += NGW) {
        const int b = row >> 13;
        float v[2][8]; float s = 0.f;
#pragma unroll
        for (int j = 0; j < 2; ++j) { const u32x4 xb = *(const u32x4*)(X + (size_t)row * D + 8 * lane + 512 * j);
#pragma unroll
            for (int e = 0; e < 4; ++e) { v[j][2 * e] = __uint_as_float(xb[e] << 16); v[j][2 * e + 1] = __uint_as_float(xb[e] & 0xffff0000u); }
#pragma unroll
            for (int e = 0; e < 8; ++e) s += v[j][e] * v[j][e]; }
        const float rstd = rsqrtf(wave_sum(s) * (1.f / D) + 1e-6f);
#pragma unroll
        for (int o = 0; o < NOUT; ++o) {
            const float* g = o ? g1 : g0; const float* md = (o ? mod1 : mod0) + (size_t)b * MOD_N; void* out = o ? out1 : out0;
#pragma unroll
            for (int j = 0; j < 2; ++j) { const int col = 8 * lane + 512 * j; float y[8];
#pragma unroll
                for (int q = 0; q < 2; ++q) { const f32x4 gv = *(const f32x4*)(g + col + 4 * q), sh = *(const f32x4*)(md + col + 4 * q), sc = *(const f32x4*)(md + 1024 + col + 4 * q);
#pragma unroll
                    for (int e = 0; e < 4; ++e) y[4 * q + e] = v[j][4 * q + e] * rstd * gv[e] * (sc[e] + 1.0f) + sh[e]; }
                if (F32OUT) { *(f32x4*)((float*)out + (size_t)row * D + col) = (f32x4){y[0], y[1], y[2], y[3]}; *(f32x4*)((float*)out + (size_t)row * D + col + 4) = (f32x4){y[4], y[5], y[6], y[7]}; }
                else { u32x4 w; w.x = pk2(y[0], y[1]); w.y = pk2(y[2], y[3]); w.z = pk2(y[4], y[5]); w.w = pk2(y[6], y[7]); *(u32x4*)((bf16*)out + (size_t)row * D + col) = w; } }
        }
    }
}

__device__ __forceinline__ void fixup_mamba(const float* P, const float* UH, const float* cw, const float* cb, bf16* XBC) {
    const int total = 128 * 3 * 4096;
    for (int i = blockIdx.x * NTHR + threadIdx.x; i < total; i += gridDim.x * NTHR) {
        const int ch = i & 4095, r = (i >> 12) % 3, pm = i / (3 * 4096); const int c = ch;
        float v = P[((size_t)pm * 3 + r) * 4096 + c];
        if (pm & 31) { for (int k = r + 1; k <= 3; ++k) v += cw[(3 - k) * 4096 + ch] * UH[((size_t)(pm - 1) * 3 + (3 + r - k)) * 4096 + c]; }
        XBC[(size_t)(pm * 256 + r) * 4096 + ch] = (bf16)f2bf(silu_f(v));
    }
}
__device__ __forceinline__ void fixup_ffn(const float* P, const float* UH, const float* cw, const float* cb, bf16* G) {
    const int total = 128 * 2 * 2816;
    for (int i = blockIdx.x * NTHR + threadIdx.x; i < total; i += gridDim.x * NTHR) {
        const int j = i % 2816, r = (i / 2816) & 1, pm = i / (2 * 2816); const int cg_ = (j >> 7) * 256 + (j & 127), cv_ = cg_ + 128;
        float g = P[((size_t)pm * 2 + r) * 5632 + cg_], v = P[((size_t)pm * 2 + r) * 5632 + cv_];
        if (pm & 31) { for (int k = r + 1; k <= 2; ++k) { const size_t ro = ((size_t)(pm - 1) * 2 + (2 + r - k)) * 5632;
            g += cw[(2 - k) * 5632 + j] * UH[ro + cg_]; v += cw[(2 - k) * 5632 + 2816 + j] * UH[ro + cv_]; } }
        G[(size_t)(pm * 256 + r) * 2816 + j] = (bf16)f2bf(silu_f(g) * v);
    }
}

constexpr int SSD_CS = 0, SSD_BS = 34816, SSD_XT = 69632, SSD_XDT = 78336, SSD_HS0 = 87040, SSD_HS1 = 95744, SSD_ACS = 104448, SSD_WSCR = 104960;
__device__ __forceinline__ void acs_phase(const float* DT, const float* a_log, float* ACS) {
    const int lane = threadIdx.x & 63, wave = threadIdx.x >> 6;
    const int h = lane & 31, sub = lane >> 5; const float A = -__expf(a_log[h]);
    for (int task = blockIdx.x * 8 + wave; task < 256; task += gridDim.x * 8) {
        const size_t tok0 = (size_t)task * 128 + sub * 64;
        float s = 0.f;
#pragma unroll 8
        for (int i = 0; i < 64; ++i) s += DT[(tok0 + i) * 32 + h] * A;
        const float s0 = __shfl(s, h);
        float run = sub ? s0 : 0.f;
#pragma unroll 8
        for (int i = 0; i < 64; ++i) { run += DT[(tok0 + i) * 32 + h] * A; ACS[(tok0 + i) * 32 + h] = run; }
    }
}
template <int LT> __device__ __forceinline__ void ssd_diag(const LAS bf16* Bs, const LAS bf16* XTs, const LAS float* acs_s, const bf16x8 (&cf)[4], float acs_l, int r16, int quad, f32x4 (&Yd)[2]) {
#pragma unroll
    for (int t = 0; t <= (LT >> 1); ++t) {
        f32x4 mm[2];
#pragma unroll
        for (int hf = 0; hf < 2; ++hf) { const int st = 2 * t + hf; mm[hf] = (f32x4){0.f, 0.f, 0.f, 0.f};
            if (st <= LT) { f32x4 acc = (f32x4){0.f, 0.f, 0.f, 0.f};
#pragma unroll
                for (int ks = 0; ks < 4; ++ks) { const bf16x8 af = *(const LAS bf16x8*)(Bs + (16 * st + r16) * 136 + ks * 32 + quad * 8); acc = MFMA16(af, cf[ks], acc); }
                const f32x4 as4 = *(const LAS f32x4*)(acs_s + 16 * st + 4 * quad);
#pragma unroll
                for (int j = 0; j < 4; ++j) { const float v = acc[j] * __expf(acs_l - as4[j]); mm[hf][j] = (st == LT && (4 * quad + j > r16)) ? 0.f : v; } } }
        u32x4 mp; mp.x = pk2(mm[0][0], mm[0][1]); mp.y = pk2(mm[0][2], mm[0][3]); mp.z = pk2(mm[1][0], mm[1][1]); mp.w = pk2(mm[1][2], mm[1][3]);
        const bf16x8 mf = __builtin_bit_cast(bf16x8, mp);
#pragma unroll
        for (int pt = 0; pt < 2; ++pt) { const LAS bf16* xp = XTs + (16 * pt + r16) * 136 + 32 * t + 4 * quad;
            const u32x2 lo = *(const LAS u32x2*)xp, hi = *(const LAS u32x2*)(xp + 16);
            const bf16x8 xf = __builtin_bit_cast(bf16x8, ((u32x4){lo.x, lo.y, hi.x, hi.y}));
            Yd[pt] = MFMA16(mf, xf, Yd[pt]); }
    }
}
__device__ __forceinline__ void ssreduce_phase(const float* PS, float* RS) {
    for (int t = blockIdx.x * NTHR + threadIdx.x; t < T; t += gridDim.x * NTHR) { float s = 0.f;
#pragma unroll 16
        for (int q = 0; q < 64; ++q) s += PS[(size_t)q * T + t];
        RS[t] = rsqrtf(s * (1.0f / 2048.0f) + 1e-6f); }
}
template <bool REAL, int MODE = 15> __device__ __forceinline__ void ssd_phase(const bf16* XBC, bf16* Zb, const float* DT, const float* ACS, const float* a_log, const float* d_skip, const float* normg, float* SUMSQ, LAS unsigned char* L) {
    int tid_ = threadIdx.x; asm volatile("" : "+v"(tid_));
    const int tid = tid_, lane = tid & 63, w = __builtin_amdgcn_readfirstlane(tid >> 6), r16 = lane & 15, quad = lane >> 4;
    LAS bf16* Cs = (LAS bf16*)(L + SSD_CS); LAS bf16* Bs = (LAS bf16*)(L + SSD_BS); LAS bf16* XTs = (LAS bf16*)(L + SSD_XT); LAS bf16* XDs = (LAS bf16*)(L + SSD_XDT);
    LAS float* acs_s = (LAS float*)(L + SSD_ACS);
    LAS bf16* Wx = (LAS bf16*)(L + SSD_WSCR + w * 3840); LAS bf16* Wz = Wx + 640; LAS bf16* Wy = Wx + 1280;
    const int lt = w < 4 ? w : 11 - w;
    const int vcu = (gridDim.x == 256) ? (int)((blockIdx.x & 7) * 32 + (blockIdx.x >> 3)) : (int)blockIdx.x;
    for (int unit = vcu; unit < 256; unit += gridDim.x) {
        const int b = unit >> 6, h = (unit >> 1) & 31, ph = unit & 1, g = h >> 2;
        const float Dh = d_skip[h];
        const int xcol = h * 64 + ph * 32;
        const float ng0 = normg[xcol + r16], ng1 = normg[xcol + 16 + r16];
        for (int i = tid; i < 8704 / 4; i += NTHR) ((LAS unsigned*)(L + SSD_HS0))[i] = 0u;
        f32x4 Hst[2][2]; Hst[0][0] = Hst[0][1] = Hst[1][0] = Hst[1][1] = (f32x4){0.f, 0.f, 0.f, 0.f};
        int hb = 0;
        const int srow = tid >> 4, sg = tid & 15, lr = lane >> 2, part = lane & 3, lx = 16 * lt + lr;
        u32x4 cv[4], bv[4], xv, zv; float dtl, acl, aclast, a01;
#define SSD_LOAD(c_) do { const size_t tk = (size_t)b * SEQ + (size_t)(c_) * 128; \
            _Pragma("unroll") for (int i = 0; i < 4; ++i) { const bf16* src = XBC + (tk + srow + 32 * i) * 4096 + g * 128 + sg * 8; cv[i] = *(const u32x4*)(src + 3072); bv[i] = *(const u32x4*)(src + 2048); } \
            xv = *(const u32x4*)(XBC + (tk + lx) * 4096 + xcol + part * 8); zv = *(const u32x4*)(Zb + (tk + lx) * 2048 + xcol + part * 8); \
            dtl = DT[(tk + lx) * 32 + h]; acl = ACS[(tk + lx) * 32 + h]; aclast = ACS[(tk + 127) * 32 + h]; a01 = ACS[(tk + 2 * w * 0 + (tid & 127)) * 32 + h]; } while (0)
        SSD_LOAD(0);
        for (int c = 0; c < 64; ++c) {
            const size_t tok0 = (size_t)b * SEQ + (size_t)c * 128;
#pragma unroll
            for (int i = 0; i < 4; ++i) { const int l = srow + 32 * i; *(LAS u32x4*)(Cs + l * 136 + sg * 8) = cv[i]; *(LAS u32x4*)(Bs + l * 136 + sg * 8) = bv[i]; }
            if (tid < 128) acs_s[tid] = a01;
            const float acs_last = aclast;
            { const float dec = __expf(acs_last - acl);
                *(LAS u32x4*)(Wx + lr * 40 + part * 8) = xv; *(LAS u32x4*)(Wz + lr * 40 + part * 8) = zv;
#pragma unroll
                for (int e = 0; e < 8; ++e) { const unsigned xb = (xv[e >> 1] >> (16 * (e & 1))) & 0xffffu; const float xd = bf2f(xb) * dtl;
                    XTs[(part * 8 + e) * 136 + lx] = (bf16)f2bf(xd); XDs[(part * 8 + e) * 136 + lx] = (bf16)f2bf(xd * dec); } }
            __syncthreads();
            if (c < 63) SSD_LOAD(c + 1);
            __builtin_amdgcn_sched_barrier(0);
            bf16x8 cf[4];
#pragma unroll
            for (int ks = 0; ks < 4; ++ks) cf[ks] = *(const LAS bf16x8*)(Cs + (16 * lt + r16) * 136 + ks * 32 + quad * 8);
            const float acs_l = acs_s[16 * lt + r16];
            f32x4 Yd[2], Yo[2]; Yd[0] = Yd[1] = Yo[0] = Yo[1] = (f32x4){0.f, 0.f, 0.f, 0.f};
            if constexpr ((MODE & 1) != 0)
            switch (lt) {
                case 0: ssd_diag<0>(Bs, XTs, acs_s, cf, acs_l, r16, quad, Yd); break; case 1: ssd_diag<1>(Bs, XTs, acs_s, cf, acs_l, r16, quad, Yd); break;
                case 2: ssd_diag<2>(Bs, XTs, acs_s, cf, acs_l, r16, quad, Yd); break; case 3: ssd_diag<3>(Bs, XTs, acs_s, cf, acs_l, r16, quad, Yd); break;
                case 4: ssd_diag<4>(Bs, XTs, acs_s, cf, acs_l, r16, quad, Yd); break; case 5: ssd_diag<5>(Bs, XTs, acs_s, cf, acs_l, r16, quad, Yd); break;
                case 6: ssd_diag<6>(Bs, XTs, acs_s, cf, acs_l, r16, quad, Yd); break; default: ssd_diag<7>(Bs, XTs, acs_s, cf, acs_l, r16, quad, Yd); break; }
            if constexpr ((MODE & 2) != 0)
            { const LAS bf16* Hc = (const LAS bf16*)(L + (hb ? SSD_HS1 : SSD_HS0));
#pragma unroll
                for (int pt = 0; pt < 2; ++pt)
#pragma unroll
                    for (int ks = 0; ks < 4; ++ks) { const bf16x8 hf = *(const LAS bf16x8*)(Hc + (16 * pt + r16) * 136 + ks * 32 + quad * 8); Yo[pt] = MFMA16(cf[ks], hf, Yo[pt]); } }
            if constexpr ((MODE & 4) != 0) {
            float ssq[4] = {0.f, 0.f, 0.f, 0.f};
            { const f32x4 al4 = *(const LAS f32x4*)(acs_s + 16 * lt + 4 * quad);
#pragma unroll
            for (int j = 0; j < 4; ++j) { const int lrow = 4 * quad + j; const float el = __expf(al4[j]);
#pragma unroll
                for (int pt = 0; pt < 2; ++pt) { const int pcol = 16 * pt + r16;
                    float y = Yd[pt][j] + el * Yo[pt][j];
                    y += Dh * bf2f(Wx[lrow * 40 + pcol]);
                    const float gz = y * silu_f(bf2f(Wz[lrow * 40 + pcol])); ssq[j] += gz * gz;
                    Wy[lrow * 40 + pcol] = (bf16)f2bf(gz * (pt ? ng1 : ng0)); } } }
#pragma unroll
            for (int j = 0; j < 4; ++j) { float v = ssq[j]; v += __shfl_xor(v, 1); v += __shfl_xor(v, 2); v += __shfl_xor(v, 4); v += __shfl_xor(v, 8); ssq[j] = v; }
            { const float sv = r16 == 0 ? ssq[0] : r16 == 1 ? ssq[1] : r16 == 2 ? ssq[2] : ssq[3];
                if (r16 < 4) SUMSQ[(size_t)(h * 2 + ph) * T + tok0 + 16 * lt + 4 * quad + r16] = sv; }
            asm volatile("s_waitcnt lgkmcnt(0)" ::: "memory");
            { const u32x4 yv = *(const LAS u32x4*)(Wy + lr * 40 + part * 8);
                if (REAL) *(u32x4*)(Zb + (tok0 + 16 * lt + lr) * 2048 + xcol + part * 8) = yv; }
            } else { if (Yd[0][0] + Yd[1][0] + Yo[0][0] + Yo[1][0] == 12345.f) Wy[0] = 1; }
            if (((MODE & 8) != 0) && w < 4) {
                f32x4 a4[2][2];
#pragma unroll
                for (int q = 0; q < 2; ++q) a4[q][0] = a4[q][1] = (f32x4){0.f, 0.f, 0.f, 0.f};
#pragma unroll
                for (int ks = 0; ks < 4; ++ks) { bf16x8 af[2];
#pragma unroll
                    for (int pt = 0; pt < 2; ++pt) af[pt] = *(const LAS bf16x8*)(XDs + (16 * pt + r16) * 136 + ks * 32 + quad * 8);
#pragma unroll
                    for (int q = 0; q < 2; ++q) { bf16x8 bfr;
#pragma unroll
                        for (int j = 0; j < 8; ++j) bfr[j] = (short)Bs[(ks * 32 + quad * 8 + j) * 136 + 16 * (2 * w + q) + r16];
#pragma unroll
                        for (int pt = 0; pt < 2; ++pt) a4[q][pt] = MFMA16(af[pt], bfr, a4[q][pt]); } }
                const float cd = __expf(acs_last);
                LAS bf16* Hn = (LAS bf16*)(L + (hb ? SSD_HS0 : SSD_HS1));
#pragma unroll
                for (int q = 0; q < 2; ++q)
#pragma unroll
                    for (int pt = 0; pt < 2; ++pt)
#pragma unroll
                        for (int j = 0; j < 4; ++j) { const float hv = Hst[q][pt][j] * cd + a4[q][pt][j]; Hst[q][pt][j] = hv; Hn[(16 * pt + 4 * quad + j) * 136 + 16 * (2 * w + q) + r16] = (bf16)f2bf(hv); }
            }
            hb ^= 1;
            __syncthreads();
        }
#undef SSD_LOAD
    }
}

constexpr int AT_KS = 0, AT_VS = 18432, AT_SMAX = 35840;
template <bool DIAG, int NKT> __device__ __forceinline__ float att_elem(f32x4 (&S)[8], float suffix, int q_rel, int quad) {
    f32x4 Lg[8];
#pragma unroll
    for (int kt = 0; kt < NKT; ++kt) { const f32x4 y = S[kt]; f32x4 sp;
#pragma unroll
        for (int j = 0; j < 4; ++j) sp[j] = __builtin_amdgcn_logf(1.0f + __builtin_amdgcn_exp2f(-__builtin_fabsf(y[j])));
        f32x4 lg = -(sp + __builtin_elementwise_max(y, (f32x4){0.f, 0.f, 0.f, 0.f}));
        if (DIAG) {
#pragma unroll
            for (int j = 0; j < 4; ++j) if (!(16 * kt + 4 * quad + j < q_rel)) lg[j] = 0.f; }
        lg[2] += lg[3]; lg[1] += lg[2]; lg[0] += lg[1]; Lg[kt] = lg; }
    float tail = 0.f;
#pragma unroll
    for (int kt = NKT - 1; kt >= 0; --kt) { const float a = Lg[kt][0]; const float bq = __shfl_xor(a, 16), cq = __shfl_xor(a, 32), dq = __shfl_xor(bq, 32);
        const float E = quad == 0 ? (bq + cq + dq) : quad == 1 ? (cq + dq) : quad == 2 ? bq : 0.f;
        Lg[kt] = Lg[kt] + (E + tail);
        tail += (a + bq) + (cq + dq); }
#pragma unroll
    for (int kt = 0; kt < NKT; ++kt) { const f32x4 lw = (S[kt] + Lg[kt]) + suffix;
#pragma unroll
        for (int j = 0; j < 4; ++j) { float wv = __builtin_amdgcn_exp2f(lw[j]); if (DIAG && !(16 * kt + 4 * quad + j < q_rel)) wv = 0.f; S[kt][j] = wv; } }
    return tail;
}
template <bool DIAG, int NKT> __device__ __forceinline__ float att_block(const LAS bf16* Ks, const LAS bf16* Vs, const bf16x8 (&qf)[2], f32x4 (&O)[4], float suffix, int q_rel, int r16, int quad) {
    f32x4 S[8];
#pragma unroll
    for (int kt = 0; kt < 8; ++kt) S[kt] = (f32x4){0.f, 0.f, 0.f, 0.f};
#pragma unroll
    for (int kt = 0; kt < NKT; ++kt)
#pragma unroll
        for (int ks = 0; ks < 2; ++ks) { const bf16x8 kf = *(const LAS bf16x8*)(Ks + (16 * kt + r16) * 72 + ks * 32 + quad * 8); S[kt] = MFMA16(kf, qf[ks], S[kt]); }
    const float tail = att_elem<DIAG, NKT>(S, suffix, q_rel, quad);
#pragma unroll
    for (int t = 0; t < (NKT + 1) / 2; ++t) { u32x4 wp; wp.x = pk2(S[2 * t][0], S[2 * t][1]); wp.y = pk2(S[2 * t][2], S[2 * t][3]); wp.z = pk2(S[2 * t + 1][0], S[2 * t + 1][1]); wp.w = pk2(S[2 * t + 1][2], S[2 * t + 1][3]);
        const bf16x8 wf = __builtin_bit_cast(bf16x8, wp);
#pragma unroll
        for (int dt = 0; dt < 4; ++dt) { const LAS bf16* vp = Vs + (16 * dt + r16) * 136 + 32 * t + 4 * quad;
            const u32x2 lo = *(const LAS u32x2*)vp, hi = *(const LAS u32x2*)(vp + 16);
            const bf16x8 vf = __builtin_bit_cast(bf16x8, ((u32x4){lo.x, lo.y, hi.x, hi.y}));
            O[dt] = MFMA16(wf, vf, O[dt]); } }
    return tail;
}
template <bool REAL> __device__ __forceinline__ void attn_phase(bf16* QO, const bf16* Kb, const bf16* VT, LAS unsigned char* L) {
    int tid_ = threadIdx.x; asm volatile("" : "+v"(tid_));
    const int tid = tid_, lane = tid & 63, w = __builtin_amdgcn_readfirstlane(tid >> 6), r16 = lane & 15, quad = lane >> 4;
    LAS bf16* Ks = (LAS bf16*)(L + AT_KS); LAS bf16* Vs = (LAS bf16*)(L + AT_VS); LAS float* smax_s = (LAS float*)(L + AT_SMAX);
    const int ks_s = tid >> 2, ks_p = tid & 3, vs_d = tid >> 3, vs_p = tid & 7;
    u32x4 pk0, pk1, pv0, pv1; bf16x8 qn[2];
#define ATT_LOAD(b_, h_, kb_) do { const bf16* src = Kb + ((size_t)(b_) * SEQ + (kb_) * 128 + ks_s) * 1024 + (h_) * 64 + ks_p * 16; pk0 = *(const u32x4*)src; pk1 = *(const u32x4*)(src + 8); \
        const bf16* vsrc = VT + (size_t)((h_) * 64 + vs_d) * T + (size_t)(b_) * SEQ + (kb_) * 128 + vs_p * 16; pv0 = *(const u32x4*)vsrc; pv1 = *(const u32x4*)(vsrc + 8); } while (0)
#define ATT_QLOAD(b_, h_, qb_) do { const size_t rq_ = (size_t)(b_) * SEQ + (qb_) * 128 + 16 * w; \
        _Pragma("unroll") for (int ks = 0; ks < 2; ++ks) qn[ks] = *(const bf16x8*)(QO + (rq_ + r16) * 1024 + (h_) * 64 + ks * 32 + quad * 8); } while (0)
    if ((int)blockIdx.x < 4096) { const int u0 = blockIdx.x, bh0 = u0 & 63, qb0 = 63 - (u0 >> 6); ATT_QLOAD(bh0 >> 4, bh0 & 15, qb0); ATT_LOAD(bh0 >> 4, bh0 & 15, qb0); }
    for (int unit = blockIdx.x; unit < 4096; unit += gridDim.x) {
        const int bh = unit & 63, qb = 63 - (unit >> 6), b = bh >> 4, h = bh & 15;
        const size_t rowq = (size_t)b * SEQ + qb * 128 + 16 * w;
        bf16x8 qf[2]; qf[0] = qn[0]; qf[1] = qn[1];
        f32x4 O[4]; O[0] = O[1] = O[2] = O[3] = (f32x4){0.f, 0.f, 0.f, 0.f};
        float suffix = 0.f, wsm = 0.f;
        const int q_rel = 16 * w + r16;
        for (int kb = qb; kb >= 0; --kb) {
            *(LAS u32x4*)(Ks + ks_s * 72 + ks_p * 16) = pk0; *(LAS u32x4*)(Ks + ks_s * 72 + ks_p * 16 + 8) = pk1;
            *(LAS u32x4*)(Vs + vs_d * 136 + vs_p * 16) = pv0; *(LAS u32x4*)(Vs + vs_d * 136 + vs_p * 16 + 8) = pv1;
            __syncthreads();
            if (kb > 0) ATT_LOAD(b, h, kb - 1);
            __builtin_amdgcn_sched_barrier(0);
            if (wsm > -160.f) {
                float tail;
                if (kb != qb) tail = att_block<false, 8>(Ks, Vs, qf, O, suffix, q_rel, r16, quad);
                else switch (w) {
                    case 0: tail = att_block<true, 1>(Ks, Vs, qf, O, suffix, q_rel, r16, quad); break; case 1: tail = att_block<true, 2>(Ks, Vs, qf, O, suffix, q_rel, r16, quad); break;
                    case 2: tail = att_block<true, 3>(Ks, Vs, qf, O, suffix, q_rel, r16, quad); break; case 3: tail = att_block<true, 4>(Ks, Vs, qf, O, suffix, q_rel, r16, quad); break;
                    case 4: tail = att_block<true, 5>(Ks, Vs, qf, O, suffix, q_rel, r16, quad); break; case 5: tail = att_block<true, 6>(Ks, Vs, qf, O, suffix, q_rel, r16, quad); break;
                    case 6: tail = att_block<true, 7>(Ks, Vs, qf, O, suffix, q_rel, r16, quad); break; default: tail = att_block<true, 8>(Ks, Vs, qf, O, suffix, q_rel, r16, quad); break; }
                suffix += tail;
                float sm = suffix; sm = fmaxf(sm, __shfl_xor(sm, 1)); sm = fmaxf(sm, __shfl_xor(sm, 2)); sm = fmaxf(sm, __shfl_xor(sm, 4)); sm = fmaxf(sm, __shfl_xor(sm, 8));
                wsm = sm;
            }
            if (lane == 0) smax_s[w] = wsm;
            __syncthreads();
            float mall = smax_s[0];
#pragma unroll
            for (int i = 1; i < 8; ++i) mall = fmaxf(mall, smax_s[i]);
            if (mall < -160.f) break;
        }
        { const int nu = unit + gridDim.x; if (nu < 4096) { const int nbh = nu & 63, nqb = 63 - (nu >> 6); ATT_QLOAD(nbh >> 4, nbh & 15, nqb); ATT_LOAD(nbh >> 4, nbh & 15, nqb); } }
        __builtin_amdgcn_sched_barrier(0);
        {
            LAS bf16* Ow = (LAS bf16*)(L + 73728 + w * 2304);
#pragma unroll
            for (int dt = 0; dt < 4; ++dt)
#pragma unroll
                for (int j = 0; j < 4; ++j) Ow[(4 * quad + j) * 72 + 16 * dt + r16] = (bf16)f2bf(O[dt][j]);
            asm volatile("s_waitcnt lgkmcnt(0)" ::: "memory");
#pragma unroll
            for (int k = 0; k < 2; ++k) { const int row = lane >> 2, seg = (lane & 3) + 4 * k; const u32x4 ov = *(const LAS u32x4*)(Ow + row * 72 + seg * 8);
                if (REAL) *(u32x4*)(QO + (rowq + row) * 1024 + h * 64 + seg * 8) = ov; }
        }
    }
}
#undef ATT_LOAD
#undef ATT_QLOAD

#define XB_TMO      128
#define XB_XCNT(j)  (256  + 64 * (j))
#define XB_XSUB(j)  (1280 + 64 * (j))
#define XB_XGEN(j)  (2304 + 64 * (j))
#define XB_TOP      3328
#define XB_TOPGEN   3392
#define XCD_BAR_WORDS 3456
#define XB_SPIN_CAP (1u << 20)

__device__ __forceinline__ unsigned xb_ld(unsigned* p)              { return __hip_atomic_load(p, __ATOMIC_RELAXED, __HIP_MEMORY_SCOPE_AGENT); }
__device__ __forceinline__ unsigned xb_add(unsigned* p, unsigned v) { return __hip_atomic_fetch_add(p, v, __ATOMIC_RELAXED, __HIP_MEMORY_SCOPE_AGENT); }
__device__ __forceinline__ unsigned xb_xcc_id() { return (unsigned)__builtin_amdgcn_s_getreg((3 << 11) | 20) & 0xFu; }
#define XB_SPIN(cond, bar) do { unsigned _sp = 0; while (cond) { __builtin_amdgcn_s_sleep(1); \
    if ((++_sp & 255u) == 0u) { if (xb_ld(&(bar)[XB_TMO])) break; if (_sp > XB_SPIN_CAP) { atomicAdd(&(bar)[XB_TMO], 1u); break; } } } } while (0)

struct XcdBarrier {
    unsigned* bar; unsigned x;
    volatile LAS unsigned* st;
};

__device__ __forceinline__ XcdBarrier xcd_barrier_post(unsigned* bar, volatile LAS unsigned* st) {
    XcdBarrier b; b.bar = bar; b.x = xb_xcc_id(); b.st = st;
    if (threadIdx.x == 0) (void)xb_add(&bar[XB_XCNT(b.x)], 1u);
    return b;
}
__device__ __forceinline__ void xcd_barrier_complete(unsigned* bar, unsigned x, unsigned& nloc, unsigned& nx) {
    const unsigned G = gridDim.x * gridDim.y * gridDim.z;
    unsigned sum, cnt, mine, sp = 0u;
    for (;;) {
        sum = 0u; cnt = 0u; mine = 0u;
#pragma unroll
        for (unsigned j = 0; j < 16; ++j) { const unsigned c = xb_ld(&bar[XB_XCNT(j)]); sum += c; cnt += (c > 0u) ? 1u : 0u; mine = (j == x) ? c : mine; }
        if (sum == G) break;
        __builtin_amdgcn_s_sleep(1);
        if ((++sp & 255u) == 0u) { if (xb_ld(&bar[XB_TMO])) break; if (sp > XB_SPIN_CAP) { atomicAdd(&bar[XB_TMO], 1u); break; } }
    }
    nloc = mine > 0u ? mine : 1u; nx = cnt > 0u ? cnt : 1u;
}

__device__ __forceinline__ void xcd_barrier(const XcdBarrier& b) {
    asm volatile("s_waitcnt vmcnt(0)" ::: "memory");
    __syncthreads();
    if (threadIdx.x == 0) {
        unsigned* bar = b.bar;
        __builtin_amdgcn_s_waitcnt(0);
        unsigned nloc = b.st[0], nx = b.st[1];
        if (nloc == 0u) { xcd_barrier_complete(bar, b.x, nloc, nx); b.st[0] = nloc; b.st[1] = nx; }
        const unsigned old = xb_add(&bar[XB_XSUB(b.x)], 1u);
        const unsigned gen = old / nloc;
        if (old + 1u == (gen + 1u) * nloc) {
            __builtin_amdgcn_fence(__ATOMIC_RELEASE, "agent");
            asm volatile("s_waitcnt vmcnt(0)" ::: "memory");
            const unsigned og = xb_add(&bar[XB_TOP], 1u);
            const unsigned tg = og / nx;
            if (og + 1u == (tg + 1u) * nx) xb_add(&bar[XB_TOPGEN], 1u);
            else XB_SPIN(xb_ld(&bar[XB_TOPGEN]) == tg, bar);
            __builtin_amdgcn_fence(__ATOMIC_ACQUIRE, "agent");
            xb_add(&bar[XB_XGEN(b.x)], 1u);
            asm volatile("s_waitcnt vmcnt(0)" ::: "memory");
        } else {
            XB_SPIN(xb_ld(&bar[XB_XGEN(b.x)]) == gen, bar);
            __builtin_amdgcn_fence(__ATOMIC_ACQUIRE, "agent");
            asm volatile("s_waitcnt vmcnt(0)" ::: "memory");
        }
    }
    __syncthreads();
}

#ifndef DUPMASK
#define DUPMASK 0
#endif
#ifndef SSD_DMODE
#define SSD_DMODE 15
#endif
#define DUP(k) constexpr ((DUPMASK >> (k)) & 1)
__global__ void __launch_bounds__(NTHR, 2) yoco_fwd(Params p) {
    extern __shared__ __attribute__((aligned(16))) unsigned char lds[];
    LAS unsigned char* L = (LAS unsigned char*)lds;
    cg::grid_group grid = cg::this_grid();
    if (threadIdx.x < 2) ((LAS unsigned*)(L + LDS_BYTES - 16))[threadIdx.x] = 0u;
    __syncthreads();
    const XcdBarrier xbar = xcd_barrier_post((unsigned*)(p.ws + WS_BAR), (volatile LAS unsigned*)(L + LDS_BYTES - 16));
    if (gridDim.x > 65536u) grid.sync();
#define GSYNC() xcd_barrier(xbar)
    unsigned char* ws = p.ws;
    bf16* WB = (bf16*)(ws + WS_W);
    float* MODS = (float*)(ws + WS_MODS); float* SUMSQ = (float*)(ws + WS_SUMSQ);
    bf16* X = (bf16*)(ws + WS_X);
    bf16* H0 = (bf16*)(ws + WS_X); float* DTb = (float*)(ws + WS_X + 64 * MiB); float* ACSb = (float*)(ws + WS_X + 92 * MiB); float* PSb = (float*)(ws + WS_X + 96 * MiB); float* P0b = (float*)(ws + WS_X + 68 * MiB); float* UH0 = (float*)(ws + WS_X + 80 * MiB);
    bf16* XBC = (bf16*)(ws + WS_BIG); bf16* Gb = (bf16*)(ws + WS_BIG); bf16* H = (bf16*)(ws + WS_BIG + 176 * MiB);
    float* P1b = (float*)(ws + WS_BIG + 240 * MiB); float* UH1 = (float*)(ws + WS_BIG + 248 * MiB);
    bf16* HK = (bf16*)(ws + WS_BIG); bf16* QO = (bf16*)(ws + WS_BIG + 64 * MiB);
    bf16* Zb = (bf16*)p.out; bf16* Kb = (bf16*)p.out; bf16* VT = (bf16*)((unsigned char*)p.out + 64 * MiB);
    LAS float* xch = (LAS float*)(L + XCH_OFF);
    const int G_ = gridDim.x, c_ = blockIdx.x;
    using pg8::Gemm; using pg8::StaticOrder;

#ifndef PHM
#define PHM 0xffff
#endif
#define EN(x) constexpr ((PHM >> (x)) & 1)
    unsigned long long* TS = (unsigned long long*)(ws + WS_FLAGS + 4096);
    STAMP(0);
if DUP(1) { if EN(0) p0_phase(p, L); GSYNC(); }
        if EN(0) p0_phase(p, L);
    GSYNC(); STAMP(1);
if DUP(2) { if EN(1) norm_phase<1, false>(p.in[0], p.in[4], MODS + 0, H0, nullptr, nullptr, nullptr); GSYNC(); }
        if EN(1) norm_phase<1, false>(p.in[0], p.in[4], MODS + 0, H0, nullptr, nullptr, nullptr);
    GSYNC(); STAMP(2);
    if DUP(3) { if EN(2) {
        Gemm g{H0, WB + W_IN, T, 2304, 1024}; StaticOrder S; S.init(T, 2304, G_, c_);
        pg8::EpiZdt E{Zb, DTb, p.in[9]};
        pg8::gemm_phase<pg8::EpiZdt, StaticOrder, true, true>(L, g, S, E);
    }
    if EN(2) {
        Gemm g{H0, WB + W_IN + (size_t)2304 * 1024, T, 4096, 1024}; StaticOrder S; S.init(T, 4096, G_, c_);
        pg8::EpiMamba E{XBC, P0b, UH0, p.in[7], p.in[8], xch};
        pg8::gemm_phase<pg8::EpiMamba, StaticOrder, true, true>(L, g, S, E);
    } GSYNC(); }
    if EN(2) {
        Gemm g{H0, WB + W_IN, T, 2304, 1024}; StaticOrder S; S.init(T, 2304, G_, c_);
        pg8::EpiZdt E{Zb, DTb, p.in[9]};
        pg8::gemm_phase<pg8::EpiZdt, StaticOrder, true, true>(L, g, S, E);
    }
    if EN(2) {
        Gemm g{H0, WB + W_IN + (size_t)2304 * 1024, T, 4096, 1024}; StaticOrder S; S.init(T, 4096, G_, c_);
        pg8::EpiMamba E{XBC, P0b, UH0, p.in[7], p.in[8], xch};
        pg8::gemm_phase<pg8::EpiMamba, StaticOrder, true, true>(L, g, S, E);
    }
    GSYNC(); STAMP(3);
#ifdef XSYNC
    for (int i = 0; i < XSYNC; ++i) GSYNC();
#endif
    if EN(3) { fixup_mamba(P0b, UH0, p.in[7], p.in[8], XBC); acs_phase(DTb, p.in[10], ACSb); }
    GSYNC(); STAMP(4);
    if DUP(5) { ssd_phase<false, SSD_DMODE>(XBC, Zb, DTb, ACSb, p.in[10], p.in[11], p.in[12], PSb, L); GSYNC(); }
    if EN(4) ssd_phase<true>(XBC, Zb, DTb, ACSb, p.in[10], p.in[11], p.in[12], PSb, L);
    GSYNC();
    ssreduce_phase(PSb, SUMSQ);
    GSYNC(); STAMP(5);
    if DUP(6) { if EN(5) {
        Gemm g{Zb, WB + W_SOUT, T, 1024, 2048}; StaticOrder S; S.init(T, 1024, G_, c_);
        pg8::EpiRes<true> E{p.in[0], X, MODS + 2048, SUMSQ};
        pg8::gemm_phase<pg8::EpiRes<true>, StaticOrder, true, true>(L, g, S, E);
    } GSYNC(); }
    if EN(5) {
        Gemm g{Zb, WB + W_SOUT, T, 1024, 2048}; StaticOrder S; S.init(T, 1024, G_, c_);
        pg8::EpiRes<true> E{p.in[0], X, MODS + 2048, SUMSQ};
        pg8::gemm_phase<pg8::EpiRes<true>, StaticOrder, true, true>(L, g, S, E);
    }
    GSYNC(); STAMP(6);
    {
        const float* md = MODS;
if DUP(7) { norm_phase_b<1, false>(X, p.in[5] + 0, md + 3072, H, nullptr, nullptr, nullptr); GSYNC(); }
            norm_phase_b<1, false>(X, p.in[5] + 0, md + 3072, H, nullptr, nullptr, nullptr);
        GSYNC(); STAMP(7);
        if DUP(8) { if EN(9) { Gemm g{H, WB + (W_FIN0), T, 5632, 1024}; StaticOrder S; S.init(T, 5632, G_, c_);
          pg8::EpiFFN E{Gb, P1b, UH1, p.in[22] + 0, p.in[23] + 0, xch};
          pg8::gemm_phase<pg8::EpiFFN, StaticOrder, true, true>(L, g, S, E); } GSYNC(); }
    if EN(9) { Gemm g{H, WB + (W_FIN0), T, 5632, 1024}; StaticOrder S; S.init(T, 5632, G_, c_);
          pg8::EpiFFN E{Gb, P1b, UH1, p.in[22] + 0, p.in[23] + 0, xch};
          pg8::gemm_phase<pg8::EpiFFN, StaticOrder, true, true>(L, g, S, E); }
        GSYNC(); STAMP(8);
        if EN(10) fixup_ffn(P1b, UH1, p.in[22] + 0, p.in[23] + 0, Gb);
        GSYNC(); STAMP(9);
        if DUP(10) { if EN(11) { Gemm g{Gb, WB + (W_FOUT0), T, 1024, 2816}; StaticOrder S; S.init(T, 1024, G_, c_); pg8::EpiRes<false> E{X, (bf16*)p.out, md + 5120, nullptr};
          pg8::gemm_phase<pg8::EpiRes<false>, StaticOrder, true, true>(L, g, S, E); } GSYNC(); }
    if EN(11) { Gemm g{Gb, WB + (W_FOUT0), T, 1024, 2816}; StaticOrder S; S.init(T, 1024, G_, c_); pg8::EpiRes<false> E{X, X, md + 5120, nullptr};
          pg8::gemm_phase<pg8::EpiRes<false>, StaticOrder, true, true>(L, g, S, E); }
        GSYNC(); STAMP(10);
    }
    {
        const float* md = MODS + MOD_L;
if DUP(11) { norm_phase_b<2, false>(X, p.in[16], MODS + MOD_KV, HK, p.in[4] + 1024, md + 0, H); GSYNC(); }
                norm_phase_b<2, false>(X, p.in[16], MODS + MOD_KV, HK, p.in[4] + 1024, md + 0, H);
            GSYNC(); STAMP(11);
            if DUP(12) { if EN(6) { Gemm g{HK, WB + W_K, T, 1024, 1024}; StaticOrder S; S.init(T, 1024, G_, c_); pg8::EpiStore E{Kb, 1024, 1.0f};
              pg8::gemm_phase<pg8::EpiStore, StaticOrder, true, true>(L, g, S, E); }
            if EN(6) { Gemm g{WB + W_V, HK, 1024, T, 1024}; StaticOrder S; S.init(1024, T, G_, c_); pg8::EpiStore E{VT, T, 1.0f};
              pg8::gemm_phase<pg8::EpiStore, StaticOrder, true, true>(L, g, S, E); }
            if EN(6) { Gemm g{H, WB + W_Q, T, 1024, 1024}; StaticOrder S; S.init(T, 1024, G_, c_); pg8::EpiStore E{QO, 1024, 0.125f * 1.4426950408889634f};
              pg8::gemm_phase<pg8::EpiStore, StaticOrder, true, true>(L, g, S, E); } GSYNC(); }
    if EN(6) { Gemm g{HK, WB + W_K, T, 1024, 1024}; StaticOrder S; S.init(T, 1024, G_, c_); pg8::EpiStore E{Kb, 1024, 1.0f};
              pg8::gemm_phase<pg8::EpiStore, StaticOrder, true, true>(L, g, S, E); }
            if EN(6) { Gemm g{WB + W_V, HK, 1024, T, 1024}; StaticOrder S; S.init(1024, T, G_, c_); pg8::EpiStore E{VT, T, 1.0f};
              pg8::gemm_phase<pg8::EpiStore, StaticOrder, true, true>(L, g, S, E); }
            if EN(6) { Gemm g{H, WB + W_Q, T, 1024, 1024}; StaticOrder S; S.init(T, 1024, G_, c_); pg8::EpiStore E{QO, 1024, 0.125f * 1.4426950408889634f};
              pg8::gemm_phase<pg8::EpiStore, StaticOrder, true, true>(L, g, S, E); }
            GSYNC(); STAMP(12);
            if DUP(13) { attn_phase<false>(QO, Kb, VT, L); GSYNC(); }
            if EN(7) attn_phase<true>(QO, Kb, VT, L);
            GSYNC(); STAMP(13);
            if DUP(14) { if EN(8) { Gemm g{QO, WB + W_O, T, 1024, 1024}; StaticOrder S; S.init(T, 1024, G_, c_); pg8::EpiRes<false> E{X, (bf16*)p.out, md + 2048, nullptr};
              pg8::gemm_phase<pg8::EpiRes<false>, StaticOrder, true, true>(L, g, S, E); } GSYNC(); }
    if EN(8) { Gemm g{QO, WB + W_O, T, 1024, 1024}; StaticOrder S; S.init(T, 1024, G_, c_); pg8::EpiRes<false> E{X, X, md + 2048, nullptr};
              pg8::gemm_phase<pg8::EpiRes<false>, StaticOrder, true, true>(L, g, S, E); }
            GSYNC(); STAMP(14);
if DUP(15) { norm_phase_b<1, false>(X, p.in[5] + 1024, md + 3072, H, nullptr, nullptr, nullptr); GSYNC(); }
            norm_phase_b<1, false>(X, p.in[5] + 1024, md + 3072, H, nullptr, nullptr, nullptr);
        GSYNC(); STAMP(15);
        if DUP(16) { if EN(9) { Gemm g{H, WB + (W_FIN1), T, 5632, 1024}; StaticOrder S; S.init(T, 5632, G_, c_);
          pg8::EpiFFN E{Gb, P1b, UH1, p.in[22] + 16896, p.in[23] + 5632, xch};
          pg8::gemm_phase<pg8::EpiFFN, StaticOrder, true, true>(L, g, S, E); } GSYNC(); }
    if EN(9) { Gemm g{H, WB + (W_FIN1), T, 5632, 1024}; StaticOrder S; S.init(T, 5632, G_, c_);
          pg8::EpiFFN E{Gb, P1b, UH1, p.in[22] + 16896, p.in[23] + 5632, xch};
          pg8::gemm_phase<pg8::EpiFFN, StaticOrder, true, true>(L, g, S, E); }
        GSYNC(); STAMP(16);
        if EN(10) fixup_ffn(P1b, UH1, p.in[22] + 16896, p.in[23] + 5632, Gb);
        GSYNC(); STAMP(17);
        if DUP(18) { if EN(11) { Gemm g{Gb, WB + (W_FOUT1), T, 1024, 2816}; StaticOrder S; S.init(T, 1024, G_, c_); pg8::EpiRes<false> E{X, (bf16*)p.out, md + 5120, nullptr};
          pg8::gemm_phase<pg8::EpiRes<false>, StaticOrder, true, true>(L, g, S, E); } GSYNC(); }
    if EN(11) { Gemm g{Gb, WB + (W_FOUT1), T, 1024, 2816}; StaticOrder S; S.init(T, 1024, G_, c_); pg8::EpiRes<false> E{X, X, md + 5120, nullptr};
          pg8::gemm_phase<pg8::EpiRes<false>, StaticOrder, true, true>(L, g, S, E); }
        GSYNC(); STAMP(18);
    }
if DUP(19) { norm_phase_b<1, true>(X, p.in[27], MODS + MOD_FIN, p.out, nullptr, nullptr, nullptr); GSYNC(); }
        norm_phase_b<1, true>(X, p.in[27], MODS + MOD_FIN, p.out, nullptr, nullptr, nullptr);
#ifdef PROBE
    GSYNC(); STAMP(19);
    __threadfence();
    {   volatile unsigned long long* tsv = TS; float ta = 0.f, tb = 0.f;
        for (int k = 1; k <= 19; ++k) { const float d = (float)(tsv[k] - tsv[k - 1]) * 0.01f; if ((PROBE_A >> k) & 1) ta += d; if ((PROBE_B >> k) & 1) tb += d; }
        for (int i = blockIdx.x * NTHR + threadIdx.x; i < (1 << 22); i += gridDim.x * NTHR) p.out[(1 << 24) + i] = tb;
        if (blockIdx.x == 0 && threadIdx.x == 0) p.out[0] = ta * 10.0f; }
#endif
}

extern "C" void kernel_launch(void* const* d_in, const int* in_sizes, int n_in, void* d_out, int out_size, void* d_ws, size_t ws_size, hipStream_t stream) {
    static int grid = 0;
    if (grid == 0) {
        if (n_in != 28 || out_size != T * D || ws_size < WS_END) { fprintf(stderr, "kernel_launch: unexpected shapes (n_in %d out %d ws %zu)\n", n_in, out_size, ws_size); grid = -1; return; }
        int dev = 0, cus = 0, per_cu = 0;
        hipGetDevice(&dev); hipDeviceGetAttribute(&cus, hipDeviceAttributeMultiprocessorCount, dev);
        hipFuncSetAttribute((const void*)yoco_fwd, hipFuncAttributeMaxDynamicSharedMemorySize, LDS_BYTES);
        hipOccupancyMaxActiveBlocksPerMultiprocessor(&per_cu, (const void*)yoco_fwd, NTHR, LDS_BYTES);
        if (per_cu < 1) per_cu = 1;
        grid = cus * per_cu; if (grid > 256) grid = 256;
        (void)hipGetLastError();
    }
    if (grid < 0) return;
    Params p{};
    for (int i = 0; i < 28; ++i) p.in[i] = (const float*)d_in[i];
    p.out = (float*)d_out; p.ws = (unsigned char*)d_ws;
    (void)hipMemsetAsync((unsigned char*)d_ws + WS_BAR, 0, 16384, stream);
    void* args[] = {&p};
    hipError_t e = hipLaunchCooperativeKernel((const void*)yoco_fwd, dim3(grid), dim3(NTHR), args, LDS_BYTES, stream);
    if (e != hipSuccess) fprintf(stderr, "cooperative launch failed: %s (grid %d)\n", hipGetErrorString(e), grid);
}
```
